# Optimizing an MI355X kernel written in HIP

```python
import jax
import jax.numpy as jnp
from jax import lax
import numpy as np

D_MODEL = 1024
BATCH = 8
SEQ = 2048
DEPTH = 4

GRID_W = 64
CTX_LEN = 256
HEAD_DIM = D_MODEL // 16
A_HEADS = 4
B_HEADS = 4
C_HEADS = 8
A_WIDTH = A_HEADS * HEAD_DIM
B_WIDTH = B_HEADS * HEAD_DIM
C_WIDTH = C_HEADS * HEAD_DIM
MIX_WIDTH = A_WIDTH + B_WIDTH + C_WIDTH
HGRN_CHUNK = 16
HGRN_F_FLOOR = 1e-20
RWKV_W_RANK = 64
RWKV_A_RANK = 64
RWKV_G_RANK = 128
RWKV_LN_EPS = 64e-5
NA_WIN_ROWS = 8
NA_WIN_COLS = 16
NA_COL_BLOCK = 16
NA_KEY_COLS = NA_COL_BLOCK + NA_WIN_COLS
ROPE_THETA = 10000.0
N_GROUPS = 4
EXPERTS_PER_GROUP = 8
TOP_K_IN_GROUP = 2
D_EXPERT = 512
EPS = 1e-6
NEG_INF = -1e30
A_PROJ = 5 * A_WIDTH
B_PROJ = 3 * B_WIDTH + 2 * RWKV_W_RANK + 2 * RWKV_A_RANK + RWKV_G_RANK
C_PROJ = 3 * C_WIDTH
P_TOTAL = A_PROJ + B_PROJ + C_PROJ
RWKV_SPLITS = (B_WIDTH, 2 * B_WIDTH, 3 * B_WIDTH, 3 * B_WIDTH + RWKV_W_RANK, 3 * B_WIDTH + 2 * RWKV_W_RANK,
               3 * B_WIDTH + 2 * RWKV_W_RANK + RWKV_A_RANK, 3 * B_WIDTH + 2 * RWKV_W_RANK + 2 * RWKV_A_RANK)

kernel_name = 'hybrid_diffusion_trunk'


def rms_norm(x, gain):
    xf = x.astype(jnp.float32)
    return xf * lax.rsqrt(jnp.mean(xf * xf, axis=-1, keepdims=True) + EPS) * gain.astype(jnp.float32)


def to_heads(t, n_heads):
    b, t_len, _ = t.shape
    return t.reshape(b, t_len, n_heads, HEAD_DIM).transpose(0, 2, 1, 3)


def chunk_gla(q, k, v, log_f, s0):
    b, h, t_len, _ = q.shape
    n = t_len // HGRN_CHUNK

    def blocks(u):
        return u.reshape(b, h, n, HGRN_CHUNK, u.shape[-1])

    q, k, v, log_f = blocks(q), blocks(k), blocks(v), blocks(log_f)
    cum = jnp.cumsum(log_f, axis=3)
    tri = jnp.tril(jnp.ones((HGRN_CHUNK, HGRN_CHUNK), dtype=bool))[:, :, None]
    diff = cum[:, :, :, :, None, :] - cum[:, :, :, None, :, :]
    decay = jnp.where(tri, jnp.exp(jnp.where(tri, diff, 0.0)), 0.0)
    scores = jnp.einsum('bhntd,bhnsd,bhntsd->bhnts', q, k, decay)
    o_intra = jnp.einsum('bhnts,bhnsv->bhntv', scores, v)
    q_in = q * jnp.exp(cum)
    k_out = k * jnp.exp(cum[:, :, :, -1:, :] - cum)
    kv = jnp.einsum('bhnsd,bhnsv->bhndv', k_out, v)
    chunk_decay = jnp.exp(cum[:, :, :, -1, :])

    def step(s, inp):
        q_c, dec_c, kv_c = inp
        o_c = jnp.einsum('bhtd,bhdv->bhtv', q_c, s)
        return s * dec_c[..., None] + kv_c, o_c

    s_fin, o_inter = lax.scan(step, s0, (jnp.moveaxis(q_in, 2, 0), jnp.moveaxis(chunk_decay, 2, 0),
                                         jnp.moveaxis(kv, 2, 0)))
    o = o_intra + jnp.moveaxis(o_inter, 0, 2)
    return o.reshape(b, h, t_len, v.shape[-1]), s_fin


def hgrn2_forget(f_pre, lb):
    f = lb + (1.0 - lb) * jax.nn.sigmoid(f_pre)
    log_f = jnp.log(jnp.maximum(f, HGRN_F_FLOOR))
    k = (1.0 - lb) * jax.nn.sigmoid(-f_pre)
    return to_heads(log_f, A_HEADS), to_heads(k, A_HEADS)


def hgrn2_mixer(p_ctx, p_lat, lb_fwd, lb_bwd, gn_gain):
    qc, ffc, fbc, ic, gc = jnp.split(p_ctx, 5, axis=-1)
    ql, ffl, fbl, il, gl = jnp.split(p_lat, 5, axis=-1)
    qc, ic, ql, il = (to_heads(t, A_HEADS) for t in (qc, ic, ql, il))
    s0 = jnp.zeros((p_lat.shape[0], A_HEADS, HEAD_DIM, HEAD_DIM), jnp.float32)

    def flip(t):
        return t[:, :, ::-1]

    lf, kf = hgrn2_forget(ffc, lb_fwd)
    oc_f, s_f = chunk_gla(qc, kf, ic, lf, s0)
    lf, kf = hgrn2_forget(ffl, lb_fwd)
    ol_f, _ = chunk_gla(ql, kf, il, lf, s_f)
    lbk, kb = hgrn2_forget(fbc, lb_bwd)
    oc_b, s_b = chunk_gla(flip(qc), flip(kb), flip(ic), flip(lbk), s0)
    lbk, kb = hgrn2_forget(fbl, lb_bwd)
    ol_b, _ = chunk_gla(flip(ql), flip(kb), flip(il), flip(lbk), s_b)

    def readout(o, g):
        o = rms_norm(o.transpose(0, 2, 1, 3), gn_gain)
        return o.reshape(g.shape) * jax.nn.silu(g)

    return readout(ol_f + flip(ol_b), gl), readout(oc_f + flip(oc_b), gc)


def centred_shift(u):
    pad = jnp.pad(u, ((0, 0), (1, 1), (0, 0)))
    return 0.5 * (pad[:, :-2] + pad[:, 2:])


def rwkv7_scan(r, w, k, v, kk, ak, s0):
    def step(s, inp):
        r_t, w_t, k_t, v_t, kk_t, ak_t = inp
        sa = jnp.einsum('bhvk,bhk->bhv', s, kk_t)
        s = s * w_t[:, :, None, :] - sa[..., None] * ak_t[:, :, None, :] + v_t[..., None] * k_t[:, :, None, :]
        return s, jnp.einsum('bhvk,bhk->bhv', s, r_t)

    xs = tuple(jnp.moveaxis(u, 1, 0) for u in (r, w, k, v, kk, ak))
    s_fin, ys = lax.scan(step, s0, xs)
    return jnp.moveaxis(ys, 0, 1), s_fin


def rwkv7_mixer(p_ctx, p_lat, mu, w0, w_up, a0, a_up, g_up, kk_scale, k_a, r_k, ln_gain, ln_bias):
    def hd(t):
        return t.reshape(t.shape[0], t.shape[1], B_HEADS, HEAD_DIM)

    def prep(p):
        p = p + (centred_shift(p) - p) * mu
        r, k, v, wdf, wdb, adf, adb, gd = jnp.split(p, list(RWKV_SPLITS), axis=-1)
        kk = hd(k * kk_scale)
        kk = kk / jnp.maximum(jnp.sqrt(jnp.sum(kk * kk, axis=-1, keepdims=True)), 1e-12)
        dirs = []
        for d, (wd, ad) in enumerate(((wdf, adf), (wdb, adb))):
            w = -jax.nn.softplus(-(w0[d] + jnp.tanh(wd) @ w_up[d])) - 0.5
            decay = jnp.exp(-jnp.exp(w))
            a = jax.nn.sigmoid(a0[d] + ad @ a_up[d])
            k_d = k * (1.0 + (a - 1.0) * k_a)
            dirs.append((hd(decay), hd(k_d), hd(a) * kk))
        g = jax.nn.sigmoid(gd) @ g_up
        return hd(r), hd(v), kk, dirs, g

    rc, vc, kkc, dc, gc = prep(p_ctx)
    rl, vl, kkl, dl, gl = prep(p_lat)
    s0 = jnp.zeros((p_lat.shape[0], B_HEADS, HEAD_DIM, HEAD_DIM), jnp.float32)

    def flip(t):
        return t[:, ::-1]

    (wcf, kcf, akcf), (wcb, kcb, akcb) = dc
    (wlf, klf, aklf), (wlb, klb, aklb) = dl
    yc_f, s_f = rwkv7_scan(rc, wcf, kcf, vc, kkc, akcf, s0)
    yl_f, _ = rwkv7_scan(rl, wlf, klf, vl, kkl, aklf, s_f)
    yc_b, s_b = rwkv7_scan(flip(rc), flip(wcb), flip(kcb), flip(vc), flip(kkc), flip(akcb), s0)
    yl_b, _ = rwkv7_scan(flip(rl), flip(wlb), flip(klb), flip(vl), flip(kkl), flip(aklb), s_b)

    def readout(y, r, v, k_f, k_b, g):
        mean = jnp.mean(y, axis=-1, keepdims=True)
        var = jnp.mean(jnp.square(y - mean), axis=-1, keepdims=True)
        y = ((y - mean) * lax.rsqrt(var + RWKV_LN_EPS)).reshape(g.shape) * ln_gain + ln_bias
        bonus = (jnp.sum(r * (k_f + k_b) * r_k, axis=-1, keepdims=True) * v).reshape(g.shape)
        return (y + bonus) * g

    out_lat = readout(yl_f + flip(yl_b), rl, vl, klf, klb, gl)
    out_ctx = readout(yc_f + flip(yc_b), rc, vc, kcf, kcb, gc)
    return out_lat, out_ctx


def axial_rope(t, pos_r, pos_c):
    quarter = HEAD_DIM // 4
    inv = ROPE_THETA ** (-jnp.arange(quarter, dtype=jnp.float32) / quarter)
    ang = jnp.concatenate([pos_r[:, None] * inv, pos_c[:, None] * inv], axis=-1)
    cos = jnp.cos(ang)[None, :, None, :]
    sin = jnp.sin(ang)[None, :, None, :]
    t1, t2 = jnp.split(t, 2, axis=-1)
    return jnp.concatenate([t1 * cos - t2 * sin, t2 * cos + t1 * sin], axis=-1)


def neighbourhood_attention(p_ctx, p_lat, q_gain, k_gain, rpb, pos_r, pos_c, need_ctx):
    bsz, t_lat, _ = p_lat.shape
    n_ctx = p_ctx.shape[1]
    rows = t_lat // GRID_W
    win_r = min(NA_WIN_ROWS, rows)
    scale = HEAD_DIM ** -0.5

    def qkv(p):
        q, k, v = jnp.split(p, 3, axis=-1)
        hd = lambda t: t.reshape(t.shape[0], t.shape[1], C_HEADS, HEAD_DIM)
        return rms_norm(hd(q), q_gain), rms_norm(hd(k), k_gain), hd(v)

    qc, kc, vc = qkv(p_ctx)
    ql, kl, vl = qkv(p_lat)
    ql, kl = axial_rope(ql, pos_r, pos_c), axial_rope(kl, pos_r, pos_c)
    kc_h, vc_h = kc.transpose(0, 2, 1, 3), vc.transpose(0, 2, 1, 3)

    def grid(t):
        return t.transpose(0, 2, 1, 3).reshape(bsz, C_HEADS, rows, GRID_W, HEAD_DIM)

    qg, kg, vg = grid(ql), grid(kl), grid(vl)
    n_cb = GRID_W // NA_COL_BLOCK
    q_col = jnp.arange(GRID_W).reshape(n_cb, NA_COL_BLOCK)
    k_start = jnp.clip(jnp.arange(n_cb) * NA_COL_BLOCK - NA_WIN_COLS // 2, 0, GRID_W - NA_KEY_COLS)
    k_col = k_start[:, None] + jnp.arange(NA_KEY_COLS)
    w_start = jnp.clip(q_col - NA_WIN_COLS // 2, 0, GRID_W - NA_WIN_COLS)
    kc3 = k_col[:, None, :]
    in_win = (kc3 >= w_start[..., None]) & (kc3 < w_start[..., None] + NA_WIN_COLS)
    col_idx = jnp.clip(kc3 - q_col[..., None] + NA_WIN_COLS - 1, 0, 2 * NA_WIN_COLS - 2)
    n_win = win_r * NA_KEY_COLS

    def one_row(r):
        r_start = jnp.clip(r - win_r // 2, 0, rows - win_r)
        k_blk = lax.dynamic_slice_in_dim(kg, r_start, win_r, axis=2)[:, :, :, k_col]
        v_blk = lax.dynamic_slice_in_dim(vg, r_start, win_r, axis=2)[:, :, :, k_col]
        q_row = lax.dynamic_index_in_dim(qg, r, axis=2, keepdims=False).reshape(
            bsz, C_HEADS, n_cb, NA_COL_BLOCK, HEAD_DIM)
        s_win = jnp.einsum('bhjqd,bhrjkd->bhjqrk', q_row, k_blk) * scale
        row_idx = r_start + jnp.arange(win_r) - r + NA_WIN_ROWS - 1
        bias = rpb[:, row_idx[None, None, :, None], col_idx[:, :, None, :]]
        s_win = jnp.where(in_win[:, :, None, :], s_win + bias, NEG_INF)
        s_ctx = jnp.einsum('bhjqd,bhld->bhjql', q_row, kc_h) * scale
        s_all = jnp.concatenate([s_win.reshape(s_win.shape[:4] + (n_win,)), s_ctx], axis=-1)
        prob = jax.nn.softmax(s_all, axis=-1)
        p_win = prob[..., :n_win].reshape(s_win.shape)
        p_ctx = prob[..., n_win:]
        o = (jnp.einsum('bhjqrk,bhrjkd->bhjqd', p_win, v_blk)
             + jnp.einsum('bhjql,bhld->bhjqd', p_ctx, vc_h))
        return o.reshape(bsz, C_HEADS, GRID_W, HEAD_DIM)

    o = lax.map(one_row, jnp.arange(rows))
    out_lat = o.transpose(1, 0, 3, 2, 4).reshape(bsz, t_lat, C_WIDTH)
    out_ctx = None
    if need_ctx:
        qc_h = qc.transpose(0, 2, 1, 3)
        pc = jax.nn.softmax(jnp.einsum('bhqd,bhkd->bhqk', qc_h, kc_h) * scale, axis=-1)
        out_ctx = jnp.einsum('bhqk,bhkd->bhqd', pc, vc_h).transpose(0, 2, 1, 3).reshape(bsz, n_ctx, C_WIDTH)
    return out_lat, out_ctx


def hierarchical_moe(h, w_rg, b_rg, w_re, b_re, w_gate, w_up, w_down):
    g_logits = h @ w_rg + b_rg
    g_prob = jax.nn.softmax(g_logits, axis=-1)
    g_sel = jnp.argmax(g_logits, axis=-1)
    g_w = jnp.take_along_axis(g_prob, g_sel[:, None], axis=-1)
    e_logits = (h @ w_re + b_re).reshape(-1, N_GROUPS, EXPERTS_PER_GROUP)
    e_logits = jnp.take_along_axis(e_logits, g_sel[:, None, None], axis=1)[:, 0]
    e_prob = jax.nn.softmax(e_logits, axis=-1)
    top_w, top_i = lax.top_k(e_prob, TOP_K_IN_GROUP)
    top_w = top_w / jnp.sum(top_w, axis=-1, keepdims=True) * g_w
    e_w = jnp.sum(jax.nn.one_hot(top_i, EXPERTS_PER_GROUP, dtype=jnp.float32) * top_w[..., None], axis=1)
    comb = jax.nn.one_hot(g_sel, N_GROUPS, dtype=jnp.float32)[:, :, None] * e_w[:, None, :]
    y = jnp.zeros(h.shape, jnp.float32)
    for gi in range(N_GROUPS):
        hid = jax.nn.silu(jnp.einsum('nd,edf->nef', h, w_gate[gi])) * jnp.einsum('nd,edf->nef', h, w_up[gi])
        y = y + jnp.einsum('nef,efd->nd', hid * comb[:, gi, :, None], w_down[gi])
    return y


def setup_inputs(seed: int = 0) -> dict:
    key = jax.random.key(seed)
    ks = iter(jax.random.split(key, 40))
    D, G, E, F = D_MODEL, N_GROUPS, EXPERTS_PER_GROUP, D_EXPERT

    def nrm(shape, s):
        return s * jax.random.normal(next(ks), shape, jnp.float32)

    return {
        'x': nrm((BATCH, SEQ, D), 1.0),
        'c': nrm((BATCH, D), 1.0),
        'ctx': nrm((BATCH, CTX_LEN, D), 1.0),
        'c_ctx': nrm((D,), 1.0),
        'norm1_gain': 1.0 + nrm((DEPTH, D), 0.02),
        'norm2_gain': 1.0 + nrm((DEPTH, D), 0.02),
        'w_ada': nrm((DEPTH, D, 6 * D), 0.5 * D ** -0.5),
        'b_ada': nrm((DEPTH, 6 * D), 0.02),
        'w_in': nrm((DEPTH, D, P_TOTAL), D ** -0.5),
        'w_out': nrm((DEPTH, MIX_WIDTH, D), MIX_WIDTH ** -0.5),
        'hgrn_lb_logits': nrm((2, DEPTH, A_WIDTH), 0.5),
        'hgrn_gn_gain': 1.0 + nrm((DEPTH, A_HEADS, HEAD_DIM), 0.02),
        'rwkv_mu': jax.random.uniform(next(ks), (DEPTH, B_PROJ), jnp.float32, 0.0, 1.0),
        'rwkv_w0': -1.5 + nrm((DEPTH, 2, B_WIDTH), 0.5),
        'rwkv_w_up': nrm((DEPTH, 2, RWKV_W_RANK, B_WIDTH), RWKV_W_RANK ** -0.5),
        'rwkv_a0': nrm((DEPTH, 2, B_WIDTH), 0.1),
        'rwkv_a_up': nrm((DEPTH, 2, RWKV_A_RANK, B_WIDTH), RWKV_A_RANK ** -0.5),
        'rwkv_g_up': nrm((DEPTH, RWKV_G_RANK, B_WIDTH), RWKV_G_RANK ** -0.5),
        'rwkv_kk_scale': 0.85 + nrm((DEPTH, B_WIDTH), 0.02),
        'rwkv_k_a': 1.0 + nrm((DEPTH, B_WIDTH), 0.02),
        'rwkv_r_k': nrm((DEPTH, B_HEADS, HEAD_DIM), 0.1),
        'rwkv_ln_gain': 1.0 + nrm((DEPTH, B_WIDTH), 0.02),
        'rwkv_ln_bias': nrm((DEPTH, B_WIDTH), 0.02),
        'na_q_gain': 1.0 + nrm((DEPTH, HEAD_DIM), 0.02),
        'na_k_gain': 1.0 + nrm((DEPTH, HEAD_DIM), 0.02),
        'na_rpb': nrm((DEPTH, C_HEADS, 2 * NA_WIN_ROWS - 1, 2 * NA_WIN_COLS - 1), 0.1),
        'w_router_group': nrm((DEPTH, D, G), D ** -0.5),
        'b_router_group': nrm((DEPTH, G), 0.01),
        'w_router_expert': nrm((DEPTH, D, G * E), D ** -0.5),
        'b_router_expert': nrm((DEPTH, G * E), 0.01),
        'w_exp_gate': nrm((DEPTH, G, E, D, F), D ** -0.5),
        'w_exp_up': nrm((DEPTH, G, E, D, F), D ** -0.5),
        'w_exp_down': nrm((DEPTH, G, E, F, D), F ** -0.5),
    }


def reference(x, c, ctx, c_ctx, norm1_gain, norm2_gain, w_ada, b_ada, w_in, w_out,
              hgrn_lb_logits, hgrn_gn_gain, rwkv_mu, rwkv_w0, rwkv_w_up, rwkv_a0, rwkv_a_up,
              rwkv_g_up, rwkv_kk_scale, rwkv_k_a, rwkv_r_k, rwkv_ln_gain, rwkv_ln_bias,
              na_q_gain, na_k_gain, na_rpb, w_router_group, b_router_group,
              w_router_expert, b_router_expert, w_exp_gate, w_exp_up, w_exp_down):
    f32 = jnp.float32
    bsz, t_lat, _ = x.shape
    n_ctx = ctx.shape[1]
    pos = jnp.arange(t_lat)
    pos_r = (pos // GRID_W).astype(f32)
    pos_c = (pos % GRID_W).astype(f32)
    lb_p = jax.nn.softmax(hgrn_lb_logits.astype(f32), axis=1)
    lower_bounds = jnp.cumsum(lb_p, axis=1) - lb_p[:, :1]
    silu_c = jax.nn.silu(c.astype(f32))
    silu_cc = jax.nn.silu(c_ctx.astype(f32))
    xl = x.astype(f32)
    xc = ctx.astype(f32)
    for layer in range(DEPTH):
        last = layer == DEPTH - 1
        mod_l = (silu_c @ w_ada[layer] + b_ada[layer])[:, None, :]
        mod_c = (silu_cc @ w_ada[layer] + b_ada[layer])[None, None, :]
        sh1l, sc1l, g1l, sh2l, sc2l, g2l = jnp.split(mod_l, 6, axis=-1)
        sh1c, sc1c, g1c, sh2c, sc2c, g2c = jnp.split(mod_c, 6, axis=-1)
        hl = rms_norm(xl, norm1_gain[layer]) * (1.0 + sc1l) + sh1l
        hc = rms_norm(xc, norm1_gain[layer]) * (1.0 + sc1c) + sh1c
        pl = hl @ w_in[layer]
        pc = hc @ w_in[layer]
        al, bl, cl = jnp.split(pl, [A_PROJ, A_PROJ + B_PROJ], axis=-1)
        ac, bc, cc = jnp.split(pc, [A_PROJ, A_PROJ + B_PROJ], axis=-1)
        a_lat, a_ctx = hgrn2_mixer(ac, al, lower_bounds[0, layer], lower_bounds[1, layer], hgrn_gn_gain[layer])
        b_lat, b_ctx = rwkv7_mixer(bc, bl, rwkv_mu[layer], rwkv_w0[layer], rwkv_w_up[layer], rwkv_a0[layer],
                                   rwkv_a_up[layer], rwkv_g_up[layer], rwkv_kk_scale[layer], rwkv_k_a[layer],
                                   rwkv_r_k[layer], rwkv_ln_gain[layer], rwkv_ln_bias[layer])
        c_lat, c_ctxo = neighbourhood_attention(cc, cl, na_q_gain[layer], na_k_gain[layer], na_rpb[layer],
                                                pos_r, pos_c, not last)
        xl = xl + g1l * (jnp.concatenate([a_lat, b_lat, c_lat], axis=-1) @ w_out[layer])
        h2l = (rms_norm(xl, norm2_gain[layer]) * (1.0 + sc2l) + sh2l).reshape(-1, D_MODEL)
        moe_w = (w_router_group[layer], b_router_group[layer], w_router_expert[layer], b_router_expert[layer],
                 w_exp_gate[layer], w_exp_up[layer], w_exp_down[layer])
        if last:
            xl = xl + g2l * hierarchical_moe(h2l, *moe_w).reshape(xl.shape)
        else:
            xc = xc + g1c * (jnp.concatenate([a_ctx, b_ctx, c_ctxo], axis=-1) @ w_out[layer])
            h2c = (rms_norm(xc, norm2_gain[layer]) * (1.0 + sc2c) + sh2c).reshape(-1, D_MODEL)
            y = hierarchical_moe(jnp.concatenate([h2c, h2l], axis=0), *moe_w)
            xc = xc + g2c * y[:bsz * n_ctx].reshape(xc.shape)
            xl = xl + g2l * y[bsz * n_ctx:].reshape(xl.shape)
    return xl.astype(x.dtype)
```

```cpp
#include <hip/hip_runtime.h>
#include <cstdio>
#include <cstdint>

#ifndef MK_SPLIT
#define MK_SPLIT 0
#endif

#ifndef REP_PHASE
#define REP_PHASE -1
#endif

#define LAS __attribute__((address_space(3)))
typedef unsigned short bf16_t;
typedef short  bf16x8 __attribute__((ext_vector_type(8)));
typedef short  bf16x4 __attribute__((ext_vector_type(4)));
typedef float  f32x4  __attribute__((ext_vector_type(4)));
typedef unsigned u32x4 __attribute__((ext_vector_type(4)));
typedef unsigned u32x2 __attribute__((ext_vector_type(2)));

constexpr int D = 1024, NB = 8, SEQ = 2048, CTX = 256, TPB = 2304, MTOK = NB * TPB, DEPTH = 4, PT = 3968;
constexpr int NEXP = 32, DF = 512, HIDROWS = 45056;
constexpr int NBLK16 = TPB / 16;
constexpr int PA_Q = 0, PA_FF = 256, PA_FB = 512, PA_I = 768, PA_G = 1024, PB0 = 1280, PC_Q = 2432, PC_K = 2944, PC_V = 3456;

constexpr size_t WS_CTL = 0, CTL_BYTES = 65536;
constexpr size_t WS_MOD = 65536;
constexpr size_t WS_LB = WS_MOD + 884736;
constexpr size_t WS_ROPE = WS_LB + 8192;
constexpr size_t WS_LORA = WS_ROPE + 8192;
constexpr size_t LORA_L = 196608;
constexpr size_t WS_ROUTE = WS_LORA + 4 * LORA_L;
constexpr size_t WS_LIST = WS_ROUTE + 294912;
constexpr size_t WS_LISTW = WS_LIST + 2359296;
constexpr size_t WS_WIN = 8388608;
constexpr size_t WS_WOUT = WS_WIN + 33554432;
constexpr size_t WS_W1 = WS_WOUT + 8388608;
constexpr size_t WS_W2 = WS_W1 + 67108864;
constexpr size_t WS_X = WS_W2 + 33554432;
constexpr size_t WS_H = WS_X + 75497472;
constexpr size_t WS_MIX = WS_H + 37748736;
constexpr size_t WS_P = WS_MIX + 37748736;
constexpr size_t WS_MR = WS_P + 146276352;
constexpr size_t SZ_T512 = 18874368;
constexpr size_t WS_QN = WS_MR, WS_KN = WS_QN + SZ_T512, WS_VT = WS_KN + SZ_T512;
constexpr size_t WS_QIN = WS_VT + SZ_T512;
constexpr size_t WS_KOT = WS_QIN + SZ_T512;
constexpr size_t WS_IT = WS_KOT + SZ_T512;
constexpr size_t WS_DEC = WS_IT + 9437184;
constexpr size_t WS_O1 = WS_DEC + 2359296;
constexpr size_t WS_O2 = WS_O1 + SZ_T512;
constexpr size_t WS_RW = WS_O2 + 2 * SZ_T512;
constexpr size_t WS_G = WS_RW + 226492416;
constexpr size_t WS_BON = WS_G + SZ_T512;
constexpr size_t WS_YS = WS_BON + SZ_T512;
constexpr size_t WS_END = WS_YS + 2 * SZ_T512;
constexpr size_t WS_Y = WS_P, WS_HID = WS_MR;
constexpr size_t WS_KHT = WS_END;
constexpr size_t WS_AHT = WS_KHT + 18874368;
constexpr size_t WS_GC = WS_AHT + 18874368;
constexpr size_t WS_RH = WS_GC + 2359296;
constexpr size_t WS_WY = WS_RH + 18874368;
constexpr size_t WS_END2 = WS_WY + 4718592;
constexpr size_t WS_ZT = WS_H;
constexpr size_t WS_VT2 = WS_H + 18874368;
static_assert(WS_END2 < (size_t)1000 * 1000 * 1000, "workspace");
constexpr int CW_CNT = 4096;
constexpr int CW_CVT = 12288;
constexpr int CW_ATT = 8192;

constexpr int LDS_BYTES = 163840, MISC_OFF = 131072;

#define XB_TMO      128
#define XB_XCNT(j)  (256  + 64 * (j))
#define XB_XSUB(j)  (1280 + 64 * (j))
#define XB_XGEN(j)  (2304 + 64 * (j))
#define XB_TOP      3328
#define XB_TOPGEN   3392
#define XCD_BAR_WORDS 3456
#define XB_SPIN_CAP (1u << 18)
__device__ __forceinline__ unsigned xb_ld(unsigned* p)              { return __hip_atomic_load(p, __ATOMIC_RELAXED, __HIP_MEMORY_SCOPE_AGENT); }
__device__ __forceinline__ unsigned xb_add(unsigned* p, unsigned v) { return __hip_atomic_fetch_add(p, v, __ATOMIC_RELAXED, __HIP_MEMORY_SCOPE_AGENT); }
__device__ __forceinline__ unsigned xb_xcc_id() { return (unsigned)__builtin_amdgcn_s_getreg((3 << 11) | 20) & 0xFu; }
#define XB_SPIN(cond, bar) do { unsigned _sp = 0; while (cond) { __builtin_amdgcn_s_sleep(1); \
    if ((++_sp & 255u) == 0u) { if (xb_ld(&(bar)[XB_TMO])) break; if (_sp > XB_SPIN_CAP) { atomicAdd(&(bar)[XB_TMO], 1u); break; } } } } while (0)
struct XcdBarrier { unsigned* bar; unsigned x; volatile LAS unsigned* st; };
__device__ __forceinline__ XcdBarrier xcd_barrier_post(unsigned* bar, volatile LAS unsigned* st, const unsigned tidx) {
    XcdBarrier b; b.bar = bar; b.x = xb_xcc_id(); b.st = st;
    if (tidx == 0) (void)xb_add(&bar[XB_XCNT(b.x)], 1u);
    return b;
}
__device__ __forceinline__ void xcd_barrier_complete(unsigned* bar, unsigned x, unsigned& nloc, unsigned& nx) {
    const unsigned G = gridDim.x * gridDim.y * gridDim.z;
    unsigned sum, cnt, mine, sp = 0u;
    for (;;) {
        sum = 0u; cnt = 0u; mine = 0u;
#pragma unroll
        for (unsigned j = 0; j < 16; ++j) { const unsigned c = xb_ld(&bar[XB_XCNT(j)]); sum += c; cnt += (c > 0u) ? 1u : 0u; mine = (j == x) ? c : mine; }
        if (sum == G) break;
        __builtin_amdgcn_s_sleep(1);
        if ((++sp & 255u) == 0u) { if (xb_ld(&bar[XB_TMO])) break; if (sp > XB_SPIN_CAP) { atomicAdd(&bar[XB_TMO], 1u); break; } }
    }
    nloc = mine > 0u ? mine : 1u; nx = cnt > 0u ? cnt : 1u;
}
__device__ __forceinline__ void xcd_barrier(const XcdBarrier& b, const unsigned tidx) {
    asm volatile("s_waitcnt vmcnt(0)" ::: "memory");
    __syncthreads();
    if (tidx == 0) {
        unsigned* bar = b.bar;
        __builtin_amdgcn_s_waitcnt(0);
        unsigned nloc = b.st[0], nx = b.st[1];
        if (nloc == 0u) { xcd_barrier_complete(bar, b.x, nloc, nx); b.st[0] = nloc; b.st[1] = nx; }
        const unsigned old = xb_add(&bar[XB_XSUB(b.x)], 1u);
        const unsigned gen = old / nloc;
        if (old + 1u == (gen + 1u) * nloc) {
            __builtin_amdgcn_fence(__ATOMIC_RELEASE, "agent");
            asm volatile("s_waitcnt vmcnt(0)" ::: "memory");
            const unsigned og = xb_add(&bar[XB_TOP], 1u);
            const unsigned tg = og / nx;
            if (og + 1u == (tg + 1u) * nx) xb_add(&bar[XB_TOPGEN], 1u);
            else XB_SPIN(xb_ld(&bar[XB_TOPGEN]) == tg, bar);
            __builtin_amdgcn_fence(__ATOMIC_ACQUIRE, "agent");
            xb_add(&bar[XB_XGEN(b.x)], 1u);
            asm volatile("s_waitcnt vmcnt(0)" ::: "memory");
        } else {
            XB_SPIN(xb_ld(&bar[XB_XGEN(b.x)]) == gen, bar);
            __builtin_amdgcn_fence(__ATOMIC_ACQUIRE, "agent");
            asm volatile("s_waitcnt vmcnt(0)" ::: "memory");
        }
    }
    __syncthreads();
}

__device__ __forceinline__ float bf2f(bf16_t b) { return __uint_as_float(((unsigned)b) << 16); }
__device__ __forceinline__ float bflo(unsigned u) { return __uint_as_float(u << 16); }
__device__ __forceinline__ float bfhi(unsigned u) { return __uint_as_float(u & 0xffff0000u); }
typedef float f32x2c __attribute__((ext_vector_type(2)));
typedef __bf16 bf16x2c __attribute__((ext_vector_type(2)));
__device__ __forceinline__ unsigned pk2(float lo, float hi) { const f32x2c v = {lo, hi}; const bf16x2c b = __builtin_convertvector(v, bf16x2c); return __builtin_bit_cast(unsigned, b); }
__device__ __forceinline__ unsigned pk2m(float lo, float hi) { return pk2(lo, hi); }
__device__ __forceinline__ bf16_t f2bf(float f) { return (bf16_t)pk2(f, f); }
__device__ __forceinline__ float sigm(float x) { return 1.f / (1.f + __expf(-x)); }
template <int CTRL> __device__ __forceinline__ float dppf(float x) { return __int_as_float(__builtin_amdgcn_update_dpp(0, __float_as_int(x), CTRL, 0xF, 0xF, true)); }
__device__ __forceinline__ float red4(float x) { x += dppf<0xB1>(x); x += dppf<0x4E>(x); return x; }
__device__ __forceinline__ float red8(float x) { x = red4(x); x += dppf<0x141>(x); return x; }
__device__ __forceinline__ float red16(float x) { x = red8(x); x += dppf<0x140>(x); return x; }
__device__ __forceinline__ int lane_now() { int t; asm volatile("v_mbcnt_lo_u32_b32 %0, -1, 0\n\tv_mbcnt_hi_u32_b32 %0, -1, %0" : "=v"(t)); return t; }
__device__ __forceinline__ float shx(float x, int m) { return __int_as_float(__builtin_amdgcn_ds_bpermute((lane_now() ^ m) << 2, __float_as_int(x))); }
__device__ __forceinline__ float shidx(float x, int idx) { return __int_as_float(__builtin_amdgcn_ds_bpermute(idx << 2, __float_as_int(x))); }
__device__ __forceinline__ float red64(float x) { x = red16(x); x += shx(x, 16); x += shx(x, 32); return x; }

#if defined(__HIP_DEVICE_COMPILE__)
#define GAS __attribute__((address_space(1)))
#else
#define GAS
#endif
struct InPtrs { const GAS float* p[33]; };
struct Args { InPtrs in; GAS float* out; GAS unsigned char* ws; int lo, hi; };
struct InView {
    const __attribute__((address_space(4))) Args* a;
    __device__ __forceinline__ const float* operator[](int i) const { return (const float*)a->in.p[i]; }
};
struct ArgView { InView in; __device__ __forceinline__ const ArgView* operator->() const { return this; } };
#define MEMBAR() asm volatile("" ::: "memory")
struct Ctx {
    ArgView a; float* out; GAS unsigned char* ws; LAS unsigned char* lds;
    int tid, lane, wave, bid, G;
    template <class T> __device__ __forceinline__ T* w(size_t off) const { return (T*)(ws + off); }
};

namespace pg8 {
constexpr int MISC_OFF = 131072; constexpr int BM = 256, BK = 64, HALF = 128, HTB = HALF * BK * 2, STAGE_BYTES = 8 * HTB, NXCD = 8, WGM = 8;
__device__ __forceinline__ int lds_byte(int r, int c) { const int st = (r >> 4) * 2 + (c >> 5), rr = r & 15, cc = c & 31, ob = rr * 64 + cc * 2; return st * 1024 + (ob ^ (((ob >> 9) & 1) << 5)); }
__device__ __forceinline__ void stage_rc(int b, int& R, int& C) { const int st = b / 1024, sb = b % 1024, swz = sb ^ (((sb >> 9) & 1) << 5); R = (st >> 1) * 16 + swz / 64; C = (st & 1) * 32 + (swz % 64) / 2; }
__device__ __forceinline__ int perm32(int rho) { const int n = rho >> 4, i = rho & 15; return 8 * (i >> 2) + 4 * n + (i & 3); }
struct Unit { int pm, pn, e, mt, cnt; };

struct StaticOrder {
    static constexpr bool GATHER_A = false;
    const char* A; const char* Bt; int K; int nM, nN, nwg, G, c; bool skip_ctx;
    __device__ __forceinline__ void init(const void* A_, const void* Bt_, int M, int N, int K_, int G_, int c_, bool skip_ctx_ = false) { A = (const char*)A_; Bt = (const char*)Bt_; K = K_; skip_ctx = skip_ctx_; nM = skip_ctx_ ? 64 : M / BM; nN = N / BM; nwg = nM * nN; G = G_; c = c_; }
    __device__ __forceinline__ bool next(int i, Unit& u) const {
        const long L = (long)i * G + c; if (L >= nwg) return false;
        int wgid = (int)L; { const int q = nwg / NXCD, r = nwg % NXCD, xcd = wgid % NXCD, off = wgid / NXCD; wgid = (xcd < r ? xcd * (q + 1) : r * (q + 1) + (xcd - r) * q) + off; }
        const int nig = WGM * nN, gid = wgid / nig, fm = gid * WGM, gsz = (nM - fm) < WGM ? (nM - fm) : WGM;
        u.pm = fm + ((wgid % nig) % gsz); u.pn = (wgid % nig) / gsz; u.e = 0; u.mt = 0; u.cnt = 0;
        if (skip_ctx) u.pm = u.pm + (u.pm >> 3) + 1;
        return true;
    }
    __device__ __forceinline__ const char* a_base(const Unit& u) const { return A + (size_t)u.pm * BM * K * 2; }
    __device__ __forceinline__ const char* b_base(const Unit& u) const { return Bt + (size_t)u.pn * BM * K * 2; }
    __device__ __forceinline__ void a_offs(const Unit&, int tid, unsigned (&vo)[2][2]) const {
#pragma unroll
        for (int i = 0; i < 2; ++i) { int R, C; stage_rc(tid * 16 + i * 8192, R, C);
#pragma unroll
            for (int h = 0; h < 2; ++h) vo[h][i] = (unsigned)((h * HALF + R) * K + C) * 2u; }
    }
};
template <bool GATHER> struct MoeOrder {
    static constexpr bool GATHER_A = GATHER;
    const char* A; const char* Bt; int K; const int* list; const LAS int* tp; const LAS int* cn; int G, c;
    __device__ __forceinline__ bool next(int i, Unit& u) const {
        if ((G & 7) == 0) {
            const int xcd = c & 7; int j = i * (G >> 3) + (c >> 3);
#pragma unroll 1
            for (int q = 0; q < 4; ++q) { const int e = xcd + 8 * q; const int t0 = __builtin_amdgcn_readfirstlane(tp[e]), t1 = __builtin_amdgcn_readfirstlane(tp[e + 1]); const int nu = 4 * (t1 - t0);
                if (j < nu) { u.e = e; u.mt = j >> 2; u.pn = j & 3; u.pm = t0 + u.mt; u.cnt = __builtin_amdgcn_readfirstlane(cn[e]); return true; }
                j -= nu; }
            return false;
        }
        const int L = i * G + c; if (L >= 4 * __builtin_amdgcn_readfirstlane(tp[32])) return false;
        const int tile = L >> 2; u.pn = L & 3; u.pm = tile;
        int e = 0;
#pragma unroll 1
        for (; e < 31; ++e) if (tile < __builtin_amdgcn_readfirstlane(tp[e + 1])) break;
        u.e = e; u.mt = tile - __builtin_amdgcn_readfirstlane(tp[e]); u.cnt = __builtin_amdgcn_readfirstlane(cn[e]); return true;
    }
    __device__ __forceinline__ const char* a_base(const Unit& u) const { return GATHER ? A : A + (size_t)u.pm * BM * K * 2; }
    __device__ __forceinline__ const char* b_base(const Unit& u) const { return Bt + ((size_t)u.e * 1024 + (size_t)u.pn * BM) * K * 2; }
    __device__ __forceinline__ void a_offs(const Unit& u, int tid, unsigned (&vo)[2][2]) const {
#pragma unroll
        for (int i = 0; i < 2; ++i) { int R, C; stage_rc(tid * 16 + i * 8192, R, C);
#pragma unroll
            for (int h = 0; h < 2; ++h) {
                int row = h * HALF + R;
                if (GATHER) { const int idx = u.mt * BM + row; row = idx < u.cnt ? list[(size_t)u.e * MTOK + idx] : 0; }
                vo[h][i] = (unsigned)(row * K + C) * 2u;
            } }
    }
};

struct EpiBf16Rows {
    static constexpr bool PERM = true;
    bf16_t* O; int ldc; int ncols;
    __device__ __forceinline__ void operator()(const f32x4 (&acc)[2][2][4][2], const Unit& u, int wr, int wc, int fr, int fq) const {
        const int row0 = u.pm * BM + wr * 64 + fr, col0 = u.pn * BM + wc * 32 + 8 * fq;
#pragma unroll
        for (int ai = 0; ai < 2; ++ai)
#pragma unroll
            for (int m = 0; m < 4; ++m) { bf16_t* rowp = O + (size_t)(row0 + ai * HALF + m * 16) * ldc + col0;
#pragma unroll
                for (int bj = 0; bj < 2; ++bj) { if (u.pn * BM + bj * HALF >= ncols) continue;
                    const f32x4 v0 = acc[ai][bj][m][0], v1 = acc[ai][bj][m][1];
                    u32x4 w; w.x = pk2(v0[0], v0[1]); w.y = pk2(v0[2], v0[3]); w.z = pk2(v1[0], v1[1]); w.w = pk2(v1[2], v1[3]);
                    *(u32x4*)(rowp + bj * HALF) = w; } }
    }
};
struct EpiX {
    static constexpr bool PERM = false;
    float* X; const float* gate;
    __device__ __forceinline__ void operator()(const f32x4 (&acc)[2][2][4][2], const Unit& u, int wr, int wc, int fr, int fq) const {
        const int row0 = u.pm * BM + wr * 64 + fr, col0 = u.pn * BM + wc * 32 + 4 * fq;
        const int bb = u.pm / 9, mrow = (u.pm - bb * 9 == 0) ? 8 : bb;
        const float* g = gate + (size_t)mrow * 6144 + col0;
        f32x4 gv[2][2];
#pragma unroll
        for (int bj = 0; bj < 2; ++bj)
#pragma unroll
            for (int n = 0; n < 2; ++n) gv[bj][n] = *(const f32x4*)(g + bj * HALF + n * 16);
#pragma unroll
        for (int ai = 0; ai < 2; ++ai)
#pragma unroll
            for (int m = 0; m < 4; ++m) { float* rowp = X + (size_t)(row0 + ai * HALF + m * 16) * D + col0;
#pragma unroll
                for (int bj = 0; bj < 2; ++bj)
#pragma unroll
                    for (int n = 0; n < 2; ++n) { f32x4* p = (f32x4*)(rowp + bj * HALF + n * 16); *p = *p + gv[bj][n] * acc[ai][bj][m][n]; } }
    }
};
struct EpiHid {
    static constexpr bool PERM = true;
    bf16_t* O; const float* listw;
    __device__ __forceinline__ void operator()(const f32x4 (&acc)[2][2][4][2], const Unit& u, int wr, int wc, int fr, int fq) const {
        const int col0 = u.pn * HALF + wc * 32 + 8 * fq;
#pragma unroll
        for (int ai = 0; ai < 2; ++ai)
#pragma unroll
            for (int m = 0; m < 4; ++m) {
                const int r = ai * HALF + wr * 64 + m * 16 + fr, idx = u.mt * BM + r;
                const float w = idx < u.cnt ? listw[(size_t)u.e * MTOK + idx] : 0.f;
                const f32x4 g0 = acc[ai][0][m][0], g1 = acc[ai][0][m][1], u0 = acc[ai][1][m][0], u1 = acc[ai][1][m][1];
                float h[8];
#pragma unroll
                for (int j = 0; j < 4; ++j) { h[j] = g0[j] * sigm(g0[j]) * u0[j] * w; h[4 + j] = g1[j] * sigm(g1[j]) * u1[j] * w; }
                u32x4 o; o.x = pk2(h[0], h[1]); o.y = pk2(h[2], h[3]); o.z = pk2(h[4], h[5]); o.w = pk2(h[6], h[7]);
                *(u32x4*)(O + (size_t)(u.pm * BM + r) * DF + col0) = o;
                asm volatile("" ::: "memory"); }
    }
};

template <class Epi, class Sched>
__device__ __forceinline__ void gemm_phase(LAS unsigned char* lds, const int tid, const Sched& S, const Epi& E) {
    const int wid = __builtin_amdgcn_readfirstlane(tid >> 6), lane = tid & 63, wr = wid >> 2, wc = wid & 3, fr = lane & 15, fq = lane >> 4;
    const int K = S.K, nt = K / BK;
    unsigned voffB[2];
#pragma unroll
    for (int i = 0; i < 2; ++i) { int Rr, Cc; stage_rc(tid * 16 + i * 8192, Rr, Cc); const int Rb = Epi::PERM ? ((Rr & ~31) + perm32(Rr & 31)) : Rr; voffB[i] = (unsigned)(Rb * K + Cc) * 2u; }
    const size_t kstep = (size_t)(BK * 2);
    const size_t hstep = (size_t)HALF * K * 2;
    const unsigned ldsw = (unsigned)wid * 1024u;
    const int aoff = lds_byte(wr * 64 + fr, fq * 8), boff = lds_byte(wc * 32 + fr, fq * 8);
#define PG8_SA(b, h) (((b) * 2 + (h)) * HTB)
#define PG8_SB(b, h) ((4 + (b) * 2 + (h)) * HTB)
#define PG8_STAGE2(bufoff, gbase, o0, o1) do { \
        __builtin_amdgcn_global_load_lds((const unsigned*)((const char*)(gbase) + (o0)), (LAS unsigned*)(lds + (bufoff) + ldsw), 16, 0, 0); \
        __builtin_amdgcn_global_load_lds((const unsigned*)((const char*)(gbase) + (o1)), (LAS unsigned*)(lds + (bufoff) + ldsw + 8192), 16, 0, 0); } while (0)
#define PG8_STAGEB(bufoff, gbase) PG8_STAGE2(bufoff, gbase, voffB[0], voffB[1])
#define PG8_LDA(dst, b, h) do { _Pragma("unroll") for (int m = 0; m < 4; ++m) _Pragma("unroll") for (int k = 0; k < 2; ++k) dst[m][k] = *(const LAS bf16x8*)(lds + PG8_SA(b, h) + aoff + m * 2048 + k * 1024); } while (0)
#define PG8_LDB(dst, b, h) do { _Pragma("unroll") for (int n = 0; n < 2; ++n) _Pragma("unroll") for (int k = 0; k < 2; ++k) dst[n][k] = *(const LAS bf16x8*)(lds + PG8_SB(b, h) + boff + n * 2048 + k * 1024); } while (0)
#define PG8_MMA(ai, bj, At, Bt) do { __builtin_amdgcn_s_setprio(1); _Pragma("unroll") for (int m = 0; m < 4; ++m) _Pragma("unroll") for (int n = 0; n < 2; ++n) _Pragma("unroll") for (int k = 0; k < 2; ++k) \
        acc[ai][bj][m][n] = __builtin_amdgcn_mfma_f32_16x16x32_bf16(Bt[n][k], At[m][k], acc[ai][bj][m][n], 0, 0, 0); __builtin_amdgcn_s_setprio(0); } while (0)
#define PG8_WAIT_V(n) asm volatile("s_waitcnt vmcnt(" #n ")" ::: "memory")
#define PG8_WAIT_L(n) asm volatile("s_waitcnt lgkmcnt(" #n ")" ::: "memory")
#define PG8_BAR __builtin_amdgcn_s_barrier()
#define PG8_SCHED __builtin_amdgcn_sched_barrier(0)
    Unit cur, nxt; int ui = 0;
    if (!S.next(0, cur)) return;
    f32x4 acc[2][2][4][2];
#pragma unroll
    for (int a = 0; a < 2; ++a)
#pragma unroll
        for (int b = 0; b < 2; ++b)
#pragma unroll
            for (int m = 0; m < 4; ++m)
#pragma unroll
                for (int n = 0; n < 2; ++n) acc[a][b][m][n] = (f32x4){0.f, 0.f, 0.f, 0.f};
    bf16x8 At[4][2], B0[2][2], B1[2][2];
    unsigned vo[2][2];
    LAS u32x4* stash = (LAS u32x4*)(lds + MISC_OFF + 1024) + tid;
    S.a_offs(cur, tid, vo);
    const char* cA = S.a_base(cur); const char* cB = S.b_base(cur);
    PG8_STAGEB(PG8_SB(0, 0), cB); PG8_STAGE2(PG8_SA(0, 0), cA, vo[0][0], vo[0][1]); PG8_STAGEB(PG8_SB(0, 1), cB + hstep); PG8_STAGE2(PG8_SA(0, 1), cA, vo[1][0], vo[1][1]);
    if (wr == 1) PG8_BAR;
    PG8_WAIT_V(4); PG8_BAR;
    PG8_STAGEB(PG8_SB(1, 0), cB + kstep); PG8_STAGE2(PG8_SA(1, 0), cA + kstep, vo[0][0], vo[0][1]); PG8_STAGEB(PG8_SB(1, 1), cB + hstep + kstep);
    PG8_WAIT_V(6); PG8_BAR;
    for (;;) {
        const bool has_next = S.next(ui + 1, nxt);
        const char* nA = cA; const char* nB = cB;
        if (has_next) { nA = S.a_base(nxt); nB = S.b_base(nxt); }
        if constexpr (Sched::GATHER_A) { unsigned nvo[2][2];
            if (has_next) S.a_offs(nxt, tid, nvo); else { nvo[0][0] = vo[0][0]; nvo[0][1] = vo[0][1]; nvo[1][0] = vo[1][0]; nvo[1][1] = vo[1][1]; }
            *stash = (u32x4){nvo[0][0], nvo[0][1], nvo[1][0], nvo[1][1]}; }
        for (int t = 0; t < nt; t += 2) {
            const bool last = (t == nt - 2);
            const char* a1 = cA + (size_t)(t + 1) * kstep;
            const char* a2 = last ? nA : cA + (size_t)(t + 2) * kstep; const char* b2 = last ? nB : cB + (size_t)(t + 2) * kstep;
            const char* a3 = a2 + kstep; const char* b3 = b2 + kstep;
            unsigned s00 = vo[0][0], s01 = vo[0][1], s10 = vo[1][0], s11 = vo[1][1];
            if constexpr (Sched::GATHER_A) { if (last) { const u32x4 nv = *stash; s00 = nv.x; s01 = nv.y; s10 = nv.z; s11 = nv.w; } }
            PG8_LDB(B0, 0, 0); PG8_SCHED; PG8_LDA(At, 0, 0); PG8_STAGE2(PG8_SA(1, 1), a1, vo[1][0], vo[1][1]);
            PG8_WAIT_L(8); PG8_BAR; PG8_WAIT_L(0); PG8_MMA(0, 0, At, B0); PG8_BAR; PG8_SCHED;
            PG8_LDB(B1, 0, 1); PG8_STAGEB(PG8_SB(0, 0), b2);
            PG8_BAR; PG8_WAIT_L(0); PG8_MMA(0, 1, At, B1); PG8_BAR;
            PG8_LDA(At, 0, 1); PG8_STAGE2(PG8_SA(0, 0), a2, s00, s01);
            PG8_BAR; PG8_WAIT_L(0); PG8_MMA(1, 0, At, B0); PG8_BAR; PG8_SCHED;
            PG8_STAGEB(PG8_SB(0, 1), b2 + hstep);
            PG8_WAIT_V(6); PG8_BAR; PG8_MMA(1, 1, At, B1); PG8_BAR;
            PG8_LDB(B0, 1, 0); PG8_SCHED; PG8_LDA(At, 1, 0); PG8_STAGE2(PG8_SA(0, 1), a2, s10, s11);
            PG8_WAIT_L(8); PG8_BAR; PG8_WAIT_L(0); PG8_MMA(0, 0, At, B0); PG8_BAR; PG8_SCHED;
            PG8_LDB(B1, 1, 1); PG8_STAGEB(PG8_SB(1, 0), b3);
            PG8_BAR; PG8_WAIT_L(0); PG8_MMA(0, 1, At, B1); PG8_BAR;
            PG8_LDA(At, 1, 1); PG8_STAGE2(PG8_SA(1, 0), a3, s00, s01);
            PG8_BAR; PG8_WAIT_L(0); PG8_MMA(1, 0, At, B0); PG8_BAR; PG8_SCHED;
            PG8_STAGEB(PG8_SB(1, 1), b3 + hstep);
            PG8_WAIT_V(6); PG8_BAR; PG8_MMA(1, 1, At, B1); PG8_BAR;
        }
        E(acc, cur, wr, wc, fr, fq);
        if (!has_next) break;
#pragma unroll
        for (int a = 0; a < 2; ++a)
#pragma unroll
            for (int b = 0; b < 2; ++b)
#pragma unroll
                for (int m = 0; m < 4; ++m)
#pragma unroll
                    for (int n = 0; n < 2; ++n) acc[a][b][m][n] = (f32x4){0.f, 0.f, 0.f, 0.f};
        cur = nxt; cA = nA; cB = nB; ++ui;
        if constexpr (Sched::GATHER_A) { const u32x4 nv = *stash; vo[0][0] = nv.x; vo[0][1] = nv.y; vo[1][0] = nv.z; vo[1][1] = nv.w; }
    }
    PG8_WAIT_V(0);
    if (wr == 0) PG8_BAR;
    PG8_BAR;
#undef PG8_SA
#undef PG8_SB
#undef PG8_STAGE2
#undef PG8_STAGEB
#undef PG8_LDA
#undef PG8_LDB
#undef PG8_MMA
#undef PG8_WAIT_V
#undef PG8_WAIT_L
#undef PG8_BAR
#undef PG8_SCHED
}
}

__device__ __forceinline__ void cvt_tile(const Ctx& c, LAS float* T, const float* src, int src_ld, bf16_t* dst, int dst_ld) {
    const int ty = c.tid >> 4, tx = c.tid & 15;
#pragma unroll
    for (int i = 0; i < 2; ++i) { const int k = ty + 32 * i; const float4 v = *(const float4*)(src + (size_t)k * src_ld + tx * 4);
        T[k * 65 + tx * 4 + 0] = v.x; T[k * 65 + tx * 4 + 1] = v.y; T[k * 65 + tx * 4 + 2] = v.z; T[k * 65 + tx * 4 + 3] = v.w; }
    __syncthreads();
    const int tn = c.tid >> 3, tk = c.tid & 7;
    float v[8];
#pragma unroll
    for (int j = 0; j < 8; ++j) v[j] = T[(tk * 8 + j) * 65 + tn];
    u32x4 o; o.x = pk2(v[0], v[1]); o.y = pk2(v[2], v[3]); o.z = pk2(v[4], v[5]); o.w = pk2(v[6], v[7]);
    *(u32x4*)(dst + (size_t)tn * dst_ld + tk * 8) = o;
    __syncthreads();
}

struct CvtJob { const float* src; bf16_t* dst; int src_ld, dst_ld; };
__device__ __forceinline__ void cvt_tile4(const Ctx& c, LAS float* T, const CvtJob (&jb)[4]) {
    const int ty = c.tid >> 4, tx = c.tid & 15;
    float4 v[4][2];
#pragma unroll
    for (int q = 0; q < 4; ++q)
#pragma unroll
        for (int i = 0; i < 2; ++i) v[q][i] = *(const float4*)(jb[q].src + (size_t)(ty + 32 * i) * jb[q].src_ld + tx * 4);
#pragma unroll
    for (int q = 0; q < 4; ++q)
#pragma unroll
        for (int i = 0; i < 2; ++i) { LAS float* t = T + q * 4160 + (ty + 32 * i) * 65 + tx * 4; t[0] = v[q][i].x; t[1] = v[q][i].y; t[2] = v[q][i].z; t[3] = v[q][i].w; }
    __syncthreads();
    const int tn = c.tid >> 3, tk = c.tid & 7;
#pragma unroll
    for (int q = 0; q < 4; ++q) {
        float w[8];
#pragma unroll
        for (int j = 0; j < 8; ++j) w[j] = T[q * 4160 + (tk * 8 + j) * 65 + tn];
        u32x4 o; o.x = pk2(w[0], w[1]); o.y = pk2(w[2], w[3]); o.z = pk2(w[4], w[5]); o.w = pk2(w[6], w[7]);
        *(u32x4*)(jb[q].dst + (size_t)tn * jb[q].dst_ld + tk * 8) = o;
    }
    __syncthreads();
}

__device__ __forceinline__ void phase_prologue(const Ctx& c) {
    {
        LAS float* Ssm = (LAS float*)c.lds; LAS float* red = Ssm + 9 * 1024;
        for (int i = c.tid; i < 9 * 1024; i += 512) { const int r = i >> 10, k = i & 1023; const float v = r < 8 ? c.a->in[1][r * 1024 + k] : c.a->in[3][k]; Ssm[i] = v * sigm(v); }
        __syncthreads();
        float* MOD = c.w<float>(WS_MOD);
        for (int task = c.bid; task < 384; task += c.G) {
            const int l = task / 96, c0 = (task % 96) * 64, kg = c.tid >> 6, col = c.tid & 63;
            const float* wp = c.a->in[6] + ((size_t)l * 1024 + kg * 128) * 6144 + c0 + col;
            float acc[9];
#pragma unroll
            for (int r = 0; r < 9; ++r) acc[r] = 0.f;
#pragma unroll 4
            for (int k = 0; k < 128; ++k) { const float wv = wp[(size_t)k * 6144];
#pragma unroll
                for (int r = 0; r < 9; ++r) acc[r] += Ssm[r * 1024 + kg * 128 + k] * wv; }
#pragma unroll
            for (int r = 0; r < 9; ++r) red[(kg * 9 + r) * 64 + col] = acc[r];
            __syncthreads();
            for (int i = c.tid; i < 576; i += 512) { const int r = i >> 6, cc = i & 63; float s = 0.f;
#pragma unroll
                for (int k2 = 0; k2 < 8; ++k2) s += red[(k2 * 9 + r) * 64 + cc];
                MOD[((size_t)l * 9 + r) * 6144 + c0 + cc] = s + c.a->in[7][l * 6144 + c0 + cc]; }
            __syncthreads();
        }
    }
    if (c.bid == 0) {
        const int d = c.tid >> 8, ch = c.tid & 255; const float* lg = c.a->in[10] + (size_t)d * 4 * 256 + ch;
        const float a0 = lg[0], a1 = lg[256], a2 = lg[512], a3 = lg[768]; const float mx = fmaxf(fmaxf(a0, a1), fmaxf(a2, a3));
        const float e0 = expf(a0 - mx), e1 = expf(a1 - mx), e2 = expf(a2 - mx), e3 = expf(a3 - mx), inv = 1.f / (e0 + e1 + e2 + e3);
        float* LB = c.w<float>(WS_LB) + (size_t)d * 4 * 256 + ch;
        LB[0] = 0.f; LB[256] = e1 * inv; LB[512] = (e1 + e2) * inv; LB[768] = (e1 + e2 + e3) * inv;
    }
    if (c.bid == 1 % c.G) {
        float* RT = c.w<float>(WS_ROPE);
        for (int i = c.tid; i < 64 * 16; i += 512) { const int pos = i >> 4, j = i & 15; const float inv = exp2f(-(float)j * (13.287712379549449f / 16.f)); const float ang = (float)pos * inv;
            RT[i * 2] = __cosf(ang); RT[i * 2 + 1] = __sinf(ang); }
    }
    {
        __syncthreads();
        LAS float* T = (LAS float*)c.lds;
        constexpr int PER_L = 992 + 256 + 24;
        for (int task4 = c.bid; task4 < PER_L; task4 += c.G) {
            CvtJob jb[4];
#pragma unroll
            for (int q = 0; q < 4; ++q) {
                const int task = task4 * 4 + q; const int l = task / PER_L; int t = task - l * PER_L;
                if (t < 992) { const int kt = t / 62, nt = t % 62;
                    jb[q].src = c.a->in[8] + ((size_t)l * 1024 + kt * 64) * PT + nt * 64; jb[q].src_ld = PT; jb[q].dst = c.w<bf16_t>(WS_WIN) + ((size_t)l * 4096 + nt * 64) * 1024 + kt * 64; jb[q].dst_ld = 1024;
                } else if (t < 992 + 256) { t -= 992; const int kt = t >> 4, nt = t & 15;
                    jb[q].src = c.a->in[9] + ((size_t)l * 1024 + kt * 64) * 1024 + nt * 64; jb[q].src_ld = 1024; jb[q].dst = c.w<bf16_t>(WS_WOUT) + ((size_t)l * 1024 + nt * 64) * 1024 + kt * 64; jb[q].dst_ld = 1024;
                } else { t -= 992 + 256; bf16_t* lo = c.w<bf16_t>(WS_LORA + (size_t)l * LORA_L);
                    if (t < 8) { const int d = t >> 2, nt = t & 3;
                        jb[q].src = c.a->in[14] + ((size_t)(l * 2 + d) * 64) * 256 + nt * 64; jb[q].src_ld = 256; jb[q].dst = lo + (size_t)d * 16384 + (size_t)nt * 64 * 64; jb[q].dst_ld = 64;
                    } else if (t < 16) { t -= 8; const int d = t >> 2, nt = t & 3;
                        jb[q].src = c.a->in[16] + ((size_t)(l * 2 + d) * 64) * 256 + nt * 64; jb[q].src_ld = 256; jb[q].dst = lo + 32768 + (size_t)d * 16384 + (size_t)nt * 64 * 64; jb[q].dst_ld = 64;
                    } else { t -= 16; const int kt = t >> 2, nt = t & 3;
                        jb[q].src = c.a->in[17] + ((size_t)l * 128 + kt * 64) * 256 + nt * 64; jb[q].src_ld = 256; jb[q].dst = lo + 65536 + (size_t)nt * 64 * 128 + kt * 64; jb[q].dst_ld = 128;
                    }
                }
            }
            cvt_tile4(c, T, jb);
        }
        u32x4* z = c.w<u32x4>(WS_WIN);
        for (int i = c.bid * 512 + c.tid; i < 4 * 16384; i += c.G * 512) { const int l = i >> 14, o = i & 16383; z[((size_t)l * 4096 + 3968) * 128 + o] = (u32x4){0u, 0u, 0u, 0u}; }
    }
}

__device__ __forceinline__ void build_tpre(const Ctx& c, int l) {
    LAS int* tp = (LAS int*)(c.lds + MISC_OFF + 64); LAS int* cn = (LAS int*)(c.lds + MISC_OFF + 256);
    __syncthreads();
    if (c.tid < 32) cn[c.tid] = (int)__hip_atomic_load(c.w<unsigned>(WS_CTL) + CW_CNT + l * 64 + c.tid, __ATOMIC_RELAXED, __HIP_MEMORY_SCOPE_AGENT);
    __syncthreads();
    if (c.tid == 0) { int s = 0; for (int e = 0; e < 32; ++e) { tp[e] = s; s += (cn[e] + 255) >> 8; } tp[32] = s; }
    __syncthreads();
}

__device__ __forceinline__ void phase_norm1(const Ctx& c, int l) {
    LAS int* tp = (LAS int*)(c.lds + MISC_OFF + 64);
    if (l > 0) build_tpre(c, l - 1);
    const float* MOD = c.w<float>(WS_MOD); float* X = c.w<float>(WS_X); const bf16_t* Y = c.w<bf16_t>(WS_Y); bf16_t* H = c.w<bf16_t>(WS_H);
    const int4* ROUTE = c.w<int4>(WS_ROUTE);
    const int stride = c.G * 8, lane = c.lane;
    constexpr int NR = 3;
    for (int rowb = c.bid * 8 + c.wave; rowb < MTOK; rowb += NR * stride) {
        f32x4 x[NR][4]; int4 rt[NR]; bool act[NR]; int mrow[NR];
#pragma unroll
        for (int u = 0; u < NR; ++u) { const int row = rowb + u * stride; const int rr = row < MTOK ? row : rowb; const int b = rr / TPB, s = rr - b * TPB;
            act[u] = row < MTOK && !(l == DEPTH && s < CTX); mrow[u] = s < CTX ? 8 : b;
            const float* xs = l > 0 ? X + (size_t)rr * D : (s < CTX ? c.a->in[2] + ((size_t)b * CTX + s) * D : c.a->in[0] + ((size_t)b * SEQ + (s - CTX)) * D);
#pragma unroll
            for (int j = 0; j < 4; ++j) x[u][j] = *(const f32x4*)(xs + lane * 4 + 256 * j);
            rt[u] = l > 0 ? ROUTE[rr] : make_int4(0, 0, 0, 0); }
        if (l > 0) {
            u32x2 y0[NR][4], y1[NR][4];
#pragma unroll
            for (int u = 0; u < NR; ++u) { const int e0 = act[u] ? rt[u].x : 0, e1 = act[u] ? rt[u].z : 0, p0 = act[u] ? rt[u].y : 0, p1 = act[u] ? rt[u].w : 0;
                const size_t r0 = (size_t)tp[e0] * 256 + p0, r1 = (size_t)tp[e1] * 256 + p1;
#pragma unroll
                for (int j = 0; j < 4; ++j) { y0[u][j] = *(const u32x2*)(Y + r0 * D + lane * 4 + 256 * j); y1[u][j] = *(const u32x2*)(Y + r1 * D + lane * 4 + 256 * j); } }
#pragma unroll
            for (int u = 0; u < NR; ++u) { const float* g2 = MOD + ((size_t)(l - 1) * 9 + mrow[u]) * 6144 + 5120;
#pragma unroll
                for (int j = 0; j < 4; ++j) { const f32x4 g = *(const f32x4*)(g2 + lane * 4 + 256 * j);
                    x[u][j][0] += g[0] * (bflo(y0[u][j].x) + bflo(y1[u][j].x)); x[u][j][1] += g[1] * (bfhi(y0[u][j].x) + bfhi(y1[u][j].x));
                    x[u][j][2] += g[2] * (bflo(y0[u][j].y) + bflo(y1[u][j].y)); x[u][j][3] += g[3] * (bfhi(y0[u][j].y) + bfhi(y1[u][j].y)); } }
        }
#pragma unroll
        for (int u = 0; u < NR; ++u) {
            if (!act[u]) continue;
            const int row = rowb + u * stride; const int b = row / TPB, s = row - b * TPB;
            if (l == DEPTH) {
                float* o = c.out + ((size_t)b * SEQ + (s - CTX)) * D;
#pragma unroll
                for (int j = 0; j < 4; ++j) *(f32x4*)(o + lane * 4 + 256 * j) = x[u][j];
                continue;
            }
#pragma unroll
            for (int j = 0; j < 4; ++j) *(f32x4*)(X + (size_t)row * D + lane * 4 + 256 * j) = x[u][j];
            float ss = 0.f;
#pragma unroll
            for (int j = 0; j < 4; ++j) ss += x[u][j][0] * x[u][j][0] + x[u][j][1] * x[u][j][1] + x[u][j][2] * x[u][j][2] + x[u][j][3] * x[u][j][3];
            ss = red64(ss);
            const float inv = rsqrtf(ss * (1.f / 1024.f) + 1e-6f);
            const float* gain = c.a->in[4] + (size_t)l * D; const float* md = MOD + ((size_t)l * 9 + mrow[u]) * 6144;
#pragma unroll
            for (int j = 0; j < 4; ++j) { const int col = lane * 4 + 256 * j;
                const f32x4 gn = *(const f32x4*)(gain + col), sh = *(const f32x4*)(md + col), sc = *(const f32x4*)(md + 1024 + col);
                const f32x4 h = x[u][j] * inv * gn * (1.f + sc) + sh;
                u32x2 o; o.x = pk2(h[0], h[1]); o.y = pk2(h[2], h[3]); *(u32x2*)(H + (size_t)row * D + col) = o; }
        }
    }
}

__device__ __forceinline__ void phase_prep(const Ctx& c, int l) {
    const bf16_t* P = c.w<bf16_t>(WS_P);
    const int gw = c.bid * 8 + c.wave, nw = c.G * 8, lane = c.lane;
    {
        const float* RT = c.w<float>(WS_ROPE); bf16_t* QN = c.w<bf16_t>(WS_QN); bf16_t* KN = c.w<bf16_t>(WS_KN);
        const int hd = lane >> 3, sub = lane & 7;
        u32x2 nq[2][2];
#define QK_LOAD(r_) do { _Pragma("unroll") for (int w_ = 0; w_ < 2; ++w_) { const bf16_t* pq_ = P + (size_t)(r_) * PT + (w_ ? PC_K : PC_Q) + hd * 64 + sub * 4; \
            nq[w_][0] = *(const u32x2*)pq_; nq[w_][1] = *(const u32x2*)(pq_ + 32); } } while (0)
        QK_LOAD(gw < MTOK ? gw : 0);
        for (int row = gw; row < MTOK; row += nw) {
            const int b = row / TPB, s = row - b * TPB; const bool lat = s >= CTX; const int t = s - CTX, pr = t >> 6, pc = t & 63;
            const int pos = sub < 4 ? pr : pc, jj0 = (sub & 3) * 4;
            u32x2 cq[2][2];
#pragma unroll
            for (int w_ = 0; w_ < 2; ++w_) { cq[w_][0] = nq[w_][0]; cq[w_][1] = nq[w_][1]; }
            QK_LOAD(row + nw < MTOK ? row + nw : row);
#pragma unroll
            for (int which = 0; which < 2; ++which) {
                const u32x2 a = cq[which][0], bq = cq[which][1];
                float x1[4] = {bflo(a.x), bfhi(a.x), bflo(a.y), bfhi(a.y)}, x2[4] = {bflo(bq.x), bfhi(bq.x), bflo(bq.y), bfhi(bq.y)};
                float ss = 0.f;
#pragma unroll
                for (int j = 0; j < 4; ++j) ss += x1[j] * x1[j] + x2[j] * x2[j];
                ss = red8(ss);
                const float inv = rsqrtf(ss * (1.f / 64.f) + 1e-6f);
                const float* gn = c.a->in[which ? 24 : 23] + l * 64 + sub * 4;
                float y1[4], y2[4];
#pragma unroll
                for (int j = 0; j < 4; ++j) { const float u1 = x1[j] * inv * gn[j], u2 = x2[j] * inv * gn[32 + j];
                    if (lat) { const float cs = RT[(pos * 16 + jj0 + j) * 2], sn = RT[(pos * 16 + jj0 + j) * 2 + 1]; y1[j] = u1 * cs - u2 * sn; y2[j] = u2 * cs + u1 * sn; }
                    else { y1[j] = u1; y2[j] = u2; }
                    if (!which) { y1[j] *= 0.125f; y2[j] *= 0.125f; } }
                u32x2 o1, o2; o1.x = pk2(y1[0], y1[1]); o1.y = pk2(y1[2], y1[3]); o2.x = pk2(y2[0], y2[1]); o2.y = pk2(y2[2], y2[3]);
                if (which) {
                    bf16_t* dst = KN + ((size_t)(b * 8 + hd)) * TPB * 64 + (size_t)(s >> 3) * 512 + (s & 7) * 32 + (sub >> 1) * 8 + (sub & 1) * 4;
                    *(u32x2*)dst = o1; *(u32x2*)(dst + 256) = o2;
                } else {
                    bf16_t* dst = QN + (((size_t)(b * 8 + hd)) * TPB + s) * 64 + sub * 4;
                    *(u32x2*)dst = o1; *(u32x2*)(dst + 32) = o2;
                }
            }
        }
    }
    {
        LAS bf16_t* T = (LAS bf16_t*)(c.lds + c.wave * 9216);
        bf16_t* VT = c.w<bf16_t>(WS_VT);
        for (int task = gw; task < NB * 8 * 36; task += nw) {
            const int b = task / 288, h = (task / 36) & 7, tb = task % 36;
#pragma unroll
            for (int i = 0; i < 8; ++i) { const int tok = i * 8 + (lane >> 3), ch = lane & 7;
                const u32x4 v = *(const u32x4*)(P + (size_t)(b * TPB + tb * 64 + tok) * PT + PC_V + h * 64 + ch * 8);
                *(LAS u32x4*)(T + tok * 72 + ch * 8) = v; }
            __builtin_amdgcn_wave_barrier();
            unsigned pk[32];
#pragma unroll
            for (int i = 0; i < 32; ++i) pk[i] = (unsigned)T[(2 * i) * 72 + lane] | ((unsigned)T[(2 * i + 1) * 72 + lane] << 16);
            bf16_t* dst = VT + (size_t)(b * 8 + h) * 64 * TPB + (size_t)(tb * 8) * 512 + (lane >> 4) * 128 + (lane & 15) * 8;
#pragma unroll
            for (int i = 0; i < 8; ++i) *(u32x4*)(dst + i * 512) = (u32x4){pk[4 * i], pk[4 * i + 1], pk[4 * i + 2], pk[4 * i + 3]};
            __builtin_amdgcn_wave_barrier();
        }
    }
}
__device__ __forceinline__ void phase_prep_hgrn(const Ctx& c, int l) {
    const bf16_t* P = c.w<bf16_t>(WS_P);
    const int gw = c.bid * 8 + c.wave, nw = c.G * 8;
    {
        LAS bf16_t* QT = (LAS bf16_t*)(c.lds + (c.wave < 7 ? c.wave * 8192 : 132096)); LAS bf16_t* KTl = QT + 16 * 72; LAS bf16_t* IV = KTl + 16 * 72;
        const float* LB = c.w<float>(WS_LB);
        bf16_t* QIN = c.w<bf16_t>(WS_QIN); bf16_t* KOT = c.w<bf16_t>(WS_KOT); bf16_t* IT = c.w<bf16_t>(WS_IT); float* DEC = c.w<float>(WS_DEC); bf16_t* O1 = c.w<bf16_t>(WS_O1);
        const bool bal = (c.G == 256);
        const int t_lo = bal ? (c.bid < 128 ? c.bid * 12 : 1536 + (c.bid - 128) * 24) + c.wave : gw;
        const int t_hi = bal ? (c.bid < 128 ? c.bid * 12 + 12 : 1536 + (c.bid - 128) * 24 + 24) : NB * 4 * NBLK16;
        const int t_st = bal ? 8 : nw;
        bf16_t nqr[16], nir[16], nfr[16], nbr[16];
#define HG_TLOAD(task_) do { const int tk_ = (task_); const int b_ = tk_ / (4 * NBLK16), h_ = (tk_ / NBLK16) & 3, nb_ = tk_ % NBLK16; \
            const bf16_t* pr_ = P + (size_t)(b_ * TPB + nb_ * 16) * PT + h_ * 64 + c.lane; \
            _Pragma("unroll") for (int t_ = 0; t_ < 16; ++t_) { nqr[t_] = pr_[(size_t)t_ * PT + PA_Q]; nir[t_] = pr_[(size_t)t_ * PT + PA_I]; nfr[t_] = pr_[(size_t)t_ * PT + PA_FF]; nbr[t_] = pr_[(size_t)t_ * PT + PA_FB]; } } while (0)
        if (t_lo < t_hi) HG_TLOAD(t_lo);
        for (int task = t_lo; task < t_hi; task += t_st) {
            int lane = c.lane; asm volatile("" : "+v"(lane));
            const int fr = lane & 15, g = lane >> 4;
            const int b = task / (4 * NBLK16), h = (task / NBLK16) & 3, nb = task % NBLK16; const int row0 = b * TPB + nb * 16;
            float q[16]; bf16_t ffr[16], fbr[16];
            {
                float iv[16];
#pragma unroll
                for (int t = 0; t < 16; ++t) { q[t] = bf2f(nqr[t]); iv[t] = bf2f(nir[t]); ffr[t] = nfr[t]; fbr[t] = nbr[t]; }
                HG_TLOAD(task + t_st < t_hi ? task + t_st : task);
                unsigned pk[8];
#pragma unroll
                for (int i = 0; i < 8; ++i) pk[i] = pk2(iv[2 * i], iv[2 * i + 1]);
                bf16_t* dst = IT + (((size_t)(b * 4 + h) * NBLK16 + nb) * 64 + lane) * 16;
                *(u32x4*)dst = (u32x4){pk[0], pk[1], pk[2], pk[3]}; *(u32x4*)(dst + 8) = (u32x4){pk[4], pk[5], pk[6], pk[7]};
                *(LAS u32x4*)(IV + lane * 24) = (u32x4){pk[0], pk[1], pk[2], pk[3]}; *(LAS u32x4*)(IV + lane * 24 + 8) = (u32x4){pk[4], pk[5], pk[6], pk[7]};
            }
            f32x4 oacc[4];
#pragma unroll
            for (int n = 0; n < 4; ++n) oacc[n] = (f32x4){0.f, 0.f, 0.f, 0.f};
#pragma unroll 1
            for (int dir = 0; dir < 2; ++dir) {
                const float lb = LB[((size_t)dir * 4 + l) * 256 + h * 64 + lane];
                float kf[16], cum[16];
#pragma unroll
                for (int t = 0; t < 16; ++t) { const float fp = bf2f(dir ? fbr[t] : ffr[t]);
                    const float f = lb + (1.f - lb) * sigm(fp); cum[t] = __logf(fmaxf(f, 1e-20f)); kf[t] = (1.f - lb) * sigm(-fp); }
                if (dir == 0) {
#pragma unroll
                    for (int t = 1; t < 16; ++t) cum[t] += cum[t - 1];
                } else {
#pragma unroll
                    for (int t = 14; t >= 0; --t) cum[t] += cum[t + 1];
                }
                const float cend = dir ? cum[0] : cum[15], cmid = dir ? cum[8] : cum[7];
                const size_t blk = ((size_t)(dir * 8 + b) * 4 + h) * NBLK16 + nb;
                DEC[blk * 64 + lane] = __expf(cend);
                unsigned pko[8];
#pragma unroll
                for (int t = 0; t < 16; ++t) {
                    const float qi = q[t] * __expf(cum[t]), ko = kf[t] * __expf(cend - cum[t]);
                    QIN[((size_t)dir * MTOK + row0 + t) * 256 + h * 64 + lane] = f2bf(qi);
                    if (t & 1) pko[t >> 1] |= (unsigned)f2bf(ko) << 16; else pko[t >> 1] = (unsigned)f2bf(ko);
                    QT[t * 72 + lane] = f2bf(q[t] * __expf(fminf(fmaxf(cum[t] - cmid, -80.f), 80.f)));
                    KTl[t * 72 + lane] = f2bf(kf[t] * __expf(fminf(fmaxf(cmid - cum[t], -80.f), 80.f)));
                }
                { bf16_t* dst = KOT + (blk * 64 + lane) * 16;
                  *(u32x4*)dst = (u32x4){pko[0], pko[1], pko[2], pko[3]}; *(u32x4*)(dst + 8) = (u32x4){pko[4], pko[5], pko[6], pko[7]}; }
                MEMBAR();
                __builtin_amdgcn_wave_barrier();
                f32x4 sT = {0.f, 0.f, 0.f, 0.f};
#pragma unroll
                for (int ks = 0; ks < 2; ++ks) {
                    const bf16x8 aK = *(const LAS bf16x8*)(KTl + fr * 72 + ks * 32 + g * 8), bQ = *(const LAS bf16x8*)(QT + fr * 72 + ks * 32 + g * 8);
                    sT = __builtin_amdgcn_mfma_f32_16x16x32_bf16(aK, bQ, sT, 0, 0, 0);
                }
                float sm[4];
#pragma unroll
                for (int j = 0; j < 4; ++j) { const int sI = 4 * g + j; const bool ok = dir ? (sI >= fr) : (sI <= fr); sm[j] = ok ? sT[j] : 0.f; }
                union { u32x2 u; bf16x4 v; } aS; aS.u = (u32x2){pk2m(sm[0], sm[1]), pk2m(sm[2], sm[3])};
#pragma unroll
                for (int n = 0; n < 4; ++n) { const bf16x4 bI = *(const LAS bf16x4*)(IV + (16 * n + fr) * 24 + 4 * g);
                    oacc[n] = __builtin_amdgcn_mfma_f32_16x16x16bf16_1k(aS.v, bI, oacc[n], 0, 0, 0); }
                MEMBAR();
                __builtin_amdgcn_wave_barrier();
            }
#pragma unroll
            for (int n = 0; n < 4; ++n)
#pragma unroll
                for (int j = 0; j < 4; ++j) O1[(size_t)(row0 + 4 * g + j) * 256 + h * 64 + 16 * n + fr] = f2bf(oacc[n][j]);
        }
    }
}
__device__ __forceinline__ void rwkv_chunk_task(const Ctx& c, const int task);
__device__ __forceinline__ void phase_prep_rwkv(const Ctx& c, int l) {
    const bf16_t* P = c.w<bf16_t>(WS_P);
    const int lane = c.lane;
    {
        LAS float* SP = (LAS float*)c.lds;
        LAS float* KKI = SP + 16 * 1152;
        LAS float* BONP = KKI + 64;
        LAS bf16_t* ACT = (LAS bf16_t*)(BONP + 128);
        const float* mu = c.a->in[12] + (size_t)l * 1152;
        const float* kks = c.a->in[18] + l * 256; const float* k_a = c.a->in[19] + l * 256; const float* r_k = c.a->in[20] + l * 256;
        const bf16_t* lo = c.w<bf16_t>(WS_LORA + (size_t)l * LORA_L);
        float* RW = c.w<float>(WS_RW); bf16_t* GG = c.w<bf16_t>(WS_G); bf16_t* BON = c.w<bf16_t>(WS_BON);
        const int fr = lane & 15, g = lane >> 4;
        for (int tile = c.bid; tile < MTOK / 16; tile += c.G) {
            const int r0 = tile * 16; const int b = r0 / TPB, s0 = r0 - b * TPB;
#pragma unroll
            for (int it = 0; it < 5; ++it) {
                const int idx = c.tid + it * 512;
                if (idx < 16 * 144) {
                    const int t = idx / 144, ch = (idx - t * 144) * 8; const int s = s0 + t;
                    const bf16_t* pp = P + (size_t)(r0 + t) * PT + PB0 + ch;
                    const u32x4 zero4 = {0u, 0u, 0u, 0u};
                    const u32x4 p4 = *(const u32x4*)pp;
                    const u32x4 m4 = (s != 0 && s != CTX) ? *(const u32x4*)(pp - PT) : zero4;
                    const u32x4 n4 = (s != CTX - 1 && s != TPB - 1) ? *(const u32x4*)(pp + PT) : zero4;
                    const f32x4 mu0 = *(const f32x4*)(mu + ch), mu1 = *(const f32x4*)(mu + ch + 4);
                    f32x4 o0, o1;
#pragma unroll
                    for (int e = 0; e < 4; ++e) {
                        const unsigned pw = p4[e], mw = m4[e], nw = n4[e];
                        const float pl = bflo(pw), ph = bfhi(pw);
                        const float vl = pl + (0.5f * (bflo(mw) + bflo(nw)) - pl) * (e < 2 ? mu0[2 * e] : mu1[2 * e - 4]);
                        const float vh = ph + (0.5f * (bfhi(mw) + bfhi(nw)) - ph) * (e < 2 ? mu0[2 * e + 1] : mu1[2 * e - 3]);
                        if (e < 2) { o0[2 * e] = vl; o0[2 * e + 1] = vh; } else { o1[2 * e - 4] = vl; o1[2 * e - 3] = vh; }
                    }
                    *(LAS f32x4*)(SP + t * 1152 + ch) = o0; *(LAS f32x4*)(SP + t * 1152 + ch + 4) = o1;
                }
            }
            __syncthreads();
            {
#pragma unroll
                for (int it = 0; it < 6; ++it) { const int idx = c.tid + it * 512; const int t = idx / 192, c2 = (idx - t * 192) * 2;
                    const float x0 = SP[t * 1152 + 768 + c2], x1 = SP[t * 1152 + 768 + c2 + 1];
                    float y0, y1;
                    if (c2 < 128) { y0 = 1.f - 2.f / (__expf(2.f * x0) + 1.f); y1 = 1.f - 2.f / (__expf(2.f * x1) + 1.f); }
                    else if (c2 < 256) { y0 = x0; y1 = x1; }
                    else { y0 = sigm(x0); y1 = sigm(x1); }
                    *(LAS unsigned*)(ACT + t * 392 + c2) = pk2(y0, y1); }
            }
            {
#pragma unroll
                for (int tt = 0; tt < 2; ++tt) { const int t = c.wave * 2 + tt; float ss = 0.f;
#pragma unroll
                    for (int j = 0; j < 4; ++j) { const float v = SP[t * 1152 + 256 + lane * 4 + j] * kks[lane * 4 + j]; ss += v * v; }
                    ss = red16(ss);
                    if (fr == 0) KKI[t * 4 + g] = 1.f / fmaxf(sqrtf(ss), 1e-12f); }
            }
            __syncthreads();
            float bpart[4] = {0.f, 0.f, 0.f, 0.f};
#pragma unroll 1
            for (int nn = 0; nn < 2; ++nn) {
                const int nt = c.wave * 2 + nn, ch = nt * 16 + fr, hh = nt >> 2;
                f32x4 aw[2], aa[2], ag = (f32x4){0.f, 0.f, 0.f, 0.f};
#pragma unroll
                for (int d = 0; d < 2; ++d) { aw[d] = (f32x4){0.f, 0.f, 0.f, 0.f}; aa[d] = aw[d]; }
#pragma unroll
                for (int d = 0; d < 2; ++d)
#pragma unroll
                    for (int ks = 0; ks < 2; ++ks) {
                        const bf16x8 fa = *(const LAS bf16x8*)(ACT + fr * 392 + d * 64 + ks * 32 + g * 8), fb = *(const LAS bf16x8*)(ACT + fr * 392 + 128 + d * 64 + ks * 32 + g * 8);
                        const bf16x8 bw = *(const bf16x8*)(lo + (size_t)d * 16384 + (size_t)ch * 64 + ks * 32 + g * 8);
                        const bf16x8 ba = *(const bf16x8*)(lo + 32768 + (size_t)d * 16384 + (size_t)ch * 64 + ks * 32 + g * 8);
                        aw[d] = __builtin_amdgcn_mfma_f32_16x16x32_bf16(fa, bw, aw[d], 0, 0, 0);
                        aa[d] = __builtin_amdgcn_mfma_f32_16x16x32_bf16(fb, ba, aa[d], 0, 0, 0);
                    }
#pragma unroll
                for (int ks = 0; ks < 4; ++ks) {
                    const bf16x8 fg = *(const LAS bf16x8*)(ACT + fr * 392 + 256 + ks * 32 + g * 8);
                    const bf16x8 bg = *(const bf16x8*)(lo + 65536 + (size_t)ch * 128 + ks * 32 + g * 8);
                    ag = __builtin_amdgcn_mfma_f32_16x16x32_bf16(fg, bg, ag, 0, 0, 0);
                }
                const float kksc = kks[ch], kac = k_a[ch], rkc = r_k[ch];
                const float w0f = c.a->in[13][(size_t)(l * 2 + 0) * 256 + ch], w0b = c.a->in[13][(size_t)(l * 2 + 1) * 256 + ch];
                const float a0f = c.a->in[15][(size_t)(l * 2 + 0) * 256 + ch], a0b = c.a->in[15][(size_t)(l * 2 + 1) * 256 + ch];
#pragma unroll
                for (int j = 0; j < 4; ++j) {
                    const int t = 4 * g + j; const size_t row = (size_t)r0 + t;
                    const float rr = SP[t * 1152 + ch], kk0 = SP[t * 1152 + 256 + ch], vv = SP[t * 1152 + 512 + ch];
                    const float kk = kk0 * kksc * KKI[t * 4 + hh];
                    float kdsum = 0.f;
#pragma unroll
                    for (int d = 0; d < 2; ++d) {
                        const float wl = (d ? w0b : w0f) + aw[d][j];
                        const float xx = -wl; const float sp = fmaxf(xx, 0.f) + __logf(1.f + __expf(-fabsf(xx)));
                        const float wlog = -sp - 0.5f; const float dec = __expf(-__expf(wlog));
                        const float a = sigm((d ? a0b : a0f) + aa[d][j]);
                        const float kd = kk0 * (1.f + (a - 1.f) * kac), ak = a * kk;
                        kdsum += kd;
                        float* dst = RW + (((size_t)d * MTOK + row) * 4 + hh) * 384 + (ch & 63);
                        dst[0] = dec; dst[64] = kk; dst[128] = ak; dst[192] = kd; dst[256] = rr; dst[320] = vv;
                    }
                    GG[row * 256 + ch] = f2bf(ag[j]);
                    bpart[j] += rr * kdsum * rkc;
                }
            }
#pragma unroll
            for (int j = 0; j < 4; ++j) { const float s = red16(bpart[j]); if (fr == 0) BONP[(4 * g + j) * 8 + c.wave] = s; }
            __syncthreads();
            for (int idx = c.tid; idx < 16 * 256; idx += 512) { const int t = idx >> 8, ch = idx & 255, hh = ch >> 6;
                BON[((size_t)r0 + t) * 256 + ch] = f2bf((BONP[t * 8 + hh * 2] + BONP[t * 8 + hh * 2 + 1]) * SP[t * 1152 + 512 + ch]); }
            asm volatile("s_waitcnt vmcnt(0)" ::: "memory");
            __syncthreads();
            rwkv_chunk_task(c, ((b * 4 + (c.wave >> 1)) * 2 + (c.wave & 1)) * 144 + (s0 >> 4));
            if (REP_PHASE == 35) rwkv_chunk_task(c, ((b * 4 + (c.wave >> 1)) * 2 + (c.wave & 1)) * 144 + (s0 >> 4));
            __syncthreads();
        }
    }
}

__device__ __forceinline__ void rwkv_chunk_task(const Ctx& c, const int task) {
    const int wv = c.wave;
    {
    int lane = c.lane; asm volatile("" : "+v"(lane));
    const int fr = lane & 15, g = lane >> 4;
    LAS unsigned char* base = c.lds + (wv < 7 ? wv * 17408 : 132096);
    LAS bf16_t* ALT = (LAS bf16_t*)base; LAS bf16_t* KT = ALT + 16 * 72; LAS bf16_t* KAP = KT + 16 * 72; LAS bf16_t* RT = KAP + 16 * 72;
    LAS float* SM = (LAS float*)(base + 9216);
    const float* RW = c.w<float>(WS_RW);
    bf16_t* KHT = c.w<bf16_t>(WS_KHT); bf16_t* AHT = c.w<bf16_t>(WS_AHT); float* GCo = c.w<float>(WS_GC); bf16_t* RH = c.w<bf16_t>(WS_RH); bf16_t* WYo = c.w<bf16_t>(WS_WY); bf16_t* ZT = c.w<bf16_t>(WS_ZT); bf16_t* VT2 = c.w<bf16_t>(WS_VT2);
    {
        const int nb = task % 144, sq = task / 144, dir = sq & 1, h = (sq >> 1) & 3, b = sq >> 3;
        const int row0 = b * TPB + nb * 16;
        const float* rec0 = RW + (((size_t)dir * MTOK + row0) * 4 + h) * 384 + lane;
        float kap[16], alt[16], kt[16], Rt[16];
        float Gc = 1.f;
        const float* rp = rec0 + (dir ? 15 * 1536 : 0); const long rstep = dir ? -1536 : 1536;
        float vv[16];
#pragma unroll
        for (int t = 0; t < 16; ++t) {
            const float w = rp[0], kk = rp[64], ak = rp[128], kd = rp[192], r = rp[256]; vv[t] = rp[320];
            rp += rstep;
            kap[t] = Gc * kk; Gc *= w; const float iG = 1.f / Gc; alt[t] = ak * iG; kt[t] = kd * iG; Rt[t] = Gc * r;
        }
        {
            unsigned pk[8];
#pragma unroll
            for (int i = 0; i < 8; ++i) pk[i] = pk2(vv[2 * i], vv[2 * i + 1]);
            bf16_t* dst = VT2 + ((size_t)task * 64 + lane) * 16;
            *(u32x4*)dst = (u32x4){pk[0], pk[1], pk[2], pk[3]}; *(u32x4*)(dst + 8) = (u32x4){pk[4], pk[5], pk[6], pk[7]};
        }
#pragma unroll
        for (int t = 0; t < 16; ++t) { ALT[t * 72 + lane] = f2bf(alt[t]); KT[t * 72 + lane] = f2bf(kt[t]); KAP[t * 72 + lane] = f2bf(kap[t]); RT[t * 72 + lane] = f2bf(Rt[t]); }
        MEMBAR();
        __builtin_amdgcn_wave_barrier();
        {
            f32x4 dN = {0.f, 0.f, 0.f, 0.f}, dM = dN, dNR = dN, dMR = dN;
#pragma unroll
            for (int ks = 0; ks < 2; ++ks) {
                const bf16x8 aA = *(const LAS bf16x8*)(ALT + fr * 72 + ks * 32 + g * 8), aK = *(const LAS bf16x8*)(KT + fr * 72 + ks * 32 + g * 8);
                const bf16x8 bP = *(const LAS bf16x8*)(KAP + fr * 72 + ks * 32 + g * 8), bR = *(const LAS bf16x8*)(RT + fr * 72 + ks * 32 + g * 8);
                dN = __builtin_amdgcn_mfma_f32_16x16x32_bf16(aA, bP, dN, 0, 0, 0); dM = __builtin_amdgcn_mfma_f32_16x16x32_bf16(aK, bP, dM, 0, 0, 0);
                dNR = __builtin_amdgcn_mfma_f32_16x16x32_bf16(aA, bR, dNR, 0, 0, 0); dMR = __builtin_amdgcn_mfma_f32_16x16x32_bf16(aK, bR, dMR, 0, 0, 0);
            }
#pragma unroll
            for (int j = 0; j < 4; ++j) { const int sI = 4 * g + j;
                SM[0 * 256 + sI * 16 + fr] = sI < fr ? dN[j] : 0.f; SM[1 * 256 + sI * 16 + fr] = sI < fr ? dM[j] : 0.f;
                SM[2 * 256 + sI * 16 + fr] = sI <= fr ? dNR[j] : 0.f; SM[3 * 256 + sI * 16 + fr] = sI <= fr ? dMR[j] : 0.f; }
        }
        __builtin_amdgcn_wave_barrier();
        {
            const int role = g & 1;
            float X[16];
#define ROW4(dst, mat, r_) do { _Pragma("unroll") for (int q_ = 0; q_ < 4; ++q_) dst[q_] = *(const LAS f32x4*)(SM + (mat) * 256 + (r_) * 16 + 4 * q_); } while (0)
            {
                f32x4 nr[4]; float nrhs = role ? SM[2 * 256 + 15 * 16 + fr] : (15 == fr ? 1.f : 0.f);
                ROW4(nr, 0, 15);
#pragma unroll
                for (int sI = 15; sI >= 0; --sI) {
                    f32x4 cr[4]; float acc = nrhs;
#pragma unroll
                    for (int q = 0; q < 4; ++q) cr[q] = nr[q];
                    if (sI > 0) { ROW4(nr, 0, sI - 1); nrhs = role ? SM[2 * 256 + (sI - 1) * 16 + fr] : (sI - 1 == fr ? 1.f : 0.f); }
                    MEMBAR();
#pragma unroll
                    for (int j = sI + 1; j < 16; ++j) acc -= cr[j >> 2][j & 3] * X[j];
                    X[sI] = acc;
                }
            }
            {
                f32x4 nr[4]; float nmr = SM[3 * 256 + 0 * 16 + fr];
                ROW4(nr, 1, 0);
#pragma unroll
                for (int sI = 0; sI < 16; ++sI) {
                    f32x4 cr[4]; const float mr = nmr;
#pragma unroll
                    for (int q = 0; q < 4; ++q) cr[q] = nr[q];
                    if (sI < 15) { ROW4(nr, 1, sI + 1); nmr = SM[3 * 256 + (sI + 1) * 16 + fr]; }
                    MEMBAR();
                    float om = 0.f;
#pragma unroll
                    for (int j = sI + 1; j < 16; ++j) om += cr[j >> 2][j & 3] * X[j];
                    const float oo = role ? mr - om : om;
                    SM[(4 + role) * 256 + sI * 16 + fr] = X[sI]; SM[(6 + role) * 256 + sI * 16 + fr] = oo;
                }
            }
        }
        __builtin_amdgcn_wave_barrier();
        float Kh[16], ahv[16];
        {
            float Rh[16];
#pragma unroll
            for (int t = 0; t < 16; ++t) { Kh[t] = 0.f; Rh[t] = bf2f(RT[t * 72 + lane]); }
            f32x4 nt4[4], ng4[4]; bf16_t nk = KAP[0 * 72 + lane];
            ROW4(nt4, 4, 0); ROW4(ng4, 5, 0);
            MEMBAR();
#pragma unroll
            for (int sI = 0; sI < 16; ++sI) {
                f32x4 ct[4], cg[4]; const float kps = bf2f(nk);
#pragma unroll
                for (int q = 0; q < 4; ++q) { ct[q] = nt4[q]; cg[q] = ng4[q]; }
                if (sI < 15) { ROW4(nt4, 4, sI + 1); ROW4(ng4, 5, sI + 1); nk = KAP[(sI + 1) * 72 + lane]; }
                MEMBAR();
#pragma unroll
                for (int t = sI; t < 16; ++t) { Kh[t] += kps * ct[t >> 2][t & 3]; Rh[t] -= kps * cg[t >> 2][t & 3]; }
            }
            bf16_t* rd = RH + (size_t)task * 1024 + lane; bf16_t* kd2 = KHT + (size_t)task * 1024 + lane;
#pragma unroll
            for (int t = 0; t < 16; ++t) { rd[t * 64] = f2bf(Rh[t]); kd2[t * 64] = f2bf(Kh[t]); }
            GCo[(size_t)task * 64 + lane] = Gc;
            MEMBAR();
        }
        {
            float Z[16];
#pragma unroll
            for (int t = 0; t < 16; ++t) ahv[t] = bf2f(ALT[t * 72 + lane]) * Gc;
            f32x4 nm4[4]; bf16_t nk = KT[0 * 72 + lane];
            ROW4(nm4, 6, 0);
            MEMBAR();
#pragma unroll
            for (int sI = 0; sI < 16; ++sI) {
                f32x4 cm[4]; float z = bf2f(nk) * Gc;
#pragma unroll
                for (int q = 0; q < 4; ++q) cm[q] = nm4[q];
                if (sI < 15) { ROW4(nm4, 6, sI + 1); nk = KT[(sI + 1) * 72 + lane]; }
                MEMBAR();
#pragma unroll
                for (int t = sI + 1; t < 16; ++t) z -= cm[t >> 2][t & 3] * ahv[t];
                Z[sI] = z;
            }
            unsigned pz[8];
#pragma unroll
            for (int i = 0; i < 8; ++i) pz[i] = pk2(Z[2 * i], Z[2 * i + 1]);
            bf16_t* zd = ZT + ((size_t)task * 64 + lane) * 16;
            *(u32x4*)zd = (u32x4){pz[0], pz[1], pz[2], pz[3]}; *(u32x4*)(zd + 8) = (u32x4){pz[4], pz[5], pz[6], pz[7]};
            MEMBAR();
        }
#undef ROW4
        {
            unsigned pa[8];
#pragma unroll
            for (int i = 0; i < 8; ++i) pa[i] = pk2(ahv[2 * i], ahv[2 * i + 1]);
            bf16_t* ad = AHT + ((size_t)task * 64 + lane) * 16;
            *(u32x4*)ad = (u32x4){pa[0], pa[1], pa[2], pa[3]}; *(u32x4*)(ad + 8) = (u32x4){pa[4], pa[5], pa[6], pa[7]};
            if (g == 0) {
                unsigned pw[8];
#pragma unroll
                for (int i = 0; i < 8; ++i) pw[i] = pk2(SM[7 * 256 + (2 * i) * 16 + fr], SM[7 * 256 + (2 * i + 1) * 16 + fr]);
                bf16_t* wd = WYo + ((size_t)task * 16 + fr) * 16;
                *(u32x4*)wd = (u32x4){pw[0], pw[1], pw[2], pw[3]}; *(u32x4*)(wd + 8) = (u32x4){pw[4], pw[5], pw[6], pw[7]};
            }
        }
        __builtin_amdgcn_wave_barrier();
    }
    }
}

constexpr int RC_RD = 5, RC_SLOT = 10240;
__device__ __forceinline__ void rwkv_scan(const Ctx& c) {
    const int lane = c.lane, fr = lane & 15, g = lane >> 4;
    LAS unsigned char* ring = c.lds;
    for (int task = c.bid; task < 256; task += c.G) {
        const int b = task >> 5, h = (task >> 3) & 3, dir = (task >> 2) & 1, vs = task & 3;
        const size_t cbase = (size_t)((b * 4 + h) * 2 + dir) * 144;
        const unsigned char* KHT = c.w<unsigned char>(WS_KHT) + cbase * 2048 + lane * 16; const unsigned char* RH = c.w<unsigned char>(WS_RH) + cbase * 2048 + lane * 16;
        const unsigned char* AHT = c.w<unsigned char>(WS_AHT) + cbase * 2048 + lane * 16; const unsigned char* ZT = c.w<unsigned char>(WS_ZT) + cbase * 2048 + lane * 16;
        const unsigned char* X1 = lane < 16 ? c.w<unsigned char>(WS_GC) + cbase * 256 + lane * 16 : (lane < 48 ? c.w<unsigned char>(WS_WY) + cbase * 512 + (lane - 16) * 16 : c.w<unsigned char>(WS_VT2) + cbase * 2048 + vs * 512 + (lane - 48) * 16);
        const int x1s = lane < 16 ? 256 : (lane < 48 ? 512 : 2048);
        const unsigned char* X2 = lane < 16 ? c.w<unsigned char>(WS_VT2) + cbase * 2048 + vs * 512 + 256 + lane * 16 : c.w<unsigned char>(WS_GC) + cbase * 256 + (lane & 15) * 16;
        const int x2s = lane < 16 ? 2048 : 256;
        bf16_t* YSp = c.w<bf16_t>(WS_YS) + (size_t)dir * MTOK * 256 + h * 64 + vs * 16 + fr;
#define RC_NB(ci_) (dir == 0 ? (ci_) : ((ci_) < 16 ? 15 - (ci_) : 159 - (ci_)))
#define RC_DMA(ci_, slot_) do { int cc_ = (ci_); cc_ = cc_ < 144 ? cc_ : 143; const int nb_ = RC_NB(cc_); LAS unsigned char* d_ = ring + (slot_) * RC_SLOT; \
        _Pragma("unroll") for (int k_ = 0; k_ < 2; ++k_) { \
            __builtin_amdgcn_global_load_lds((const unsigned*)(KHT + (size_t)nb_ * 2048 + k_ * 1024), (LAS unsigned*)(d_ + k_ * 1024), 16, 0, 0); \
            __builtin_amdgcn_global_load_lds((const unsigned*)(RH + (size_t)nb_ * 2048 + k_ * 1024), (LAS unsigned*)(d_ + 2048 + k_ * 1024), 16, 0, 0); \
            __builtin_amdgcn_global_load_lds((const unsigned*)(AHT + (size_t)nb_ * 2048 + k_ * 1024), (LAS unsigned*)(d_ + 4096 + k_ * 1024), 16, 0, 0); \
            __builtin_amdgcn_global_load_lds((const unsigned*)(ZT + (size_t)nb_ * 2048 + k_ * 1024), (LAS unsigned*)(d_ + 6144 + k_ * 1024), 16, 0, 0); } \
        __builtin_amdgcn_global_load_lds((const unsigned*)(X1 + (size_t)nb_ * x1s), (LAS unsigned*)(d_ + 8192), 16, 0, 0); \
        __builtin_amdgcn_global_load_lds((const unsigned*)(X2 + (size_t)nb_ * x2s), (LAS unsigned*)(d_ + 9216), 16, 0, 0); } while (0)
        f32x4 S[4];
#pragma unroll
        for (int m = 0; m < 4; ++m) S[m] = (f32x4){0.f, 0.f, 0.f, 0.f};
#pragma unroll 1
        for (int q = 0; q < RC_RD; ++q) RC_DMA(q, q);
        asm volatile("s_waitcnt vmcnt(0)" ::: "memory");
        int slot = 0;
#pragma unroll 1
        for (int ci = 0; ci < 144; ++ci) {
            const int nb = RC_NB(ci); const int row0 = b * TPB + nb * 16;
            asm volatile("s_waitcnt vmcnt(%0)" :: "n"((RC_RD - 1) * 14 + 4) : "memory");
            const LAS bf16_t* sp = (const LAS bf16_t*)(ring + slot * RC_SLOT);
            u32x2 kh[2][2], rh[2][2], ah[4], zt[4], wy, vt; f32x4 gc[4];
#pragma unroll
            for (int k = 0; k < 2; ++k) { kh[k][0] = *(const LAS u32x2*)(sp + fr * 64 + 32 * k + 4 * g); kh[k][1] = *(const LAS u32x2*)(sp + fr * 64 + 32 * k + 16 + 4 * g);
                rh[k][0] = *(const LAS u32x2*)(sp + 1024 + fr * 64 + 32 * k + 4 * g); rh[k][1] = *(const LAS u32x2*)(sp + 1024 + fr * 64 + 32 * k + 16 + 4 * g); }
#pragma unroll
            for (int m = 0; m < 4; ++m) { ah[m] = *(const LAS u32x2*)(sp + 2048 + (16 * m + fr) * 16 + 4 * g); zt[m] = *(const LAS u32x2*)(sp + 3072 + (16 * m + fr) * 16 + 4 * g);
                gc[m] = *(const LAS f32x4*)((const LAS float*)(sp + 4096) + 16 * m + 4 * g); }
            wy = *(const LAS u32x2*)(sp + 4096 + 128 + fr * 16 + 4 * g);
            vt = *(const LAS u32x2*)(sp + 4096 + 384 + fr * 16 + 4 * g);
            asm volatile("s_waitcnt lgkmcnt(0)" ::: "memory");
            RC_DMA(ci + RC_RD, slot);
            union { u32x4 u; bf16x8 v; } B0, B1, A;
            union { u32x2 u; bf16x4 v; } a4, b4, w4;
            B0.u = (u32x4){pk2m(S[0][0], S[0][1]), pk2m(S[0][2], S[0][3]), pk2m(S[1][0], S[1][1]), pk2m(S[1][2], S[1][3])};
            B1.u = (u32x4){pk2m(S[2][0], S[2][1]), pk2m(S[2][2], S[2][3]), pk2m(S[3][0], S[3][1]), pk2m(S[3][2], S[3][3])};
            b4.u = vt;
            f32x4 w = {0.f, 0.f, 0.f, 0.f}, y = {0.f, 0.f, 0.f, 0.f};
            A.u = (u32x4){kh[0][0].x, kh[0][0].y, kh[0][1].x, kh[0][1].y}; w = __builtin_amdgcn_mfma_f32_16x16x32_bf16(A.v, B0.v, w, 0, 0, 0);
            A.u = (u32x4){kh[1][0].x, kh[1][0].y, kh[1][1].x, kh[1][1].y}; w = __builtin_amdgcn_mfma_f32_16x16x32_bf16(A.v, B1.v, w, 0, 0, 0);
            A.u = (u32x4){rh[0][0].x, rh[0][0].y, rh[0][1].x, rh[0][1].y}; y = __builtin_amdgcn_mfma_f32_16x16x32_bf16(A.v, B0.v, y, 0, 0, 0);
            A.u = (u32x4){rh[1][0].x, rh[1][0].y, rh[1][1].x, rh[1][1].y}; y = __builtin_amdgcn_mfma_f32_16x16x32_bf16(A.v, B1.v, y, 0, 0, 0);
            a4.u = wy; y = __builtin_amdgcn_mfma_f32_16x16x16bf16_1k(a4.v, b4.v, y, 0, 0, 0);
            w4.u = (u32x2){pk2m(-w[0], -w[1]), pk2m(-w[2], -w[3])};
#pragma unroll
            for (int m = 0; m < 4; ++m) {
                f32x4 d = {0.f, 0.f, 0.f, 0.f};
                a4.u = zt[m]; d = __builtin_amdgcn_mfma_f32_16x16x16bf16_1k(a4.v, b4.v, d, 0, 0, 0);
                a4.u = ah[m]; d = __builtin_amdgcn_mfma_f32_16x16x16bf16_1k(a4.v, w4.v, d, 0, 0, 0);
                S[m] = S[m] * gc[m] + d;
            }
#pragma unroll
            for (int j = 0; j < 4; ++j) { const int t = 4 * g + j; YSp[(size_t)(row0 + (dir ? 15 - t : t)) * 256] = f2bf(y[j]); }
            slot = slot + 1 == RC_RD ? 0 : slot + 1;
        }
        asm volatile("s_waitcnt vmcnt(0)" ::: "memory");
#undef RC_NB
#undef RC_DMA
    }
}

__device__ __forceinline__ void hgrn_scan(const Ctx& c) {
    const int lane = c.lane, fr = lane & 15, g = lane >> 4;
    for (int task = c.bid; task < 256; task += c.G) {
        const int b = task >> 5, h = (task >> 3) & 3, dir = (task >> 2) & 1, vs = task & 3;
        const bf16_t* QIN = c.w<bf16_t>(WS_QIN) + (size_t)dir * MTOK * 256 + h * 64;
        const bf16_t* KOT = c.w<bf16_t>(WS_KOT) + (((size_t)(dir * 8 + b) * 4 + h) * NBLK16) * 1024;
        const bf16_t* IT = c.w<bf16_t>(WS_IT) + (((size_t)(b * 4 + h)) * NBLK16) * 1024;
        const float* DEC = c.w<float>(WS_DEC) + (((size_t)(dir * 8 + b) * 4 + h) * NBLK16) * 64;
        bf16_t* O2 = c.w<bf16_t>(WS_O2) + (size_t)dir * MTOK * 256 + h * 64 + vs * 16 + fr;
        f32x4 S[4];
#pragma unroll
        for (int m = 0; m < 4; ++m) S[m] = (f32x4){0.f, 0.f, 0.f, 0.f};
        u32x2 q00[4], q01[4], q10[4], q11[4]; f32x4 dc[4][4]; bf16x4 ka[4][4], ib[4];
#define HG_NB(ci_) (dir == 0 ? (ci_) : ((ci_) < 16 ? 15 - (ci_) : 159 - (ci_)))
#define HG_LOAD(ci_, st_) do { int cc_ = (ci_); cc_ = cc_ < NBLK16 ? cc_ : NBLK16 - 1; const int nb_ = HG_NB(cc_); const bf16_t* qp_ = QIN + (size_t)(b * TPB + nb_ * 16 + fr) * 256 + 4 * g; \
        q00[st_] = *(const u32x2*)qp_; q01[st_] = *(const u32x2*)(qp_ + 16); q10[st_] = *(const u32x2*)(qp_ + 32); q11[st_] = *(const u32x2*)(qp_ + 48); \
        _Pragma("unroll") for (int m_ = 0; m_ < 4; ++m_) { dc[st_][m_] = *(const f32x4*)(DEC + (size_t)nb_ * 64 + 16 * m_ + 4 * g); ka[st_][m_] = *(const bf16x4*)(KOT + (size_t)nb_ * 1024 + (16 * m_ + fr) * 16 + 4 * g); } \
        ib[st_] = *(const bf16x4*)(IT + (size_t)nb_ * 1024 + (vs * 16 + fr) * 16 + 4 * g); MEMBAR(); } while (0)
#define HG_STEP(ci_, st_) do { const int nb_ = HG_NB(ci_); const int row0_ = b * TPB + nb_ * 16; \
        union { u32x4 u; bf16x8 v; } A0, A1, B0, B1; \
        A0.u = (u32x4){q00[st_].x, q00[st_].y, q01[st_].x, q01[st_].y}; A1.u = (u32x4){q10[st_].x, q10[st_].y, q11[st_].x, q11[st_].y}; \
        B0.u = (u32x4){pk2m(S[0][0], S[0][1]), pk2m(S[0][2], S[0][3]), pk2m(S[1][0], S[1][1]), pk2m(S[1][2], S[1][3])}; \
        B1.u = (u32x4){pk2m(S[2][0], S[2][1]), pk2m(S[2][2], S[2][3]), pk2m(S[3][0], S[3][1]), pk2m(S[3][2], S[3][3])}; \
        f32x4 o = (f32x4){0.f, 0.f, 0.f, 0.f}; \
        o = __builtin_amdgcn_mfma_f32_16x16x32_bf16(A0.v, B0.v, o, 0, 0, 0); o = __builtin_amdgcn_mfma_f32_16x16x32_bf16(A1.v, B1.v, o, 0, 0, 0); \
        _Pragma("unroll") for (int j_ = 0; j_ < 4; ++j_) O2[(size_t)(row0_ + 4 * g + j_) * 256] = f2bf(o[j_]); \
        _Pragma("unroll") for (int m_ = 0; m_ < 4; ++m_) { S[m_] = S[m_] * dc[st_][m_]; S[m_] = __builtin_amdgcn_mfma_f32_16x16x16bf16_1k(ka[st_][m_], ib[st_], S[m_], 0, 0, 0); } } while (0)
        HG_LOAD(0, 0); HG_LOAD(1, 1); HG_LOAD(2, 2);
#pragma unroll 1
        for (int ci = 0; ci < NBLK16; ci += 4) {
            HG_LOAD(ci + 3, 3); HG_STEP(ci, 0);
            HG_LOAD(ci + 4, 0); HG_STEP(ci + 1, 1);
            HG_LOAD(ci + 5, 1); HG_STEP(ci + 2, 2);
            HG_LOAD(ci + 6, 2); HG_STEP(ci + 3, 3);
        }
#undef HG_NB
#undef HG_LOAD
#undef HG_STEP
    }
}

template <bool LAT> __device__ __forceinline__ void attn_unit(const Ctx& c, int l, int b, int h, int r, int jb) {
    const int lane = c.lane, fr = lane & 15, g = lane >> 4;
    const size_t bh = (size_t)(b * 8 + h);
    const bf16_t* Q = c.w<bf16_t>(WS_QN) + bh * TPB * 64; const bf16_t* K = c.w<bf16_t>(WS_KN) + bh * TPB * 64; const bf16_t* V = c.w<bf16_t>(WS_VT) + bh * 64 * TPB;
    const int q0 = LAT ? CTX + r * 64 + jb * 16 : jb * 16;
    const bf16x8 qf0 = *(const bf16x8*)(Q + (size_t)(q0 + fr) * 64 + 8 * g), qf1 = *(const bf16x8*)(Q + (size_t)(q0 + fr) * 64 + 32 + 8 * g);
    constexpr int NT = LAT ? 32 : 16, NB = NT / 8;
    int r_start = r - 4; r_start = r_start < 0 ? 0 : (r_start > 24 ? 24 : r_start);
    int k_start = 16 * jb - 8; k_start = k_start < 0 ? 0 : (k_start > 32 ? 32 : k_start);
    const bf16_t* kbase = K + (size_t)(fr >> 3) * 512 + (fr & 7) * 32 + g * 8;
#define KEY0(t) ((t) < 16 ? (t) * 16 : CTX + (r_start + (((t) - 16) >> 1)) * 64 + k_start + 16 * ((t) & 1))
    f32x4 sc[NT];
    bf16x8 kf[2][8][2];
#define K_ISSUE(bt, buf) do { _Pragma("unroll") for (int i_ = 0; i_ < 8; ++i_) { const bf16_t* kp_ = kbase + (size_t)(KEY0((bt) * 8 + i_) >> 3) * 512; \
        kf[buf][i_][0] = *(const bf16x8*)kp_; kf[buf][i_][1] = *(const bf16x8*)(kp_ + 256); } MEMBAR(); } while (0)
#define K_COMP(bt, buf) do { _Pragma("unroll") for (int i_ = 0; i_ < 8; ++i_) { f32x4 a_ = (f32x4){0.f, 0.f, 0.f, 0.f}; \
        a_ = __builtin_amdgcn_mfma_f32_16x16x32_bf16(kf[buf][i_][0], qf0, a_, 0, 0, 0); a_ = __builtin_amdgcn_mfma_f32_16x16x32_bf16(kf[buf][i_][1], qf1, a_, 0, 0, 0); sc[(bt) * 8 + i_] = a_; } MEMBAR(); } while (0)
    K_ISSUE(0, 0); K_ISSUE(1, 1);
    K_COMP(0, 0);
    if (LAT) { K_ISSUE(2, 0); K_COMP(1, 1); K_ISSUE(3, 1); K_COMP(2, 0); K_COMP(3, 1); }
    else K_COMP(1, 1);
#undef K_ISSUE
#undef K_COMP
    if (LAT) {
        const int qc = 16 * jb + fr; int w_start = qc - 8; w_start = w_start < 0 ? 0 : (w_start > 48 ? 48 : w_start);
        const float* rpb = c.a->in[25] + (size_t)(l * 8 + h) * 15 * 31;
        float bias[16][4];
#pragma unroll
        for (int t = 16; t < NT; ++t) {
            const int rrow = (t - 16) >> 1, hf = t & 1; const int ridx = r_start + rrow - r + 7;
#pragma unroll
            for (int j = 0; j < 4; ++j) { const int kc = k_start + 16 * hf + 4 * g + j; int cidx = kc - qc + 15; cidx = cidx < 0 ? 0 : (cidx > 30 ? 30 : cidx); bias[t - 16][j] = rpb[ridx * 31 + cidx]; }
        }
        MEMBAR();
#pragma unroll
        for (int t = 16; t < NT; ++t)
#pragma unroll
            for (int j = 0; j < 4; ++j) { const int kc = k_start + 16 * (t & 1) + 4 * g + j; const bool ok = kc >= w_start && kc < w_start + 16; sc[t][j] = ok ? sc[t][j] + bias[t - 16][j] : -1e30f; }
    }
    float m = -3e38f;
#pragma unroll
    for (int t = 0; t < NT; ++t) m = fmaxf(m, fmaxf(fmaxf(sc[t][0], sc[t][1]), fmaxf(sc[t][2], sc[t][3])));
    m = fmaxf(m, shx(m, 16)); m = fmaxf(m, shx(m, 32));
    float ls = 0.f;
    u32x4 pa[NT / 2];
#pragma unroll
    for (int ks = 0; ks < NT / 2; ++ks) {
        float p[8];
#pragma unroll
        for (int j = 0; j < 4; ++j) { p[j] = __expf(sc[2 * ks][j] - m); p[4 + j] = __expf(sc[2 * ks + 1][j] - m); }
#pragma unroll
        for (int j = 0; j < 8; ++j) ls += p[j];
        pa[ks] = (u32x4){pk2m(p[0], p[1]), pk2m(p[2], p[3]), pk2m(p[4], p[5]), pk2m(p[6], p[7])};
    }
    ls += shx(ls, 16); ls += shx(ls, 32);
    f32x4 o[4];
#pragma unroll
    for (int n = 0; n < 4; ++n) o[n] = (f32x4){0.f, 0.f, 0.f, 0.f};
    const bf16_t* vbase = V + (size_t)(g >> 1) * 512 + fr * 8 + (g & 1) * 4;
    u32x2 vf[2][2][4][2];
#define V_ISSUE(bt, buf) do { _Pragma("unroll") for (int i_ = 0; i_ < 2; ++i_) { const int ta_ = 2 * ((bt) * 2 + i_); const int tok_ = KEY0(ta_); \
        _Pragma("unroll") for (int n_ = 0; n_ < 4; ++n_) { const bf16_t* vp_ = vbase + n_ * 128 + (size_t)(tok_ >> 3) * 512; vf[buf][i_][n_][0] = *(const u32x2*)vp_; vf[buf][i_][n_][1] = *(const u32x2*)(vp_ + 1024); } } MEMBAR(); } while (0)
#define V_COMP(bt, buf) do { _Pragma("unroll") for (int i_ = 0; i_ < 2; ++i_) { union { u32x4 u; bf16x8 v; } pa_; pa_.u = pa[(bt) * 2 + i_]; \
        _Pragma("unroll") for (int n_ = 0; n_ < 4; ++n_) { union { u32x4 u; bf16x8 v; } vf_; vf_.u = (u32x4){vf[buf][i_][n_][0].x, vf[buf][i_][n_][0].y, vf[buf][i_][n_][1].x, vf[buf][i_][n_][1].y}; \
            o[n_] = __builtin_amdgcn_mfma_f32_16x16x32_bf16(pa_.v, vf_.v, o[n_], 0, 0, 0); } } MEMBAR(); } while (0)
    V_ISSUE(0, 0); V_ISSUE(1, 1);
    V_COMP(0, 0); V_ISSUE(2, 0); V_COMP(1, 1); V_ISSUE(3, 1); V_COMP(2, 0);
    if (LAT) { V_ISSUE(4, 0); V_COMP(3, 1); V_ISSUE(5, 1); V_COMP(4, 0); V_ISSUE(6, 0); V_COMP(5, 1); V_ISSUE(7, 1); V_COMP(6, 0); V_COMP(7, 1); }
    else V_COMP(3, 1);
#undef V_ISSUE
#undef V_COMP
#undef KEY0
    bf16_t* MIX = c.w<bf16_t>(WS_MIX);
#pragma unroll
    for (int j = 0; j < 4; ++j) {
        const float li = 1.f / shidx(ls, 4 * g + j);
        bf16_t* dst = MIX + (size_t)(b * TPB + q0 + 4 * g + j) * D + 512 + h * 64 + fr;
#pragma unroll
        for (int n = 0; n < 4; ++n) dst[16 * n] = f2bf(o[n][j] * li);
    }
}

__device__ __forceinline__ void phase_mix(const Ctx& c, int l) {
#pragma unroll 1
    for (int rep = 0; rep < (REP_PHASE == 41 ? 2 : 1); ++rep) if (c.wave == 0) { __builtin_amdgcn_s_setprio(3); rwkv_scan(c); __builtin_amdgcn_s_setprio(0); }
#pragma unroll 1
    for (int rep = 0; rep < (REP_PHASE == 42 ? 2 : 1); ++rep) if (c.wave == 1) { __builtin_amdgcn_s_setprio(3); hgrn_scan(c); __builtin_amdgcn_s_setprio(0); }
    if (c.G == 256) {
        const int x = c.bid & 7;
        unsigned* head = c.w<unsigned>(WS_CTL) + CW_ATT + (l * 8 + x) * 64;
        unsigned un = 0;
        if (c.lane == 0) un = __hip_atomic_fetch_add(head, 1u, __ATOMIC_RELAXED, __HIP_MEMORY_SCOPE_AGENT);
        for (;;) {
            const unsigned u = (unsigned)__builtin_amdgcn_readfirstlane((int)un);
            if (u >= 8 * 144) break;
            if (c.lane == 0) un = __hip_atomic_fetch_add(head, 1u, __ATOMIC_RELAXED, __HIP_MEMORY_SCOPE_AGENT);
            const int p = (int)u / 144, q = (int)u - p * 144, gp = p * 8 + x, b = gp >> 3, h = gp & 7;
            if (q < 128) attn_unit<true>(c, l, b, h, q >> 2, q & 3);
            else if (l < DEPTH - 1) attn_unit<false>(c, l, b, h, 0, q - 128);
        }
    } else {
        for (int u = c.bid * 8 + c.wave; u < 8192 + 1024; u += c.G * 8) {
            if (u < 8192) attn_unit<true>(c, l, u >> 10, (u >> 7) & 7, (u >> 2) & 31, u & 3);
            else { const int v = u - 8192; attn_unit<false>(c, l, v >> 7, (v >> 4) & 7, 0, v & 15); }
        }
    }
}

__device__ __forceinline__ void cvt_moe_group(const Ctx& c, int l, int task4) {
    LAS float* T = (LAS float*)c.lds;
    bf16_t* W1 = c.w<bf16_t>(WS_W1); bf16_t* W2 = c.w<bf16_t>(WS_W2);
    CvtJob jb[4];
#pragma unroll
    for (int q = 0; q < 4; ++q) {
        const int task = task4 * 4 + q; const int e = task / 384; int t = task - e * 384;
        if (t < 256) { const int up = t >> 7; t &= 127; const int kt = t >> 3, nt = t & 7; const int n0 = nt * 64, drow = (n0 >> 7) * 256 + (n0 & 127) + up * 128;
            jb[q].src = c.a->in[up ? 31 : 30] + (((size_t)l * 32 + e) * 1024 + kt * 64) * 512 + n0; jb[q].src_ld = 512; jb[q].dst = W1 + ((size_t)e * 1024 + drow) * 1024 + kt * 64; jb[q].dst_ld = 1024;
        } else { t -= 256; const int kt = t >> 4, nt = t & 15;
            jb[q].src = c.a->in[32] + (((size_t)l * 32 + e) * 512 + kt * 64) * 1024 + nt * 64; jb[q].src_ld = 1024; jb[q].dst = W2 + ((size_t)e * 1024 + nt * 64) * 512 + kt * 64; jb[q].dst_ld = 512;
        }
    }
    cvt_tile4(c, T, jb);
}

__device__ __forceinline__ void phase_post(const Ctx& c, int l) {
    const bf16_t* P = c.w<bf16_t>(WS_P); bf16_t* MIX = c.w<bf16_t>(WS_MIX);
    const bf16_t* O1 = c.w<bf16_t>(WS_O1); const bf16_t* O2 = c.w<bf16_t>(WS_O2); const bf16_t* YS = c.w<bf16_t>(WS_YS);
    const bf16_t* GG = c.w<bf16_t>(WS_G); const bf16_t* BON = c.w<bf16_t>(WS_BON);
    const int lane = c.lane;
    {
        const int ch = lane * 4, stride = c.G * 8;
        const f32x4 gn = *(const f32x4*)(c.a->in[11] + (size_t)l * 256 + ch), lg = *(const f32x4*)(c.a->in[21] + (size_t)l * 256 + ch), lb = *(const f32x4*)(c.a->in[22] + (size_t)l * 256 + ch);
        u32x2 pa, pbo, pgg, pgp, pb0, pb1, py0, py1;
#define POST_LOAD(r_) do { const size_t rr_ = (size_t)(r_); pa = *(const u32x2*)(O1 + rr_ * 256 + ch); pb0 = *(const u32x2*)(O2 + rr_ * 256 + ch); pb1 = *(const u32x2*)(O2 + ((size_t)MTOK + rr_) * 256 + ch); \
        pgp = *(const u32x2*)(P + rr_ * PT + PA_G + ch); py0 = *(const u32x2*)(YS + rr_ * 256 + ch); py1 = *(const u32x2*)(YS + ((size_t)MTOK + rr_) * 256 + ch); \
        pbo = *(const u32x2*)(BON + rr_ * 256 + ch); pgg = *(const u32x2*)(GG + rr_ * 256 + ch); } while (0)
        const bool lat_only = (l == DEPTH - 1); const int nrows = lat_only ? NB * SEQ : MTOK;
#define POST_ROW(i_) (lat_only ? ((i_) >> 11) * TPB + CTX + ((i_) & (SEQ - 1)) : (i_))
        POST_LOAD(POST_ROW(c.bid * 8 + c.wave));
        for (int ri = c.bid * 8 + c.wave; ri < nrows; ri += stride) {
            const int row = POST_ROW(ri);
            const u32x2 gp = pgp;
            const f32x4 a = {bflo(pa.x), bfhi(pa.x), bflo(pa.y), bfhi(pa.y)}, bo = {bflo(pbo.x), bfhi(pbo.x), bflo(pbo.y), bfhi(pbo.y)}, gg = {bflo(pgg.x), bfhi(pgg.x), bflo(pgg.y), bfhi(pgg.y)};
            const f32x4 b0 = {bflo(pb0.x), bfhi(pb0.x), bflo(pb0.y), bfhi(pb0.y)}, b1 = {bflo(pb1.x), bfhi(pb1.x), bflo(pb1.y), bfhi(pb1.y)};
            const f32x4 y0 = {bflo(py0.x), bfhi(py0.x), bflo(py0.y), bfhi(py0.y)}, y1 = {bflo(py1.x), bfhi(py1.x), bflo(py1.y), bfhi(py1.y)};
            POST_LOAD(ri + stride < nrows ? POST_ROW(ri + stride) : row);
            {
                const f32x4 o = a + b0 + b1;
                float ss = o[0] * o[0] + o[1] * o[1] + o[2] * o[2] + o[3] * o[3]; ss = red16(ss);
                const float inv = rsqrtf(ss * (1.f / 64.f) + 1e-6f);
                const float g0 = bflo(gp.x), g1 = bfhi(gp.x), g2 = bflo(gp.y), g3 = bfhi(gp.y);
                u32x2 w; w.x = pk2(o[0] * inv * gn[0] * g0 * sigm(g0), o[1] * inv * gn[1] * g1 * sigm(g1)); w.y = pk2(o[2] * inv * gn[2] * g2 * sigm(g2), o[3] * inv * gn[3] * g3 * sigm(g3));
                *(u32x2*)(MIX + (size_t)row * D + ch) = w;
            }
            {
                const f32x4 y = y0 + y1;
                float sm = y[0] + y[1] + y[2] + y[3]; sm = red16(sm); const float mean = sm * (1.f / 64.f);
                const f32x4 dv = y - mean;
                float vs = dv[0] * dv[0] + dv[1] * dv[1] + dv[2] * dv[2] + dv[3] * dv[3]; vs = red16(vs);
                const float inv = rsqrtf(vs * (1.f / 64.f) + 64e-5f);
                const f32x4 r = (dv * inv * lg + lb + bo) * gg;
                u32x2 w; w.x = pk2(r[0], r[1]); w.y = pk2(r[2], r[3]);
                *(u32x2*)(MIX + (size_t)row * D + 256 + ch) = w;
            }
        }
#undef POST_LOAD
#undef POST_ROW
    }
    __syncthreads();
    {
        const int first = c.G == 256 ? 640 : 0, nhere = (l < DEPTH - 1 && c.G == 256) ? 0 : 2048;
        for (int i = first + c.bid; i < nhere; i += c.G) cvt_moe_group(c, l, 96 * (i >> 6) + (i & 63));
    }
}

constexpr int WG_OFF = 140288;
__device__ __forceinline__ void phase_norm2(const Ctx& c, int l) {
    const float* MOD = c.w<float>(WS_MOD); const float* X = c.w<float>(WS_X); bf16_t* H = c.w<bf16_t>(WS_H);
    int4* ROUTE = c.w<int4>(WS_ROUTE); int* LIST = c.w<int>(WS_LIST); float* LISTW = c.w<float>(WS_LISTW);
    unsigned* CNT = c.w<unsigned>(WS_CTL) + CW_CNT + l * 64;
    const float* brg = c.a->in[27] + l * 4; const float* bre = c.a->in[29] + l * 32;
    LAS float* WE = (LAS float*)c.lds; LAS float* WG = (LAS float*)(c.lds + WG_OFF);
    LAS unsigned* lcnt = (LAS unsigned*)(c.lds + MISC_OFF + 1024); LAS unsigned* lbase = lcnt + 32; LAS int* rinfo = (LAS int*)(lcnt + 64);
    const int lane = c.lane;
    {
        const f32x4* wre4 = (const f32x4*)(c.a->in[28] + (size_t)l * 1024 * 32); const f32x4* wrg4 = (const f32x4*)(c.a->in[26] + (size_t)l * 1024 * 4);
        f32x4 wv[18];
#pragma unroll
        for (int i = 0; i < 16; ++i) wv[i] = wre4[c.tid + i * 512];
#pragma unroll
        for (int i = 0; i < 2; ++i) wv[16 + i] = wrg4[c.tid + i * 512];
#pragma unroll
        for (int i = 0; i < 16; ++i) { const int idx = c.tid + i * 512; const int k = idx >> 3, c4 = idx & 7, slot = ((k >> 8) * 4 + (k & 3)) * 64 + ((k >> 2) & 63);
            *(LAS f32x4*)(WE + ((size_t)((c4 >> 1) * 1024 + slot)) * 8 + (c4 & 1) * 4) = wv[i]; }
#pragma unroll
        for (int i = 0; i < 2; ++i) { const int k = c.tid + i * 512; const int slot = ((k >> 8) * 4 + (k & 3)) * 64 + ((k >> 2) & 63); *(LAS f32x4*)(WG + slot * 4) = wv[16 + i]; }
        if (c.tid < 32) lcnt[c.tid] = 0u;
    }
    __syncthreads();
    int nrow = 0;
    const int stride = c.G * 8;
    f32x4 gn4[4], xc[4], shc[4], scc[4];
    {
        const float* gain = c.a->in[5] + (size_t)l * D; const int row0 = c.bid * 8 + c.wave; const int b0 = row0 / TPB, s0 = row0 - b0 * TPB;
        const float* md0 = MOD + ((size_t)l * 9 + (s0 < CTX ? 8 : b0)) * 6144;
#pragma unroll
        for (int j = 0; j < 4; ++j) { const int col = lane * 4 + 256 * j; gn4[j] = *(const f32x4*)(gain + col);
            xc[j] = *(const f32x4*)(X + (size_t)row0 * D + col); shc[j] = *(const f32x4*)(md0 + 3072 + col); scc[j] = *(const f32x4*)(md0 + 4096 + col); }
    }
    for (int row = c.bid * 8 + c.wave; row < MTOK; row += stride) {
        const int b = row / TPB, s = row - b * TPB;
        f32x4 x[4], shv[4], scv[4];
#pragma unroll
        for (int j = 0; j < 4; ++j) { x[j] = xc[j]; shv[j] = shc[j]; scv[j] = scc[j]; }
        {
            const int rn = row + stride < MTOK ? row + stride : row; const int bn = rn / TPB, sn = rn - bn * TPB;
            const float* mdn = MOD + ((size_t)l * 9 + (sn < CTX ? 8 : bn)) * 6144;
#pragma unroll
            for (int j = 0; j < 4; ++j) { const int col = lane * 4 + 256 * j;
                xc[j] = *(const f32x4*)(X + (size_t)rn * D + col); shc[j] = *(const f32x4*)(mdn + 3072 + col); scc[j] = *(const f32x4*)(mdn + 4096 + col); }
        }
        if (l == DEPTH - 1 && s < CTX) continue;
        float ss = 0.f;
#pragma unroll
        for (int j = 0; j < 4; ++j) ss += x[j][0] * x[j][0] + x[j][1] * x[j][1] + x[j][2] * x[j][2] + x[j][3] * x[j][3];
        ss = red64(ss);
        const float inv = rsqrtf(ss * (1.f / 1024.f) + 1e-6f);
        f32x4 hv[4];
#pragma unroll
        for (int j = 0; j < 4; ++j) { const int col = lane * 4 + 256 * j;
            hv[j] = x[j] * inv * gn4[j] * (1.f + scv[j]) + shv[j];
            u32x2 o; o.x = pk2(hv[j][0], hv[j][1]); o.y = pk2(hv[j][2], hv[j][3]); *(u32x2*)(H + (size_t)row * D + col) = o; }
        f32x4 gl4 = {0.f, 0.f, 0.f, 0.f};
#pragma unroll
        for (int j = 0; j < 4; ++j)
#pragma unroll
            for (int e = 0; e < 4; ++e) gl4 += *(const LAS f32x4*)(WG + ((j * 4 + e) * 64 + lane) * 4) * hv[j][e];
        float gl[4];
#pragma unroll
        for (int q = 0; q < 4; ++q) gl[q] = red64(gl4[q]) + brg[q];
        int gs = 0; float gm = gl[0];
#pragma unroll
        for (int q = 1; q < 4; ++q) if (gl[q] > gm) { gm = gl[q]; gs = q; }
        gs = __builtin_amdgcn_readfirstlane(gs);
        const float gw = 1.f / (expf(gl[0] - gm) + expf(gl[1] - gm) + expf(gl[2] - gm) + expf(gl[3] - gm));
        f32x4 e0 = {0.f, 0.f, 0.f, 0.f}, e1 = e0;
        const LAS float* we = WE + ((size_t)gs * 1024 + lane) * 8;
#pragma unroll
        for (int j = 0; j < 4; ++j)
#pragma unroll
            for (int e = 0; e < 4; ++e) { const LAS float* wp = we + (j * 4 + e) * 64 * 8; e0 += *(const LAS f32x4*)wp * hv[j][e]; e1 += *(const LAS f32x4*)(wp + 4) * hv[j][e]; }
        float el[8];
#pragma unroll
        for (int q = 0; q < 4; ++q) { el[q] = red64(e0[q]) + bre[gs * 8 + q]; el[4 + q] = red64(e1[q]) + bre[gs * 8 + 4 + q]; }
        int i0 = 0; float m0 = el[0];
#pragma unroll
        for (int q = 1; q < 8; ++q) if (el[q] > m0) { m0 = el[q]; i0 = q; }
        int i1 = -1; float m1 = -3e38f;
#pragma unroll
        for (int q = 0; q < 8; ++q) if (q != i0 && el[q] > m1) { m1 = el[q]; i1 = q; }
        if (i1 < 0) i1 = (i0 + 1) & 7;
        const float p1 = expf(m1 - m0);
        const float wa = gw / (1.f + p1), wb = gw * p1 / (1.f + p1);
        if (lane == 0) {
            const int ea = gs * 8 + i0, eb = gs * 8 + i1;
            const int ra = (int)__hip_atomic_fetch_add(lcnt + ea, 1u, __ATOMIC_RELAXED, __HIP_MEMORY_SCOPE_WORKGROUP);
            const int rb = (int)__hip_atomic_fetch_add(lcnt + eb, 1u, __ATOMIC_RELAXED, __HIP_MEMORY_SCOPE_WORKGROUP);
            LAS int* ri = rinfo + (c.wave * 16 + nrow) * 8;
            ri[0] = ea; ri[1] = ra; ri[2] = eb; ri[3] = rb; ri[4] = __float_as_int(wa); ri[5] = __float_as_int(wb); ri[6] = row;
        }
        ++nrow;
    }
    __syncthreads();
    if (c.tid < 32) { const unsigned n = lcnt[c.tid]; lbase[c.tid] = n ? atomicAdd(CNT + c.tid, n) : 0u; }
    __syncthreads();
    if (lane < nrow) {
        const LAS int* ri = rinfo + (c.wave * 16 + lane) * 8;
        const int ea = ri[0], eb = ri[2], row = ri[6]; const int pa = (int)lbase[ea] + ri[1], pb = (int)lbase[eb] + ri[3];
        LIST[(size_t)ea * MTOK + pa] = row; LISTW[(size_t)ea * MTOK + pa] = __int_as_float(ri[4]);
        LIST[(size_t)eb * MTOK + pb] = row; LISTW[(size_t)eb * MTOK + pb] = __int_as_float(ri[5]);
        ROUTE[row] = make_int4(ea, pa, eb, pb);
    }
}

constexpr int NPHASE = 2 + 9 * DEPTH;

__global__ void __launch_bounds__(512, 2) mk_fwd(Args a) {
    extern __shared__ __attribute__((aligned(16))) unsigned char lds_raw[];
    Ctx c;
    c.a.in.a = (const __attribute__((address_space(4))) Args*)__builtin_amdgcn_kernarg_segment_ptr(); c.out = (float*)a.out; c.ws = a.ws; c.lds = (LAS unsigned char*)lds_raw;
    const int wave0 = __builtin_amdgcn_readfirstlane((int)threadIdx.x >> 6);
    { int t_; asm volatile("v_mbcnt_lo_u32_b32 %0, -1, 0\n\tv_mbcnt_hi_u32_b32 %0, -1, %0" : "=v"(t_)); c.tid = wave0 * 64 + t_; }
    c.lane = c.tid & 63; c.wave = wave0; c.bid = blockIdx.x; c.G = gridDim.x;
    const int lo = a.lo, hi = a.hi;
    if (c.tid < 4) ((LAS unsigned*)(c.lds + MISC_OFF))[c.tid] = 0u;
    __syncthreads();
    XcdBarrier bar; bar.bar = c.w<unsigned>(WS_CTL); bar.x = 0; bar.st = (volatile LAS unsigned*)(c.lds + MISC_OFF);
    if (hi - lo > 1) bar = xcd_barrier_post(c.w<unsigned>(WS_CTL), (volatile LAS unsigned*)(c.lds + MISC_OFF), (unsigned)c.tid);
#ifndef PH_ONLY
#define PH_ONLY -1
#endif
#define PHON(j) (PH_ONLY < 0 || PH_ONLY == (j))
#define IN(k) (lo <= (k) && (k) < hi)
#define SEAM(k) do { if (IN((k) + 1)) xcd_barrier(bar, (unsigned)c.tid); } while (0)
#define FRESH() do { const __attribute__((address_space(4))) Args* ap_ = (const __attribute__((address_space(4))) Args*)__builtin_amdgcn_kernarg_segment_ptr(); \
        GAS unsigned char* wp_ = ap_->ws; int t_; asm volatile("v_mbcnt_lo_u32_b32 %0, -1, 0\n\tv_mbcnt_hi_u32_b32 %0, -1, %0" : "=v"(t_)); t_ += wave0 * 64; asm volatile("" : "+s"(ap_), "+s"(wp_)); \
        c.a.in.a = ap_; c.out = (float*)ap_->out; c.ws = wp_; c.tid = t_; c.lane = t_ & 63; c.wave = __builtin_amdgcn_readfirstlane(t_ >> 6); } while (0)
#if REP_PHASE >= 0 && REP_PHASE <= 10
#define SITE(j, pidx, ...) if (PHON(j) && IN(pidx)) { int nrep_ = (REP_PHASE == (j)) ? 2 : 1; asm volatile("" : "+s"(nrep_)); \
        for (int rep_ = 0; rep_ < nrep_; ++rep_) { FRESH(); { __VA_ARGS__ } if (rep_ + 1 < nrep_) xcd_barrier(bar, (unsigned)c.tid); } SEAM(pidx); }
#else
#define SITE(j, pidx, ...) if (PHON(j) && IN(pidx)) { FRESH(); { __VA_ARGS__ } SEAM(pidx); }
#endif
    SITE(0, 0, phase_prologue(c);)
#pragma unroll 1
    for (int l = 0; l < DEPTH; ++l) {
        const int p0 = 1 + 9 * l;
        SITE(1, p0 + 0, phase_norm1(c, l);)
        SITE(2, p0 + 1,
            pg8::StaticOrder S; S.init(c.w<bf16_t>(WS_H), c.w<bf16_t>(WS_WIN) + (size_t)l * 4096 * 1024, MTOK, 4096, 1024, c.G, c.bid);
            pg8::EpiBf16Rows E{c.w<bf16_t>(WS_P), PT, PT};
            pg8::gemm_phase(c.lds, c.tid, S, E);
            if (c.G == 256 && c.bid >= 128) { __syncthreads();
                for (int j = 0; j < 5; ++j) { const int i = (c.bid - 128) * 5 + j; cvt_moe_group(c, l, 96 * (i >> 6) + (i & 63)); } })
        SITE(3, p0 + 2, phase_prep(c, l); __syncthreads(); if (REP_PHASE == 31) { FRESH(); phase_prep(c, l); __syncthreads(); }
                        FRESH(); phase_prep_hgrn(c, l); __syncthreads(); if (REP_PHASE == 32) { FRESH(); phase_prep_hgrn(c, l); __syncthreads(); }
                        FRESH(); phase_prep_rwkv(c, l); if (REP_PHASE == 33) { __syncthreads(); FRESH(); phase_prep_rwkv(c, l); }
)
        SITE(4, p0 + 3, phase_mix(c, l);)
        SITE(5, p0 + 4, phase_post(c, l);)
        SITE(6, p0 + 5,
            pg8::StaticOrder S; S.init(c.w<bf16_t>(WS_MIX), c.w<bf16_t>(WS_WOUT) + (size_t)l * 1024 * 1024, MTOK, 1024, 1024, c.G, c.bid, l == DEPTH - 1);
            pg8::EpiX E{c.w<float>(WS_X), c.w<float>(WS_MOD) + (size_t)l * 9 * 6144 + 2048};
            pg8::gemm_phase(c.lds, c.tid, S, E);
            if (l < DEPTH - 1 && c.G == 256 && c.bid >= 32) { __syncthreads();
                for (int j = 0; j < 7; ++j) { const int i = 640 + (c.bid - 32) * 7 + j; if (i < 2048) cvt_moe_group(c, l, 96 * (i >> 6) + (i & 63)); } })
        SITE(7, p0 + 6, phase_norm2(c, l);)
        SITE(8, p0 + 7,
            build_tpre(c, l);
            pg8::MoeOrder<true> S{(const char*)c.w<bf16_t>(WS_H), (const char*)c.w<bf16_t>(WS_W1), 1024, c.w<int>(WS_LIST), (const LAS int*)(c.lds + MISC_OFF + 64), (const LAS int*)(c.lds + MISC_OFF + 256), c.G, c.bid};
            pg8::EpiHid E{c.w<bf16_t>(WS_HID), c.w<float>(WS_LISTW)};
            pg8::gemm_phase(c.lds, c.tid, S, E);
            {
                unsigned* tk = c.w<unsigned>(WS_CTL) + CW_CVT + l * 64; LAS int* tl = (LAS int*)(c.lds + MISC_OFF + 32);
                for (;;) { __syncthreads();
                    if (c.tid == 0) *tl = (int)__hip_atomic_fetch_add(tk, 1u, __ATOMIC_RELAXED, __HIP_MEMORY_SCOPE_AGENT);
                    __syncthreads();
                    const int j = __builtin_amdgcn_readfirstlane(*tl); if (j >= 1024) break;
                    cvt_moe_group(c, l, 96 * (j >> 5) + 64 + (j & 31)); } })
        SITE(9, p0 + 8,
            build_tpre(c, l);
            pg8::MoeOrder<false> S{(const char*)c.w<bf16_t>(WS_HID), (const char*)c.w<bf16_t>(WS_W2), 512, c.w<int>(WS_LIST), (const LAS int*)(c.lds + MISC_OFF + 64), (const LAS int*)(c.lds + MISC_OFF + 256), c.G, c.bid};
            pg8::EpiBf16Rows E{c.w<bf16_t>(WS_Y), 1024, 1024};
            pg8::gemm_phase(c.lds, c.tid, S, E);)
    }
    SITE(10, NPHASE - 1, phase_norm1(c, DEPTH);)
#undef SITE
#undef IN
#undef SEAM
}

extern "C" void kernel_launch(void* const* d_in, const int* in_sizes, int n_in, void* d_out, int out_size, void* d_ws, size_t ws_size, hipStream_t stream) {
    static int grid = 0;
    if (grid == 0) {
        if (n_in != 33 || ws_size < WS_END2) { fprintf(stderr, "kernel_launch: unexpected n_in %d / ws %zu (need %zu)\n", n_in, ws_size, (size_t)WS_END2); grid = -1; return; }
        int dev = 0, cus = 0, per_cu = 0;
        hipGetDevice(&dev); hipDeviceGetAttribute(&cus, hipDeviceAttributeMultiprocessorCount, dev);
        if (hipFuncSetAttribute((const void*)mk_fwd, hipFuncAttributeMaxDynamicSharedMemorySize, LDS_BYTES) != hipSuccess) { fprintf(stderr, "kernel_launch: hipFuncSetAttribute failed\n"); grid = -1; return; }
        hipOccupancyMaxActiveBlocksPerMultiprocessor(&per_cu, (const void*)mk_fwd, 512, LDS_BYTES);
        (void)hipGetLastError();
        if (per_cu < 1) fprintf(stderr, "kernel_launch: occupancy query reports %d\n", per_cu);
        grid = cus > 0 ? cus : 256;
    }
    if (grid < 0) return;
    hipMemsetAsync((char*)d_ws + WS_CTL, 0, CTL_BYTES, stream);
    Args a{};
    for (int i = 0; i < 33; ++i) a.in.p[i] = (const GAS float*)d_in[i];
    a.out = (GAS float*)d_out; a.ws = (GAS unsigned char*)d_ws;
#if MK_SPLIT
    for (int p = 0; p < NPHASE; ++p) { a.lo = p; a.hi = p + 1; hipLaunchKernelGGL(mk_fwd, dim3(grid), dim3(512), LDS_BYTES, stream, a); }
#else
    a.lo = 0; a.hi = NPHASE; hipLaunchKernelGGL(mk_fwd, dim3(grid), dim3(512), LDS_BYTES, stream, a);
#endif
}
```

```cpp
#include <hip/hip_runtime.h>
#include <cstdio>
#include <cstdint>

#ifndef MK_SPLIT
#define MK_SPLIT 0
#endif

#ifndef REP_PHASE
#define REP_PHASE -1
#endif

#define LAS __attribute__((address_space(3)))
typedef unsigned short bf16_t;
typedef short  bf16x8 __attribute__((ext_vector_type(8)));
typedef short  bf16x4 __attribute__((ext_vector_type(4)));
typedef float  f32x4  __attribute__((ext_vector_type(4)));
typedef unsigned u32x4 __attribute__((ext_vector_type(4)));
typedef unsigned u32x2 __attribute__((ext_vector_type(2)));

constexpr int D = 1024, NB = 8, SEQ = 2048, CTX = 256, TPB = 2304, MTOK = NB * TPB, DEPTH = 4, PT = 3968;
constexpr int NEXP = 32, DF = 512, HIDROWS = 45056;
constexpr int NBLK16 = TPB / 16;
constexpr int PA_Q = 0, PA_FF = 256, PA_FB = 512, PA_I = 768, PA_G = 1024, PB0 = 1280, PC_Q = 2432, PC_K = 2944, PC_V = 3456;

constexpr size_t WS_CTL = 0, CTL_BYTES = 65536;
constexpr size_t WS_MOD = 65536;
constexpr size_t WS_LB = WS_MOD + 884736;
constexpr size_t WS_ROPE = WS_LB + 8192;
constexpr size_t WS_LORA = WS_ROPE + 8192;
constexpr size_t LORA_L = 196608;
constexpr size_t WS_ROUTE = WS_LORA + 4 * LORA_L;
constexpr size_t WS_LIST = WS_ROUTE + 294912;
constexpr size_t WS_LISTW = WS_LIST + 2359296;
constexpr size_t WS_WIN = 8388608;
constexpr size_t WS_WOUT = WS_WIN + 33554432;
constexpr size_t WS_W1 = WS_WOUT + 8388608;
constexpr size_t WS_W2 = WS_W1 + 67108864;
constexpr size_t WS_X = WS_W2 + 33554432;
constexpr size_t WS_H = WS_X + 75497472;
constexpr size_t WS_MIX = WS_H + 37748736;
constexpr size_t WS_P = WS_MIX + 37748736;
constexpr size_t WS_MR = WS_P + 146276352;
constexpr size_t SZ_T512 = 18874368;
constexpr size_t WS_QN = WS_MR, WS_KN = WS_QN + SZ_T512, WS_VT = WS_KN + SZ_T512;
constexpr size_t WS_QIN = WS_VT + SZ_T512;
constexpr size_t WS_KOT = WS_QIN + SZ_T512;
constexpr size_t WS_IT = WS_KOT + SZ_T512;
constexpr size_t WS_DEC = WS_IT + 9437184;
constexpr size_t WS_O1 = WS_DEC + 2359296;
constexpr size_t WS_O2 = WS_O1 + SZ_T512;
constexpr size_t WS_RW = WS_O2 + 2 * SZ_T512;
constexpr size_t WS_G = WS_RW + 226492416;
constexpr size_t WS_BON = WS_G + SZ_T512;
constexpr size_t WS_YS = WS_BON + SZ_T512;
constexpr size_t WS_END = WS_YS + 2 * SZ_T512;
constexpr size_t WS_Y = WS_P, WS_HID = WS_MR;
constexpr size_t WS_KHT = WS_END;
constexpr size_t WS_AHT = WS_KHT + 18874368;
constexpr size_t WS_GC = WS_AHT + 18874368;
constexpr size_t WS_RH = WS_GC + 2359296;
constexpr size_t WS_WY = WS_RH + 18874368;
constexpr size_t WS_END2 = WS_WY + 4718592;
constexpr size_t WS_ZT = WS_H;
constexpr size_t WS_VT2 = WS_H + 18874368;
static_assert(WS_END2 < (size_t)1000 * 1000 * 1000, "workspace");
constexpr int CW_CNT = 4096;
constexpr int CW_CVT = 12288;
constexpr int CW_ATT = 8192;

constexpr int LDS_BYTES = 163840, MISC_OFF = 131072;

#define XB_TMO      128
#define XB_XCNT(j)  (256  + 64 * (j))
#define XB_XSUB(j)  (1280 + 64 * (j))
#define XB_XGEN(j)  (2304 + 64 * (j))
#define XB_TOP      3328
#define XB_TOPGEN   3392
#define XCD_BAR_WORDS 3456
#define XB_SPIN_CAP (1u << 18)
__device__ __forceinline__ unsigned xb_ld(unsigned* p)              { return __hip_atomic_load(p, __ATOMIC_RELAXED, __HIP_MEMORY_SCOPE_AGENT); }
__device__ __forceinline__ unsigned xb_add(unsigned* p, unsigned v) { return __hip_atomic_fetch_add(p, v, __ATOMIC_RELAXED, __HIP_MEMORY_SCOPE_AGENT); }
__device__ __forceinline__ unsigned xb_xcc_id() { return (unsigned)__builtin_amdgcn_s_getreg((3 << 11) | 20) & 0xFu; }
#define XB_SPIN(cond, bar) do { unsigned _sp = 0; while (cond) { __builtin_amdgcn_s_sleep(1); \
    if ((++_sp & 255u) == 0u) { if (xb_ld(&(bar)[XB_TMO])) break; if (_sp > XB_SPIN_CAP) { atomicAdd(&(bar)[XB_TMO], 1u); break; } } } } while (0)
struct XcdBarrier { unsigned* bar; unsigned x; volatile LAS unsigned* st; };
__device__ __forceinline__ XcdBarrier xcd_barrier_post(unsigned* bar, volatile LAS unsigned* st, const unsigned tidx) {
    XcdBarrier b; b.bar = bar; b.x = xb_xcc_id(); b.st = st;
    if (tidx == 0) (void)xb_add(&bar[XB_XCNT(b.x)], 1u);
    return b;
}
__device__ __forceinline__ void xcd_barrier_complete(unsigned* bar, unsigned x, unsigned& nloc, unsigned& nx) {
    const unsigned G = gridDim.x * gridDim.y * gridDim.z;
    unsigned sum, cnt, mine, sp = 0u;
    for (;;) {
        sum = 0u; cnt = 0u; mine = 0u;
#pragma unroll
        for (unsigned j = 0; j < 16; ++j) { const unsigned c = xb_ld(&bar[XB_XCNT(j)]); sum += c; cnt += (c > 0u) ? 1u : 0u; mine = (j == x) ? c : mine; }
        if (sum == G) break;
        __builtin_amdgcn_s_sleep(1);
        if ((++sp & 255u) == 0u) { if (xb_ld(&bar[XB_TMO])) break; if (sp > XB_SPIN_CAP) { atomicAdd(&bar[XB_TMO], 1u); break; } }
    }
    nloc = mine > 0u ? mine : 1u; nx = cnt > 0u ? cnt : 1u;
}
__device__ __forceinline__ void xcd_barrier(const XcdBarrier& b, const unsigned tidx) {
    asm volatile("s_waitcnt vmcnt(0)" ::: "memory");
    __syncthreads();
    if (tidx == 0) {
        unsigned* bar = b.bar;
        __builtin_amdgcn_s_waitcnt(0);
        unsigned nloc = b.st[0], nx = b.st[1];
        if (nloc == 0u) { xcd_barrier_complete(bar, b.x, nloc, nx); b.st[0] = nloc; b.st[1] = nx; }
        const unsigned old = xb_add(&bar[XB_XSUB(b.x)], 1u);
        const unsigned gen = old / nloc;
        if (old + 1u == (gen + 1u) * nloc) {
            __builtin_amdgcn_fence(__ATOMIC_RELEASE, "agent");
            asm volatile("s_waitcnt vmcnt(0)" ::: "memory");
            const unsigned og = xb_add(&bar[XB_TOP], 1u);
            const unsigned tg = og / nx;
            if (og + 1u == (tg + 1u) * nx) xb_add(&bar[XB_TOPGEN], 1u);
            else XB_SPIN(xb_ld(&bar[XB_TOPGEN]) == tg, bar);
            __builtin_amdgcn_fence(__ATOMIC_ACQUIRE, "agent");
            xb_add(&bar[XB_XGEN(b.x)], 1u);
            asm volatile("s_waitcnt vmcnt(0)" ::: "memory");
        } else {
            XB_SPIN(xb_ld(&bar[XB_XGEN(b.x)]) == gen, bar);
            __builtin_amdgcn_fence(__ATOMIC_ACQUIRE, "agent");
            asm volatile("s_waitcnt vmcnt(0)" ::: "memory");
        }
    }
    __syncthreads();
}

__device__ __forceinline__ float bf2f(bf16_t b) { return __uint_as_float(((unsigned)b) << 16); }
__device__ __forceinline__ float bflo(unsigned u) { return __uint_as_float(u << 16); }
__device__ __forceinline__ float bfhi(unsigned u) { return __uint_as_float(u & 0xffff0000u); }
typedef float f32x2c __attribute__((ext_vector_type(2)));
typedef __bf16 bf16x2c __attribute__((ext_vector_type(2)));
__device__ __forceinline__ unsigned pk2(float lo, float hi) { const f32x2c v = {lo, hi}; const bf16x2c b = __builtin_convertvector(v, bf16x2c); return __builtin_bit_cast(unsigned, b); }
__device__ __forceinline__ unsigned pk2m(float lo, float hi) { return pk2(lo, hi); }
__device__ __forceinline__ bf16_t f2bf(float f) { return (bf16_t)pk2(f, f); }
__device__ __forceinline__ float sigm(float x) { return 1.f / (1.f + __expf(-x)); }
template <int CTRL> __device__ __forceinline__ float dppf(float x) { return __int_as_float(__builtin_amdgcn_update_dpp(0, __float_as_int(x), CTRL, 0xF, 0xF, true)); }
__device__ __forceinline__ float red4(float x) { x += dppf<0xB1>(x); x += dppf<0x4E>(x); return x; }
__device__ __forceinline__ float red8(float x) { x = red4(x); x += dppf<0x141>(x); return x; }
__device__ __forceinline__ float red16(float x) { x = red8(x); x += dppf<0x140>(x); return x; }
__device__ __forceinline__ int lane_now() { int t; asm volatile("v_mbcnt_lo_u32_b32 %0, -1, 0\n\tv_mbcnt_hi_u32_b32 %0, -1, %0" : "=v"(t)); return t; }
__device__ __forceinline__ float shx(float x, int m) { return __int_as_float(__builtin_amdgcn_ds_bpermute((lane_now() ^ m) << 2, __float_as_int(x))); }
__device__ __forceinline__ float shidx(float x, int idx) { return __int_as_float(__builtin_amdgcn_ds_bpermute(idx << 2, __float_as_int(x))); }
__device__ __forceinline__ float red64(float x) { x = red16(x); x += shx(x, 16); x += shx(x, 32); return x; }

#if defined(__HIP_DEVICE_COMPILE__)
#define GAS __attribute__((address_space(1)))
#else
#define GAS
#endif
struct InPtrs { const GAS float* p[33]; };
struct Args { InPtrs in; GAS float* out; GAS unsigned char* ws; int lo, hi; };
struct InView {
    const __attribute__((address_space(4))) Args* a;
    __device__ __forceinline__ const float* operator[](int i) const { return (const float*)a->in.p[i]; }
};
struct ArgView { InView in; __device__ __forceinline__ const ArgView* operator->() const { return this; } };
#define MEMBAR() asm volatile("" ::: "memory")
struct Ctx {
    ArgView a; float* out; GAS unsigned char* ws; LAS unsigned char* lds;
    int tid, lane, wave, bid, G;
    template <class T> __device__ __forceinline__ T* w(size_t off) const { return (T*)(ws + off); }
};

namespace pg8 {
constexpr int MISC_OFF = 131072; constexpr int BM = 256, BK = 64, HALF = 128, HTB = HALF * BK * 2, STAGE_BYTES = 8 * HTB, NXCD = 8, WGM = 8;
__device__ __forceinline__ int lds_byte(int r, int c) { const int st = (r >> 4) * 2 + (c >> 5), rr = r & 15, cc = c & 31, ob = rr * 64 + cc * 2; return st * 1024 + (ob ^ (((ob >> 9) & 1) << 5)); }
__device__ __forceinline__ void stage_rc(int b, int& R, int& C) { const int st = b / 1024, sb = b % 1024, swz = sb ^ (((sb >> 9) & 1) << 5); R = (st >> 1) * 16 + swz / 64; C = (st & 1) * 32 + (swz % 64) / 2; }
__device__ __forceinline__ int perm32(int rho) { const int n = rho >> 4, i = rho & 15; return 8 * (i >> 2) + 4 * n + (i & 3); }
struct Unit { int pm, pn, e, mt, cnt; };

struct StaticOrder {
    static constexpr bool GATHER_A = false;
    const char* A; const char* Bt; int K; int nM, nN, nwg, G, c; bool skip_ctx;
    __device__ __forceinline__ void init(const void* A_, const void* Bt_, int M, int N, int K_, int G_, int c_, bool skip_ctx_ = false) { A = (const char*)A_; Bt = (const char*)Bt_; K = K_; skip_ctx = skip_ctx_; nM = skip_ctx_ ? 64 : M / BM; nN = N / BM; nwg = nM * nN; G = G_; c = c_; }
    __device__ __forceinline__ bool next(int i, Unit& u) const {
        const long L = (long)i * G + c; if (L >= nwg) return false;
        int wgid = (int)L; { const int q = nwg / NXCD, r = nwg % NXCD, xcd = wgid % NXCD, off = wgid / NXCD; wgid = (xcd < r ? xcd * (q + 1) : r * (q + 1) + (xcd - r) * q) + off; }
        const int nig = WGM * nN, gid = wgid / nig, fm = gid * WGM, gsz = (nM - fm) < WGM ? (nM - fm) : WGM;
        u.pm = fm + ((wgid % nig) % gsz); u.pn = (wgid % nig) / gsz; u.e = 0; u.mt = 0; u.cnt = 0;
        if (skip_ctx) u.pm = u.pm + (u.pm >> 3) + 1;
        return true;
    }
    __device__ __forceinline__ const char* a_base(const Unit& u) const { return A + (size_t)u.pm * BM * K * 2; }
    __device__ __forceinline__ const char* b_base(const Unit& u) const { return Bt + (size_t)u.pn * BM * K * 2; }
    __device__ __forceinline__ void a_offs(const Unit&, int tid, unsigned (&vo)[2][2]) const {
#pragma unroll
        for (int i = 0; i < 2; ++i) { int R, C; stage_rc(tid * 16 + i * 8192, R, C);
#pragma unroll
            for (int h = 0; h < 2; ++h) vo[h][i] = (unsigned)((h * HALF + R) * K + C) * 2u; }
    }
};
template <bool GATHER> struct MoeOrder {
    static constexpr bool GATHER_A = GATHER;
    const char* A; const char* Bt; int K; const int* list; const LAS int* tp; const LAS int* cn; int G, c;
    __device__ __forceinline__ bool next(int i, Unit& u) const {
        if ((G & 7) == 0) {
            const int xcd = c & 7; int j = i * (G >> 3) + (c >> 3);
#pragma unroll 1
            for (int q = 0; q < 4; ++q) { const int e = xcd + 8 * q; const int t0 = __builtin_amdgcn_readfirstlane(tp[e]), t1 = __builtin_amdgcn_readfirstlane(tp[e + 1]); const int nu = 4 * (t1 - t0);
                if (j < nu) { u.e = e; u.mt = j >> 2; u.pn = j & 3; u.pm = t0 + u.mt; u.cnt = __builtin_amdgcn_readfirstlane(cn[e]); return true; }
                j -= nu; }
            return false;
        }
        const int L = i * G + c; if (L >= 4 * __builtin_amdgcn_readfirstlane(tp[32])) return false;
        const int tile = L >> 2; u.pn = L & 3; u.pm = tile;
        int e = 0;
#pragma unroll 1
        for (; e < 31; ++e) if (tile < __builtin_amdgcn_readfirstlane(tp[e + 1])) break;
        u.e = e; u.mt = tile - __builtin_amdgcn_readfirstlane(tp[e]); u.cnt = __builtin_amdgcn_readfirstlane(cn[e]); return true;
    }
    __device__ __forceinline__ const char* a_base(const Unit& u) const { return GATHER ? A : A + (size_t)u.pm * BM * K * 2; }
    __device__ __forceinline__ const char* b_base(const Unit& u) const { return Bt + ((size_t)u.e * 1024 + (size_t)u.pn * BM) * K * 2; }
    __device__ __forceinline__ void a_offs(const Unit& u, int tid, unsigned (&vo)[2][2]) const {
#pragma unroll
        for (int i = 0; i < 2; ++i) { int R, C; stage_rc(tid * 16 + i * 8192, R, C);
#pragma unroll
            for (int h = 0; h < 2; ++h) {
                int row = h * HALF + R;
                if (GATHER) { const int idx = u.mt * BM + row; row = idx < u.cnt ? list[(size_t)u.e * MTOK + idx] : 0; }
                vo[h][i] = (unsigned)(row * K + C) * 2u;
            } }
    }
};

struct EpiBf16Rows {
    static constexpr bool PERM = true;
    bf16_t* O; int ldc; int ncols;
    __device__ __forceinline__ void operator()(const f32x4 (&acc)[2][2][4][2], const Unit& u, int wr, int wc, int fr, int fq) const {
        const int row0 = u.pm * BM + wr * 64 + fr, col0 = u.pn * BM + wc * 32 + 8 * fq;
#pragma unroll
        for (int ai = 0; ai < 2; ++ai)
#pragma unroll
            for (int m = 0; m < 4; ++m) { bf16_t* rowp = O + (size_t)(row0 + ai * HALF + m * 16) * ldc + col0;
#pragma unroll
                for (int bj = 0; bj < 2; ++bj) { if (u.pn * BM + bj * HALF >= ncols) continue;
                    const f32x4 v0 = acc[ai][bj][m][0], v1 = acc[ai][bj][m][1];
                    u32x4 w; w.x = pk2(v0[0], v0[1]); w.y = pk2(v0[2], v0[3]); w.z = pk2(v1[0], v1[1]); w.w = pk2(v1[2], v1[3]);
                    *(u32x4*)(rowp + bj * HALF) = w; } }
    }
};
struct EpiX {
    static constexpr bool PERM = false;
    float* X; const float* gate;
    __device__ __forceinline__ void operator()(const f32x4 (&acc)[2][2][4][2], const Unit& u, int wr, int wc, int fr, int fq) const {
        const int row0 = u.pm * BM + wr * 64 + fr, col0 = u.pn * BM + wc * 32 + 4 * fq;
        const int bb = u.pm / 9, mrow = (u.pm - bb * 9 == 0) ? 8 : bb;
        const float* g = gate + (size_t)mrow * 6144 + col0;
        f32x4 gv[2][2];
#pragma unroll
        for (int bj = 0; bj < 2; ++bj)
#pragma unroll
            for (int n = 0; n < 2; ++n) gv[bj][n] = *(const f32x4*)(g + bj * HALF + n * 16);
#pragma unroll
        for (int ai = 0; ai < 2; ++ai)
#pragma unroll
            for (int m = 0; m < 4; ++m) { float* rowp = X + (size_t)(row0 + ai * HALF + m * 16) * D + col0;
#pragma unroll
                for (int bj = 0; bj < 2; ++bj)
#pragma unroll
                    for (int n = 0; n < 2; ++n) { f32x4* p = (f32x4*)(rowp + bj * HALF + n * 16); *p = *p + gv[bj][n] * acc[ai][bj][m][n]; } }
    }
};
struct EpiHid {
    static constexpr bool PERM = true;
    bf16_t* O; const float* listw;
    __device__ __forceinline__ void operator()(const f32x4 (&acc)[2][2][4][2], const Unit& u, int wr, int wc, int fr, int fq) const {
        const int col0 = u.pn * HALF + wc * 32 + 8 * fq;
#pragma unroll
        for (int ai = 0; ai < 2; ++ai)
#pragma unroll
            for (int m = 0; m < 4; ++m) {
                const int r = ai * HALF + wr * 64 + m * 16 + fr, idx = u.mt * BM + r;
                const float w = idx < u.cnt ? listw[(size_t)u.e * MTOK + idx] : 0.f;
                const f32x4 g0 = acc[ai][0][m][0], g1 = acc[ai][0][m][1], u0 = acc[ai][1][m][0], u1 = acc[ai][1][m][1];
                float h[8];
#pragma unroll
                for (int j = 0; j < 4; ++j) { h[j] = g0[j] * sigm(g0[j]) * u0[j] * w; h[4 + j] = g1[j] * sigm(g1[j]) * u1[j] * w; }
                u32x4 o; o.x = pk2(h[0], h[1]); o.y = pk2(h[2], h[3]); o.z = pk2(h[4], h[5]); o.w = pk2(h[6], h[7]);
                *(u32x4*)(O + (size_t)(u.pm * BM + r) * DF + col0) = o;
                asm volatile("" ::: "memory"); }
    }
};

template <class Epi, class Sched>
__device__ __forceinline__ void gemm_phase(LAS unsigned char* lds, const int tid, const Sched& S, const Epi& E) {
    const int wid = __builtin_amdgcn_readfirstlane(tid >> 6), lane = tid & 63, wr = wid >> 2, wc = wid & 3, fr = lane & 15, fq = lane >> 4;
    const int K = S.K, nt = K / BK;
    unsigned voffB[2];
#pragma unroll
    for (int i = 0; i < 2; ++i) { int Rr, Cc; stage_rc(tid * 16 + i * 8192, Rr, Cc); const int Rb = Epi::PERM ? ((Rr & ~31) + perm32(Rr & 31)) : Rr; voffB[i] = (unsigned)(Rb * K + Cc) * 2u; }
    const size_t kstep = (size_t)(BK * 2);
    const size_t hstep = (size_t)HALF * K * 2;
    const unsigned ldsw = (unsigned)wid * 1024u;
    const int aoff = lds_byte(wr * 64 + fr, fq * 8), boff = lds_byte(wc * 32 + fr, fq * 8);
#define PG8_SA(b, h) (((b) * 2 + (h)) * HTB)
#define PG8_SB(b, h) ((4 + (b) * 2 + (h)) * HTB)
#define PG8_STAGE2(bufoff, gbase, o0, o1) do { \
        __builtin_amdgcn_global_load_lds((const unsigned*)((const char*)(gbase) + (o0)), (LAS unsigned*)(lds + (bufoff) + ldsw), 16, 0, 0); \
        __builtin_amdgcn_global_load_lds((const unsigned*)((const char*)(gbase) + (o1)), (LAS unsigned*)(lds + (bufoff) + ldsw + 8192), 16, 0, 0); } while (0)
#define PG8_STAGEB(bufoff, gbase) PG8_STAGE2(bufoff, gbase, voffB[0], voffB[1])
#define PG8_LDA(dst, b, h) do { _Pragma("unroll") for (int m = 0; m < 4; ++m) _Pragma("unroll") for (int k = 0; k < 2; ++k) dst[m][k] = *(const LAS bf16x8*)(lds + PG8_SA(b, h) + aoff + m * 2048 + k * 1024); } while (0)
#define PG8_LDB(dst, b, h) do { _Pragma("unroll") for (int n = 0; n < 2; ++n) _Pragma("unroll") for (int k = 0; k < 2; ++k) dst[n][k] = *(const LAS bf16x8*)(lds + PG8_SB(b, h) + boff + n * 2048 + k * 1024); } while (0)
#define PG8_MMA(ai, bj, At, Bt) do { __builtin_amdgcn_s_setprio(1); _Pragma("unroll") for (int m = 0; m < 4; ++m) _Pragma("unroll") for (int n = 0; n < 2; ++n) _Pragma("unroll") for (int k = 0; k < 2; ++k) \
        acc[ai][bj][m][n] = __builtin_amdgcn_mfma_f32_16x16x32_bf16(Bt[n][k], At[m][k], acc[ai][bj][m][n], 0, 0, 0); __builtin_amdgcn_s_setprio(0); } while (0)
#define PG8_WAIT_V(n) asm volatile("s_waitcnt vmcnt(" #n ")" ::: "memory")
#define PG8_WAIT_L(n) asm volatile("s_waitcnt lgkmcnt(" #n ")" ::: "memory")
#define PG8_BAR __builtin_amdgcn_s_barrier()
#define PG8_SCHED __builtin_amdgcn_sched_barrier(0)
    Unit cur, nxt; int ui = 0;
    if (!S.next(0, cur)) return;
    f32x4 acc[2][2][4][2];
#pragma unroll
    for (int a = 0; a < 2; ++a)
#pragma unroll
        for (int b = 0; b < 2; ++b)
#pragma unroll
            for (int m = 0; m < 4; ++m)
#pragma unroll
                for (int n = 0; n < 2; ++n) acc[a][b][m][n] = (f32x4){0.f, 0.f, 0.f, 0.f};
    bf16x8 At[4][2], B0[2][2], B1[2][2];
    unsigned vo[2][2];
    LAS u32x4* stash = (LAS u32x4*)(lds + MISC_OFF + 1024) + tid;
    S.a_offs(cur, tid, vo);
    const char* cA = S.a_base(cur); const char* cB = S.b_base(cur);
    PG8_STAGEB(PG8_SB(0, 0), cB); PG8_STAGE2(PG8_SA(0, 0), cA, vo[0][0], vo[0][1]); PG8_STAGEB(PG8_SB(0, 1), cB + hstep); PG8_STAGE2(PG8_SA(0, 1), cA, vo[1][0], vo[1][1]);
    if (wr == 1) PG8_BAR;
    PG8_WAIT_V(4); PG8_BAR;
    PG8_STAGEB(PG8_SB(1, 0), cB + kstep); PG8_STAGE2(PG8_SA(1, 0), cA + kstep, vo[0][0], vo[0][1]); PG8_STAGEB(PG8_SB(1, 1), cB + hstep + kstep);
    PG8_WAIT_V(6); PG8_BAR;
    for (;;) {
        const bool has_next = S.next(ui + 1, nxt);
        const char* nA = cA; const char* nB = cB;
        if (has_next) { nA = S.a_base(nxt); nB = S.b_base(nxt); }
        if constexpr (Sched::GATHER_A) { unsigned nvo[2][2];
            if (has_next) S.a_offs(nxt, tid, nvo); else { nvo[0][0] = vo[0][0]; nvo[0][1] = vo[0][1]; nvo[1][0] = vo[1][0]; nvo[1][1] = vo[1][1]; }
            *stash = (u32x4){nvo[0][0], nvo[0][1], nvo[1][0], nvo[1][1]}; }
        for (int t = 0; t < nt; t += 2) {
            const bool last = (t == nt - 2);
            const char* a1 = cA + (size_t)(t + 1) * kstep;
            const char* a2 = last ? nA : cA + (size_t)(t + 2) * kstep; const char* b2 = last ? nB : cB + (size_t)(t + 2) * kstep;
            const char* a3 = a2 + kstep; const char* b3 = b2 + kstep;
            unsigned s00 = vo[0][0], s01 = vo[0][1], s10 = vo[1][0], s11 = vo[1][1];
            if constexpr (Sched::GATHER_A) { if (last) { const u32x4 nv = *stash; s00 = nv.x; s01 = nv.y; s10 = nv.z; s11 = nv.w; } }
            PG8_LDB(B0, 0, 0); PG8_SCHED; PG8_LDA(At, 0, 0); PG8_STAGE2(PG8_SA(1, 1), a1, vo[1][0], vo[1][1]);
            PG8_WAIT_L(8); PG8_BAR; PG8_WAIT_L(0); PG8_MMA(0, 0, At, B0); PG8_BAR; PG8_SCHED;
            PG8_LDB(B1, 0, 1); PG8_STAGEB(PG8_SB(0, 0), b2);
            PG8_BAR; PG8_WAIT_L(0); PG8_MMA(0, 1, At, B1); PG8_BAR;
            PG8_LDA(At, 0, 1); PG8_STAGE2(PG8_SA(0, 0), a2, s00, s01);
            PG8_BAR; PG8_WAIT_L(0); PG8_MMA(1, 0, At, B0); PG8_BAR; PG8_SCHED;
            PG8_STAGEB(PG8_SB(0, 1), b2 + hstep);
            PG8_WAIT_V(6); PG8_BAR; PG8_MMA(1, 1, At, B1); PG8_BAR;
            PG8_LDB(B0, 1, 0); PG8_SCHED; PG8_LDA(At, 1, 0); PG8_STAGE2(PG8_SA(0, 1), a2, s10, s11);
            PG8_WAIT_L(8); PG8_BAR; PG8_WAIT_L(0); PG8_MMA(0, 0, At, B0); PG8_BAR; PG8_SCHED;
            PG8_LDB(B1, 1, 1); PG8_STAGEB(PG8_SB(1, 0), b3);
            PG8_BAR; PG8_WAIT_L(0); PG8_MMA(0, 1, At, B1); PG8_BAR;
            PG8_LDA(At, 1, 1); PG8_STAGE2(PG8_SA(1, 0), a3, s00, s01);
            PG8_BAR; PG8_WAIT_L(0); PG8_MMA(1, 0, At, B0); PG8_BAR; PG8_SCHED;
            PG8_STAGEB(PG8_SB(1, 1), b3 + hstep);
            PG8_WAIT_V(6); PG8_BAR; PG8_MMA(1, 1, At, B1); PG8_BAR;
        }
        E(acc, cur, wr, wc, fr, fq);
        if (!has_next) break;
#pragma unroll
        for (int a = 0; a < 2; ++a)
#pragma unroll
            for (int b = 0; b < 2; ++b)
#pragma unroll
                for (int m = 0; m < 4; ++m)
#pragma unroll
                    for (int n = 0; n < 2; ++n) acc[a][b][m][n] = (f32x4){0.f, 0.f, 0.f, 0.f};
        cur = nxt; cA = nA; cB = nB; ++ui;
        if constexpr (Sched::GATHER_A) { const u32x4 nv = *stash; vo[0][0] = nv.x; vo[0][1] = nv.y; vo[1][0] = nv.z; vo[1][1] = nv.w; }
    }
    PG8_WAIT_V(0);
    if (wr == 0) PG8_BAR;
    PG8_BAR;
#undef PG8_SA
#undef PG8_SB
#undef PG8_STAGE2
#undef PG8_STAGEB
#undef PG8_LDA
#undef PG8_LDB
#undef PG8_MMA
#undef PG8_WAIT_V
#undef PG8_WAIT_L
#undef PG8_BAR
#undef PG8_SCHED
}
}

__device__ __forceinline__ void cvt_tile(const Ctx& c, LAS float* T, const float* src, int src_ld, bf16_t* dst, int dst_ld) {
    const int ty = c.tid >> 4, tx = c.tid & 15;
#pragma unroll
    for (int i = 0; i < 2; ++i) { const int k = ty + 32 * i; const float4 v = *(const float4*)(src + (size_t)k * src_ld + tx * 4);
        T[k * 65 + tx * 4 + 0] = v.x; T[k * 65 + tx * 4 + 1] = v.y; T[k * 65 + tx * 4 + 2] = v.z; T[k * 65 + tx * 4 + 3] = v.w; }
    __syncthreads();
    const int tn = c.tid >> 3, tk = c.tid & 7;
    float v[8];
#pragma unroll
    for (int j = 0; j < 8; ++j) v[j] = T[(tk * 8 + j) * 65 + tn];
    u32x4 o; o.x = pk2(v[0], v[1]); o.y = pk2(v[2], v[3]); o.z = pk2(v[4], v[5]); o.w = pk2(v[6], v[7]);
    *(u32x4*)(dst + (size_t)tn * dst_ld + tk * 8) = o;
    __syncthreads();
}

struct CvtJob { const float* src; bf16_t* dst; int src_ld, dst_ld; };
__device__ __forceinline__ void cvt_tile4(const Ctx& c, LAS float* T, const CvtJob (&jb)[4]) {
    const int ty = c.tid >> 4, tx = c.tid & 15;
    float4 v[4][2];
#pragma unroll
    for (int q = 0; q < 4; ++q)
#pragma unroll
        for (int i = 0; i < 2; ++i) v[q][i] = *(const float4*)(jb[q].src + (size_t)(ty + 32 * i) * jb[q].src_ld + tx * 4);
#pragma unroll
    for (int q = 0; q < 4; ++q)
#pragma unroll
        for (int i = 0; i < 2; ++i) { LAS float* t = T + q * 4160 + (ty + 32 * i) * 65 + tx * 4; t[0] = v[q][i].x; t[1] = v[q][i].y; t[2] = v[q][i].z; t[3] = v[q][i].w; }
    __syncthreads();
    const int tn = c.tid >> 3, tk = c.tid & 7;
#pragma unroll
    for (int q = 0; q < 4; ++q) {
        float w[8];
#pragma unroll
        for (int j = 0; j < 8; ++j) w[j] = T[q * 4160 + (tk * 8 + j) * 65 + tn];
        u32x4 o; o.x = pk2(w[0], w[1]); o.y = pk2(w[2], w[3]); o.z = pk2(w[4], w[5]); o.w = pk2(w[6], w[7]);
        *(u32x4*)(jb[q].dst + (size_t)tn * jb[q].dst_ld + tk * 8) = o;
    }
    __syncthreads();
}

__device__ __forceinline__ void phase_prologue(const Ctx& c) {
    {
        LAS float* Ssm = (LAS float*)c.lds; LAS float* red = Ssm + 9 * 1024;
        for (int i = c.tid; i < 9 * 1024; i += 512) { const int r = i >> 10, k = i & 1023; const float v = r < 8 ? c.a->in[1][r * 1024 + k] : c.a->in[3][k]; Ssm[i] = v * sigm(v); }
        __syncthreads();
        float* MOD = c.w<float>(WS_MOD);
        for (int task = c.bid; task < 384; task += c.G) {
            const int l = task / 96, c0 = (task % 96) * 64, kg = c.tid >> 6, col = c.tid & 63;
            const float* wp = c.a->in[6] + ((size_t)l * 1024 + kg * 128) * 6144 + c0 + col;
            float acc[9];
#pragma unroll
            for (int r = 0; r < 9; ++r) acc[r] = 0.f;
#pragma unroll 4
            for (int k = 0; k < 128; ++k) { const float wv = wp[(size_t)k * 6144];
#pragma unroll
                for (int r = 0; r < 9; ++r) acc[r] += Ssm[r * 1024 + kg * 128 + k] * wv; }
#pragma unroll
            for (int r = 0; r < 9; ++r) red[(kg * 9 + r) * 64 + col] = acc[r];
            __syncthreads();
            for (int i = c.tid; i < 576; i += 512) { const int r = i >> 6, cc = i & 63; float s = 0.f;
#pragma unroll
                for (int k2 = 0; k2 < 8; ++k2) s += red[(k2 * 9 + r) * 64 + cc];
                MOD[((size_t)l * 9 + r) * 6144 + c0 + cc] = s + c.a->in[7][l * 6144 + c0 + cc]; }
            __syncthreads();
        }
    }
    if (c.bid == 0) {
        const int d = c.tid >> 8, ch = c.tid & 255; const float* lg = c.a->in[10] + (size_t)d * 4 * 256 + ch;
        const float a0 = lg[0], a1 = lg[256], a2 = lg[512], a3 = lg[768]; const float mx = fmaxf(fmaxf(a0, a1), fmaxf(a2, a3));
        const float e0 = expf(a0 - mx), e1 = expf(a1 - mx), e2 = expf(a2 - mx), e3 = expf(a3 - mx), inv = 1.f / (e0 + e1 + e2 + e3);
        float* LB = c.w<float>(WS_LB) + (size_t)d * 4 * 256 + ch;
        LB[0] = 0.f; LB[256] = e1 * inv; LB[512] = (e1 + e2) * inv; LB[768] = (e1 + e2 + e3) * inv;
    }
    if (c.bid == 1 % c.G) {
        float* RT = c.w<float>(WS_ROPE);
        for (int i = c.tid; i < 64 * 16; i += 512) { const int pos = i >> 4, j = i & 15; const float inv = exp2f(-(float)j * (13.287712379549449f / 16.f)); const float ang = (float)pos * inv;
            RT[i * 2] = __cosf(ang); RT[i * 2 + 1] = __sinf(ang); }
    }
    {
        __syncthreads();
        LAS float* T = (LAS float*)c.lds;
        constexpr int PER_L = 992 + 256 + 24;
        for (int task4 = c.bid; task4 < PER_L; task4 += c.G) {
            CvtJob jb[4];
#pragma unroll
            for (int q = 0; q < 4; ++q) {
                const int task = task4 * 4 + q; const int l = task / PER_L; int t = task - l * PER_L;
                if (t < 992) { const int kt = t / 62, nt = t % 62;
                    jb[q].src = c.a->in[8] + ((size_t)l * 1024 + kt * 64) * PT + nt * 64; jb[q].src_ld = PT; jb[q].dst = c.w<bf16_t>(WS_WIN) + ((size_t)l * 4096 + nt * 64) * 1024 + kt * 64; jb[q].dst_ld = 1024;
                } else if (t < 992 + 256) { t -= 992; const int kt = t >> 4, nt = t & 15;
                    jb[q].src = c.a->in[9] + ((size_t)l * 1024 + kt * 64) * 1024 + nt * 64; jb[q].src_ld = 1024; jb[q].dst = c.w<bf16_t>(WS_WOUT) + ((size_t)l * 1024 + nt * 64) * 1024 + kt * 64; jb[q].dst_ld = 1024;
                } else { t -= 992 + 256; bf16_t* lo = c.w<bf16_t>(WS_LORA + (size_t)l * LORA_L);
                    if (t < 8) { const int d = t >> 2, nt = t & 3;
                        jb[q].src = c.a->in[14] + ((size_t)(l * 2 + d) * 64) * 256 + nt * 64; jb[q].src_ld = 256; jb[q].dst = lo + (size_t)d * 16384 + (size_t)nt * 64 * 64; jb[q].dst_ld = 64;
                    } else if (t < 16) { t -= 8; const int d = t >> 2, nt = t & 3;
                        jb[q].src = c.a->in[16] + ((size_t)(l * 2 + d) * 64) * 256 + nt * 64; jb[q].src_ld = 256; jb[q].dst = lo + 32768 + (size_t)d * 16384 + (size_t)nt * 64 * 64; jb[q].dst_ld = 64;
                    } else { t -= 16; const int kt = t >> 2, nt = t & 3;
                        jb[q].src = c.a->in[17] + ((size_t)l * 128 + kt * 64) * 256 + nt * 64; jb[q].src_ld = 256; jb[q].dst = lo + 65536 + (size_t)nt * 64 * 128 + kt * 64; jb[q].dst_ld = 128;
                    }
                }
            }
            cvt_tile4(c, T, jb);
        }
        u32x4* z = c.w<u32x4>(WS_WIN);
        for (int i = c.bid * 512 + c.tid; i < 4 * 16384; i += c.G * 512) { const int l = i >> 14, o = i & 16383; z[((size_t)l * 4096 + 3968) * 128 + o] = (u32x4){0u, 0u, 0u, 0u}; }
    }
}

__device__ __forceinline__ void build_tpre(const Ctx& c, int l) {
    LAS int* tp = (LAS int*)(c.lds + MISC_OFF + 64); LAS int* cn = (LAS int*)(c.lds + MISC_OFF + 256);
    __syncthreads();
    if (c.tid < 32) cn[c.tid] = (int)__hip_atomic_load(c.w<unsigned>(WS_CTL) + CW_CNT + l * 64 + c.tid, __ATOMIC_RELAXED, __HIP_MEMORY_SCOPE_AGENT);
    __syncthreads();
    if (c.tid == 0) { int s = 0; for (int e = 0; e < 32; ++e) { tp[e] = s; s += (cn[e] + 255) >> 8; } tp[32] = s; }
    __syncthreads();
}

__device__ __forceinline__ void phase_norm1(const Ctx& c, int l) {
    LAS int* tp = (LAS int*)(c.lds + MISC_OFF + 64);
    if (l > 0) build_tpre(c, l - 1);
    const float* MOD = c.w<float>(WS_MOD); float* X = c.w<float>(WS_X); const bf16_t* Y = c.w<bf16_t>(WS_Y); bf16_t* H = c.w<bf16_t>(WS_H);
    const int4* ROUTE = c.w<int4>(WS_ROUTE);
    const int stride = c.G * 8, lane = c.lane;
    constexpr int NR = 3;
    for (int rowb = c.bid * 8 + c.wave; rowb < MTOK; rowb += NR * stride) {
        f32x4 x[NR][4]; int4 rt[NR]; bool act[NR]; int mrow[NR];
#pragma unroll
        for (int u = 0; u < NR; ++u) { const int row = rowb + u * stride; const int rr = row < MTOK ? row : rowb; const int b = rr / TPB, s = rr - b * TPB;
            act[u] = row < MTOK && !(l == DEPTH && s < CTX); mrow[u] = s < CTX ? 8 : b;
            const float* xs = l > 0 ? X + (size_t)rr * D : (s < CTX ? c.a->in[2] + ((size_t)b * CTX + s) * D : c.a->in[0] + ((size_t)b * SEQ + (s - CTX)) * D);
#pragma unroll
            for (int j = 0; j < 4; ++j) x[u][j] = *(const f32x4*)(xs + lane * 4 + 256 * j);
            rt[u] = l > 0 ? ROUTE[rr] : make_int4(0, 0, 0, 0); }
        if (l > 0) {
            u32x2 y0[NR][4], y1[NR][4];
#pragma unroll
            for (int u = 0; u < NR; ++u) { const int e0 = act[u] ? rt[u].x : 0, e1 = act[u] ? rt[u].z : 0, p0 = act[u] ? rt[u].y : 0, p1 = act[u] ? rt[u].w : 0;
                const size_t r0 = (size_t)tp[e0] * 256 + p0, r1 = (size_t)tp[e1] * 256 + p1;
#pragma unroll
                for (int j = 0; j < 4; ++j) { y0[u][j] = *(const u32x2*)(Y + r0 * D + lane * 4 + 256 * j); y1[u][j] = *(const u32x2*)(Y + r1 * D + lane * 4 + 256 * j); } }
#pragma unroll
            for (int u = 0; u < NR; ++u) { const float* g2 = MOD + ((size_t)(l - 1) * 9 + mrow[u]) * 6144 + 5120;
#pragma unroll
                for (int j = 0; j < 4; ++j) { const f32x4 g = *(const f32x4*)(g2 + lane * 4 + 256 * j);
                    x[u][j][0] += g[0] * (bflo(y0[u][j].x) + bflo(y1[u][j].x)); x[u][j][1] += g[1] * (bfhi(y0[u][j].x) + bfhi(y1[u][j].x));
                    x[u][j][2] += g[2] * (bflo(y0[u][j].y) + bflo(y1[u][j].y)); x[u][j][3] += g[3] * (bfhi(y0[u][j].y) + bfhi(y1[u][j].y)); } }
        }
#pragma unroll
        for (int u = 0; u < NR; ++u) {
            if (!act[u]) continue;
            const int row = rowb + u * stride; const int b = row / TPB, s = row - b * TPB;
            if (l == DEPTH) {
                float* o = c.out + ((size_t)b * SEQ + (s - CTX)) * D;
#pragma unroll
                for (int j = 0; j < 4; ++j) *(f32x4*)(o + lane * 4 + 256 * j) = x[u][j];
                continue;
            }
#pragma unroll
            for (int j = 0; j < 4; ++j) *(f32x4*)(X + (size_t)row * D + lane * 4 + 256 * j) = x[u][j];
            float ss = 0.f;
#pragma unroll
            for (int j = 0; j < 4; ++j) ss += x[u][j][0] * x[u][j][0] + x[u][j][1] * x[u][j][1] + x[u][j][2] * x[u][j][2] + x[u][j][3] * x[u][j][3];
            ss = red64(ss);
            const float inv = rsqrtf(ss * (1.f / 1024.f) + 1e-6f);
            const float* gain = c.a->in[4] + (size_t)l * D; const float* md = MOD + ((size_t)l * 9 + mrow[u]) * 6144;
#pragma unroll
            for (int j = 0; j < 4; ++j) { const int col = lane * 4 + 256 * j;
                const f32x4 gn = *(const f32x4*)(gain + col), sh = *(const f32x4*)(md + col), sc = *(const f32x4*)(md + 1024 + col);
                const f32x4 h = x[u][j] * inv * gn * (1.f + sc) + sh;
                u32x2 o; o.x = pk2(h[0], h[1]); o.y = pk2(h[2], h[3]); *(u32x2*)(H + (size_t)row * D + col) = o; }
        }
    }
}

__device__ __forceinline__ void phase_prep(const Ctx& c, int l) {
    const bf16_t* P = c.w<bf16_t>(WS_P);
    const int gw = c.bid * 8 + c.wave, nw = c.G * 8, lane = c.lane;
    {
        const float* RT = c.w<float>(WS_ROPE); bf16_t* QN = c.w<bf16_t>(WS_QN); bf16_t* KN = c.w<bf16_t>(WS_KN);
        const int hd = lane >> 3, sub = lane & 7;
        u32x2 nq[2][2];
#define QK_LOAD(r_) do { _Pragma("unroll") for (int w_ = 0; w_ < 2; ++w_) { const bf16_t* pq_ = P + (size_t)(r_) * PT + (w_ ? PC_K : PC_Q) + hd * 64 + sub * 4; \
            nq[w_][0] = *(const u32x2*)pq_; nq[w_][1] = *(const u32x2*)(pq_ + 32); } } while (0)
        QK_LOAD(gw < MTOK ? gw : 0);
        for (int row = gw; row < MTOK; row += nw) {
            const int b = row / TPB, s = row - b * TPB; const bool lat = s >= CTX; const int t = s - CTX, pr = t >> 6, pc = t & 63;
            const int pos = sub < 4 ? pr : pc, jj0 = (sub & 3) * 4;
            u32x2 cq[2][2];
#pragma unroll
            for (int w_ = 0; w_ < 2; ++w_) { cq[w_][0] = nq[w_][0]; cq[w_][1] = nq[w_][1]; }
            QK_LOAD(row + nw < MTOK ? row + nw : row);
#pragma unroll
            for (int which = 0; which < 2; ++which) {
                const u32x2 a = cq[which][0], bq = cq[which][1];
                float x1[4] = {bflo(a.x), bfhi(a.x), bflo(a.y), bfhi(a.y)}, x2[4] = {bflo(bq.x), bfhi(bq.x), bflo(bq.y), bfhi(bq.y)};
                float ss = 0.f;
#pragma unroll
                for (int j = 0; j < 4; ++j) ss += x1[j] * x1[j] + x2[j] * x2[j];
                ss = red8(ss);
                const float inv = rsqrtf(ss * (1.f / 64.f) + 1e-6f);
                const float* gn = c.a->in[which ? 24 : 23] + l * 64 + sub * 4;
                float y1[4], y2[4];
#pragma unroll
                for (int j = 0; j < 4; ++j) { const float u1 = x1[j] * inv * gn[j], u2 = x2[j] * inv * gn[32 + j];
                    if (lat) { const float cs = RT[(pos * 16 + jj0 + j) * 2], sn = RT[(pos * 16 + jj0 + j) * 2 + 1]; y1[j] = u1 * cs - u2 * sn; y2[j] = u2 * cs + u1 * sn; }
                    else { y1[j] = u1; y2[j] = u2; }
                    if (!which) { y1[j] *= 0.125f; y2[j] *= 0.125f; } }
                u32x2 o1, o2; o1.x = pk2(y1[0], y1[1]); o1.y = pk2(y1[2], y1[3]); o2.x = pk2(y2[0], y2[1]); o2.y = pk2(y2[2], y2[3]);
                if (which) {
                    bf16_t* dst = KN + ((size_t)(b * 8 + hd)) * TPB * 64 + (size_t)(s >> 3) * 512 + (s & 7) * 32 + (sub >> 1) * 8 + (sub & 1) * 4;
                    *(u32x2*)dst = o1; *(u32x2*)(dst + 256) = o2;
                } else {
                    bf16_t* dst = QN + (((size_t)(b * 8 + hd)) * TPB + s) * 64 + sub * 4;
                    *(u32x2*)dst = o1; *(u32x2*)(dst + 32) = o2;
                }
            }
        }
    }
    {
        LAS bf16_t* T = (LAS bf16_t*)(c.lds + c.wave * 9216);
        bf16_t* VT = c.w<bf16_t>(WS_VT);
        for (int task = gw; task < NB * 8 * 36; task += nw) {
            const int b = task / 288, h = (task / 36) & 7, tb = task % 36;
#pragma unroll
            for (int i = 0; i < 8; ++i) { const int tok = i * 8 + (lane >> 3), ch = lane & 7;
                const u32x4 v = *(const u32x4*)(P + (size_t)(b * TPB + tb * 64 + tok) * PT + PC_V + h * 64 + ch * 8);
                *(LAS u32x4*)(T + tok * 72 + ch * 8) = v; }
            __builtin_amdgcn_wave_barrier();
            unsigned pk[32];
#pragma unroll
            for (int i = 0; i < 32; ++i) pk[i] = (unsigned)T[(2 * i) * 72 + lane] | ((unsigned)T[(2 * i + 1) * 72 + lane] << 16);
            bf16_t* dst = VT + (size_t)(b * 8 + h) * 64 * TPB + (size_t)(tb * 8) * 512 + (lane >> 4) * 128 + (lane & 15) * 8;
#pragma unroll
            for (int i = 0; i < 8; ++i) *(u32x4*)(dst + i * 512) = (u32x4){pk[4 * i], pk[4 * i + 1], pk[4 * i + 2], pk[4 * i + 3]};
            __builtin_amdgcn_wave_barrier();
        }
    }
}
__device__ __forceinline__ void phase_prep_hgrn(const Ctx& c, int l) {
    const bf16_t* P = c.w<bf16_t>(WS_P);
    const int gw = c.bid * 8 + c.wave, nw = c.G * 8;
    {
        LAS bf16_t* QT = (LAS bf16_t*)(c.lds + (c.wave < 7 ? c.wave * 8192 : 132096)); LAS bf16_t* KTl = QT + 16 * 72; LAS bf16_t* IV = KTl + 16 * 72;
        const float* LB = c.w<float>(WS_LB);
        bf16_t* QIN = c.w<bf16_t>(WS_QIN); bf16_t* KOT = c.w<bf16_t>(WS_KOT); bf16_t* IT = c.w<bf16_t>(WS_IT); float* DEC = c.w<float>(WS_DEC); bf16_t* O1 = c.w<bf16_t>(WS_O1);
        const bool bal = (c.G == 256);
        const int t_lo = bal ? (c.bid < 128 ? c.bid * 12 : 1536 + (c.bid - 128) * 24) + c.wave : gw;
        const int t_hi = bal ? (c.bid < 128 ? c.bid * 12 + 12 : 1536 + (c.bid - 128) * 24 + 24) : NB * 4 * NBLK16;
        const int t_st = bal ? 8 : nw;
        bf16_t nqr[16], nir[16], nfr[16], nbr[16];
#define HG_TLOAD(task_) do { const int tk_ = (task_); const int b_ = tk_ / (4 * NBLK16), h_ = (tk_ / NBLK16) & 3, nb_ = tk_ % NBLK16; \
            const bf16_t* pr_ = P + (size_t)(b_ * TPB + nb_ * 16) * PT + h_ * 64 + c.lane; \
            _Pragma("unroll") for (int t_ = 0; t_ < 16; ++t_) { nqr[t_] = pr_[(size_t)t_ * PT + PA_Q]; nir[t_] = pr_[(size_t)t_ * PT + PA_I]; nfr[t_] = pr_[(size_t)t_ * PT + PA_FF]; nbr[t_] = pr_[(size_t)t_ * PT + PA_FB]; } } while (0)
        if (t_lo < t_hi) HG_TLOAD(t_lo);
        for (int task = t_lo; task < t_hi; task += t_st) {
            int lane = c.lane; asm volatile("" : "+v"(lane));
            const int fr = lane & 15, g = lane >> 4;
            const int b = task / (4 * NBLK16), h = (task / NBLK16) & 3, nb = task % NBLK16; const int row0 = b * TPB + nb * 16;
            float q[16]; bf16_t ffr[16], fbr[16];
            {
                float iv[16];
#pragma unroll
                for (int t = 0; t < 16; ++t) { q[t] = bf2f(nqr[t]); iv[t] = bf2f(nir[t]); ffr[t] = nfr[t]; fbr[t] = nbr[t]; }
                HG_TLOAD(task + t_st < t_hi ? task + t_st : task);
                unsigned pk[8];
#pragma unroll
                for (int i = 0; i < 8; ++i) pk[i] = pk2(iv[2 * i], iv[2 * i + 1]);
                bf16_t* dst = IT + (((size_t)(b * 4 + h) * NBLK16 + nb) * 64 + lane) * 16;
                *(u32x4*)dst = (u32x4){pk[0], pk[1], pk[2], pk[3]}; *(u32x4*)(dst + 8) = (u32x4){pk[4], pk[5], pk[6], pk[7]};
                *(LAS u32x4*)(IV + lane * 24) = (u32x4){pk[0], pk[1], pk[2], pk[3]}; *(LAS u32x4*)(IV + lane * 24 + 8) = (u32x4){pk[4], pk[5], pk[6], pk[7]};
            }
            f32x4 oacc[4];
#pragma unroll
            for (int n = 0; n < 4; ++n) oacc[n] = (f32x4){0.f, 0.f, 0.f, 0.f};
#pragma unroll 1
            for (int dir = 0; dir < 2; ++dir) {
                const float lb = LB[((size_t)dir * 4 + l) * 256 + h * 64 + lane];
                float kf[16], cum[16];
#pragma unroll
                for (int t = 0; t < 16; ++t) { const float fp = bf2f(dir ? fbr[t] : ffr[t]);
                    const float f = lb + (1.f - lb) * sigm(fp); cum[t] = __logf(fmaxf(f, 1e-20f)); kf[t] = (1.f - lb) * sigm(-fp); }
                if (dir == 0) {
#pragma unroll
                    for (int t = 1; t < 16; ++t) cum[t] += cum[t - 1];
                } else {
#pragma unroll
                    for (int t = 14; t >= 0; --t) cum[t] += cum[t + 1];
                }
                const float cend = dir ? cum[0] : cum[15], cmid = dir ? cum[8] : cum[7];
                const size_t blk = ((size_t)(dir * 8 + b) * 4 + h) * NBLK16 + nb;
                DEC[blk * 64 + lane] = __expf(cend);
                unsigned pko[8];
#pragma unroll
                for (int t = 0; t < 16; ++t) {
                    const float qi = q[t] * __expf(cum[t]), ko = kf[t] * __expf(cend - cum[t]);
                    QIN[((size_t)dir * MTOK + row0 + t) * 256 + h * 64 + lane] = f2bf(qi);
                    if (t & 1) pko[t >> 1] |= (unsigned)f2bf(ko) << 16; else pko[t >> 1] = (unsigned)f2bf(ko);
                    QT[t * 72 + lane] = f2bf(q[t] * __expf(fminf(fmaxf(cum[t] - cmid, -80.f), 80.f)));
                    KTl[t * 72 + lane] = f2bf(kf[t] * __expf(fminf(fmaxf(cmid - cum[t], -80.f), 80.f)));
                }
                { bf16_t* dst = KOT + (blk * 64 + lane) * 16;
                  *(u32x4*)dst = (u32x4){pko[0], pko[1], pko[2], pko[3]}; *(u32x4*)(dst + 8) = (u32x4){pko[4], pko[5], pko[6], pko[7]}; }
                MEMBAR();
                __builtin_amdgcn_wave_barrier();
                f32x4 sT = {0.f, 0.f, 0.f, 0.f};
#pragma unroll
                for (int ks = 0; ks < 2; ++ks) {
                    const bf16x8 aK = *(const LAS bf16x8*)(KTl + fr * 72 + ks * 32 + g * 8), bQ = *(const LAS bf16x8*)(QT + fr * 72 + ks * 32 + g * 8);
                    sT = __builtin_amdgcn_mfma_f32_16x16x32_bf16(aK, bQ, sT, 0, 0, 0);
                }
                float sm[4];
#pragma unroll
                for (int j = 0; j < 4; ++j) { const int sI = 4 * g + j; const bool ok = dir ? (sI >= fr) : (sI <= fr); sm[j] = ok ? sT[j] : 0.f; }
                union { u32x2 u; bf16x4 v; } aS; aS.u = (u32x2){pk2m(sm[0], sm[1]), pk2m(sm[2], sm[3])};
#pragma unroll
                for (int n = 0; n < 4; ++n) { const bf16x4 bI = *(const LAS bf16x4*)(IV + (16 * n + fr) * 24 + 4 * g);
                    oacc[n] = __builtin_amdgcn_mfma_f32_16x16x16bf16_1k(aS.v, bI, oacc[n], 0, 0, 0); }
                MEMBAR();
                __builtin_amdgcn_wave_barrier();
            }
#pragma unroll
            for (int n = 0; n < 4; ++n)
#pragma unroll
                for (int j = 0; j < 4; ++j) O1[(size_t)(row0 + 4 * g + j) * 256 + h * 64 + 16 * n + fr] = f2bf(oacc[n][j]);
        }
    }
}
__device__ __forceinline__ void rwkv_chunk_task(const Ctx& c, const int task);
__device__ __forceinline__ void phase_prep_rwkv(const Ctx& c, int l) {
    const bf16_t* P = c.w<bf16_t>(WS_P);
    const int lane = c.lane;
    {
        LAS float* SP = (LAS float*)c.lds;
        LAS float* KKI = SP + 16 * 1152;
        LAS float* BONP = KKI + 64;
        LAS bf16_t* ACT = (LAS bf16_t*)(BONP + 128);
        const float* mu = c.a->in[12] + (size_t)l * 1152;
        const float* kks = c.a->in[18] + l * 256; const float* k_a = c.a->in[19] + l * 256; const float* r_k = c.a->in[20] + l * 256;
        const bf16_t* lo = c.w<bf16_t>(WS_LORA + (size_t)l * LORA_L);
        float* RW = c.w<float>(WS_RW); bf16_t* GG = c.w<bf16_t>(WS_G); bf16_t* BON = c.w<bf16_t>(WS_BON);
        const int fr = lane & 15, g = lane >> 4;
        for (int tile = c.bid; tile < MTOK / 16; tile += c.G) {
            const int r0 = tile * 16; const int b = r0 / TPB, s0 = r0 - b * TPB;
#pragma unroll
            for (int it = 0; it < 5; ++it) {
                const int idx = c.tid + it * 512;
                if (idx < 16 * 144) {
                    const int t = idx / 144, ch = (idx - t * 144) * 8; const int s = s0 + t;
                    const bf16_t* pp = P + (size_t)(r0 + t) * PT + PB0 + ch;
                    const u32x4 zero4 = {0u, 0u, 0u, 0u};
                    const u32x4 p4 = *(const u32x4*)pp;
                    const u32x4 m4 = (s != 0 && s != CTX) ? *(const u32x4*)(pp - PT) : zero4;
                    const u32x4 n4 = (s != CTX - 1 && s != TPB - 1) ? *(const u32x4*)(pp + PT) : zero4;
                    const f32x4 mu0 = *(const f32x4*)(mu + ch), mu1 = *(const f32x4*)(mu + ch + 4);
                    f32x4 o0, o1;
#pragma unroll
                    for (int e = 0; e < 4; ++e) {
                        const unsigned pw = p4[e], mw = m4[e], nw = n4[e];
                        const float pl = bflo(pw), ph = bfhi(pw);
                        const float vl = pl + (0.5f * (bflo(mw) + bflo(nw)) - pl) * (e < 2 ? mu0[2 * e] : mu1[2 * e - 4]);
                        const float vh = ph + (0.5f * (bfhi(mw) + bfhi(nw)) - ph) * (e < 2 ? mu0[2 * e + 1] : mu1[2 * e - 3]);
                        if (e < 2) { o0[2 * e] = vl; o0[2 * e + 1] = vh; } else { o1[2 * e - 4] = vl; o1[2 * e - 3] = vh; }
                    }
                    *(LAS f32x4*)(SP + t * 1152 + ch) = o0; *(LAS f32x4*)(SP + t * 1152 + ch + 4) = o1;
                }
            }
            __syncthreads();
            {
#pragma unroll
                for (int it = 0; it < 6; ++it) { const int idx = c.tid + it * 512; const int t = idx / 192, c2 = (idx - t * 192) * 2;
                    const float x0 = SP[t * 1152 + 768 + c2], x1 = SP[t * 1152 + 768 + c2 + 1];
                    float y0, y1;
                    if (c2 < 128) { y0 = 1.f - 2.f / (__expf(2.f * x0) + 1.f); y1 = 1.f - 2.f / (__expf(2.f * x1) + 1.f); }
                    else if (c2 < 256) { y0 = x0; y1 = x1; }
                    else { y0 = sigm(x0); y1 = sigm(x1); }
                    *(LAS unsigned*)(ACT + t * 392 + c2) = pk2(y0, y1); }
            }
            {
#pragma unroll
                for (int tt = 0; tt < 2; ++tt) { const int t = c.wave * 2 + tt; float ss = 0.f;
#pragma unroll
                    for (int j = 0; j < 4; ++j) { const float v = SP[t * 1152 + 256 + lane * 4 + j] * kks[lane * 4 + j]; ss += v * v; }
                    ss = red16(ss);
                    if (fr == 0) KKI[t * 4 + g] = 1.f / fmaxf(sqrtf(ss), 1e-12f); }
            }
            __syncthreads();
            float bpart[4] = {0.f, 0.f, 0.f, 0.f};
#pragma unroll 1
            for (int nn = 0; nn < 2; ++nn) {
                const int nt = c.wave * 2 + nn, ch = nt * 16 + fr, hh = nt >> 2;
                f32x4 aw[2], aa[2], ag = (f32x4){0.f, 0.f, 0.f, 0.f};
#pragma unroll
                for (int d = 0; d < 2; ++d) { aw[d] = (f32x4){0.f, 0.f, 0.f, 0.f}; aa[d] = aw[d]; }
#pragma unroll
                for (int d = 0; d < 2; ++d)
#pragma unroll
                    for (int ks = 0; ks < 2; ++ks) {
                        const bf16x8 fa = *(const LAS bf16x8*)(ACT + fr * 392 + d * 64 + ks * 32 + g * 8), fb = *(const LAS bf16x8*)(ACT + fr * 392 + 128 + d * 64 + ks * 32 + g * 8);
                        const bf16x8 bw = *(const bf16x8*)(lo + (size_t)d * 16384 + (size_t)ch * 64 + ks * 32 + g * 8);
                        const bf16x8 ba = *(const bf16x8*)(lo + 32768 + (size_t)d * 16384 + (size_t)ch * 64 + ks * 32 + g * 8);
                        aw[d] = __builtin_amdgcn_mfma_f32_16x16x32_bf16(fa, bw, aw[d], 0, 0, 0);
                        aa[d] = __builtin_amdgcn_mfma_f32_16x16x32_bf16(fb, ba, aa[d], 0, 0, 0);
                    }
#pragma unroll
                for (int ks = 0; ks < 4; ++ks) {
                    const bf16x8 fg = *(const LAS bf16x8*)(ACT + fr * 392 + 256 + ks * 32 + g * 8);
                    const bf16x8 bg = *(const bf16x8*)(lo + 65536 + (size_t)ch * 128 + ks * 32 + g * 8);
                    ag = __builtin_amdgcn_mfma_f32_16x16x32_bf16(fg, bg, ag, 0, 0, 0);
                }
                const float kksc = kks[ch], kac = k_a[ch], rkc = r_k[ch];
                const float w0f = c.a->in[13][(size_t)(l * 2 + 0) * 256 + ch], w0b = c.a->in[13][(size_t)(l * 2 + 1) * 256 + ch];
                const float a0f = c.a->in[15][(size_t)(l * 2 + 0) * 256 + ch], a0b = c.a->in[15][(size_t)(l * 2 + 1) * 256 + ch];
#pragma unroll
                for (int j = 0; j < 4; ++j) {
                    const int t = 4 * g + j; const size_t row = (size_t)r0 + t;
                    const float rr = SP[t * 1152 + ch], kk0 = SP[t * 1152 + 256 + ch], vv = SP[t * 1152 + 512 + ch];
                    const float kk = kk0 * kksc * KKI[t * 4 + hh];
                    float kdsum = 0.f;
#pragma unroll
                    for (int d = 0; d < 2; ++d) {
                        const float wl = (d ? w0b : w0f) + aw[d][j];
                        const float xx = -wl; const float sp = fmaxf(xx, 0.f) + __logf(1.f + __expf(-fabsf(xx)));
                        const float wlog = -sp - 0.5f; const float dec = __expf(-__expf(wlog));
                        const float a = sigm((d ? a0b : a0f) + aa[d][j]);
                        const float kd = kk0 * (1.f + (a - 1.f) * kac), ak = a * kk;
                        kdsum += kd;
                        float* dst = RW + (((size_t)d * MTOK + row) * 4 + hh) * 384 + (ch & 63);
                        dst[0] = dec; dst[64] = kk; dst[128] = ak; dst[192] = kd; dst[256] = rr; dst[320] = vv;
                    }
                    GG[row * 256 + ch] = f2bf(ag[j]);
                    bpart[j] += rr * kdsum * rkc;
                }
            }
#pragma unroll
            for (int j = 0; j < 4; ++j) { const float s = red16(bpart[j]); if (fr == 0) BONP[(4 * g + j) * 8 + c.wave] = s; }
            __syncthreads();
            for (int idx = c.tid; idx < 16 * 256; idx += 512) { const int t = idx >> 8, ch = idx & 255, hh = ch >> 6;
                BON[((size_t)r0 + t) * 256 + ch] = f2bf((BONP[t * 8 + hh * 2] + BONP[t * 8 + hh * 2 + 1]) * SP[t * 1152 + 512 + ch]); }
            asm volatile("s_waitcnt vmcnt(0)" ::: "memory");
            __syncthreads();
            rwkv_chunk_task(c, ((b * 4 + (c.wave >> 1)) * 2 + (c.wave & 1)) * 144 + (s0 >> 4));
            if (REP_PHASE == 35) rwkv_chunk_task(c, ((b * 4 + (c.wave >> 1)) * 2 + (c.wave & 1)) * 144 + (s0 >> 4));
            __syncthreads();
        }
    }
}

__device__ __forceinline__ void rwkv_chunk_task(const Ctx& c, const int task) {
    const int wv = c.wave;
    {
    int lane = c.lane; asm volatile("" : "+v"(lane));
    const int fr = lane & 15, g = lane >> 4;
    LAS unsigned char* base = c.lds + (wv < 7 ? wv * 17408 : 132096);
    LAS bf16_t* ALT = (LAS bf16_t*)base; LAS bf16_t* KT = ALT + 16 * 72; LAS bf16_t* KAP = KT + 16 * 72; LAS bf16_t* RT = KAP + 16 * 72;
    LAS float* SM = (LAS float*)(base + 9216);
    const float* RW = c.w<float>(WS_RW);
    bf16_t* KHT = c.w<bf16_t>(WS_KHT); bf16_t* AHT = c.w<bf16_t>(WS_AHT); float* GCo = c.w<float>(WS_GC); bf16_t* RH = c.w<bf16_t>(WS_RH); bf16_t* WYo = c.w<bf16_t>(WS_WY); bf16_t* ZT = c.w<bf16_t>(WS_ZT); bf16_t* VT2 = c.w<bf16_t>(WS_VT2);
    {
        const int nb = task % 144, sq = task / 144, dir = sq & 1, h = (sq >> 1) & 3, b = sq >> 3;
        const int row0 = b * TPB + nb * 16;
        const float* rec0 = RW + (((size_t)dir * MTOK + row0) * 4 + h) * 384 + lane;
        float kap[16], alt[16], kt[16], Rt[16];
        float Gc = 1.f;
        const float* rp = rec0 + (dir ? 15 * 1536 : 0); const long rstep = dir ? -1536 : 1536;
        float vv[16];
#pragma unroll
        for (int t = 0; t < 16; ++t) {
            const float w = rp[0], kk = rp[64], ak = rp[128], kd = rp[192], r = rp[256]; vv[t] = rp[320];
            rp += rstep;
            kap[t] = Gc * kk; Gc *= w; const float iG = 1.f / Gc; alt[t] = ak * iG; kt[t] = kd * iG; Rt[t] = Gc * r;
        }
        {
            unsigned pk[8];
#pragma unroll
            for (int i = 0; i < 8; ++i) pk[i] = pk2(vv[2 * i], vv[2 * i + 1]);
            bf16_t* dst = VT2 + ((size_t)task * 64 + lane) * 16;
            *(u32x4*)dst = (u32x4){pk[0], pk[1], pk[2], pk[3]}; *(u32x4*)(dst + 8) = (u32x4){pk[4], pk[5], pk[6], pk[7]};
        }
#pragma unroll
        for (int t = 0; t < 16; ++t) { ALT[t * 72 + lane] = f2bf(alt[t]); KT[t * 72 + lane] = f2bf(kt[t]); KAP[t * 72 + lane] = f2bf(kap[t]); RT[t * 72 + lane] = f2bf(Rt[t]); }
        MEMBAR();
        __builtin_amdgcn_wave_barrier();
        {
            f32x4 dN = {0.f, 0.f, 0.f, 0.f}, dM = dN, dNR = dN, dMR = dN;
#pragma unroll
            for (int ks = 0; ks < 2; ++ks) {
                const bf16x8 aA = *(const LAS bf16x8*)(ALT + fr * 72 + ks * 32 + g * 8), aK = *(const LAS bf16x8*)(KT + fr * 72 + ks * 32 + g * 8);
                const bf16x8 bP = *(const LAS bf16x8*)(KAP + fr * 72 + ks * 32 + g * 8), bR = *(const LAS bf16x8*)(RT + fr * 72 + ks * 32 + g * 8);
                dN = __builtin_amdgcn_mfma_f32_16x16x32_bf16(aA, bP, dN, 0, 0, 0); dM = __builtin_amdgcn_mfma_f32_16x16x32_bf16(aK, bP, dM, 0, 0, 0);
                dNR = __builtin_amdgcn_mfma_f32_16x16x32_bf16(aA, bR, dNR, 0, 0, 0); dMR = __builtin_amdgcn_mfma_f32_16x16x32_bf16(aK, bR, dMR, 0, 0, 0);
            }
#pragma unroll
            for (int j = 0; j < 4; ++j) { const int sI = 4 * g + j;
                SM[0 * 256 + sI * 16 + fr] = sI < fr ? dN[j] : 0.f; SM[1 * 256 + sI * 16 + fr] = sI < fr ? dM[j] : 0.f;
                SM[2 * 256 + sI * 16 + fr] = sI <= fr ? dNR[j] : 0.f; SM[3 * 256 + sI * 16 + fr] = sI <= fr ? dMR[j] : 0.f; }
        }
        __builtin_amdgcn_wave_barrier();
        {
            const int role = g & 1;
            float X[16];
#define ROW4(dst, mat, r_) do { _Pragma("unroll") for (int q_ = 0; q_ < 4; ++q_) dst[q_] = *(const LAS f32x4*)(SM + (mat) * 256 + (r_) * 16 + 4 * q_); } while (0)
            {
                f32x4 nr[4]; float nrhs = role ? SM[2 * 256 + 15 * 16 + fr] : (15 == fr ? 1.f : 0.f);
                ROW4(nr, 0, 15);
#pragma unroll
                for (int sI = 15; sI >= 0; --sI) {
                    f32x4 cr[4]; float acc = nrhs;
#pragma unroll
                    for (int q = 0; q < 4; ++q) cr[q] = nr[q];
                    if (sI > 0) { ROW4(nr, 0, sI - 1); nrhs = role ? SM[2 * 256 + (sI - 1) * 16 + fr] : (sI - 1 == fr ? 1.f : 0.f); }
                    MEMBAR();
#pragma unroll
                    for (int j = sI + 1; j < 16; ++j) acc -= cr[j >> 2][j & 3] * X[j];
                    X[sI] = acc;
                }
            }
            {
                f32x4 nr[4]; float nmr = SM[3 * 256 + 0 * 16 + fr];
                ROW4(nr, 1, 0);
#pragma unroll
                for (int sI = 0; sI < 16; ++sI) {
                    f32x4 cr[4]; const float mr = nmr;
#pragma unroll
                    for (int q = 0; q < 4; ++q) cr[q] = nr[q];
                    if (sI < 15) { ROW4(nr, 1, sI + 1); nmr = SM[3 * 256 + (sI + 1) * 16 + fr]; }
                    MEMBAR();
                    float om = 0.f;
#pragma unroll
                    for (int j = sI + 1; j < 16; ++j) om += cr[j >> 2][j & 3] * X[j];
                    const float oo = role ? mr - om : om;
                    SM[(4 + role) * 256 + sI * 16 + fr] = X[sI]; SM[(6 + role) * 256 + sI * 16 + fr] = oo;
                }
            }
        }
        __builtin_amdgcn_wave_barrier();
        float Kh[16], ahv[16];
        {
            float Rh[16];
#pragma unroll
            for (int t = 0; t < 16; ++t) { Kh[t] = 0.f; Rh[t] = bf2f(RT[t * 72 + lane]); }
            f32x4 nt4[4], ng4[4]; bf16_t nk = KAP[0 * 72 + lane];
            ROW4(nt4, 4, 0); ROW4(ng4, 5, 0);
            MEMBAR();
#pragma unroll
            for (int sI = 0; sI < 16; ++sI) {
                f32x4 ct[4], cg[4]; const float kps = bf2f(nk);
#pragma unroll
                for (int q = 0; q < 4; ++q) { ct[q] = nt4[q]; cg[q] = ng4[q]; }
                if (sI < 15) { ROW4(nt4, 4, sI + 1); ROW4(ng4, 5, sI + 1); nk = KAP[(sI + 1) * 72 + lane]; }
                MEMBAR();
#pragma unroll
                for (int t = sI; t < 16; ++t) { Kh[t] += kps * ct[t >> 2][t & 3]; Rh[t] -= kps * cg[t >> 2][t & 3]; }
            }
            bf16_t* rd = RH + (size_t)task * 1024 + lane; bf16_t* kd2 = KHT + (size_t)task * 1024 + lane;
#pragma unroll
            for (int t = 0; t < 16; ++t) { rd[t * 64] = f2bf(Rh[t]); kd2[t * 64] = f2bf(Kh[t]); }
            GCo[(size_t)task * 64 + lane] = Gc;
            MEMBAR();
        }
        {
            float Z[16];
#pragma unroll
            for (int t = 0; t < 16; ++t) ahv[t] = bf2f(ALT[t * 72 + lane]) * Gc;
            f32x4 nm4[4]; bf16_t nk = KT[0 * 72 + lane];
            ROW4(nm4, 6, 0);
            MEMBAR();
#pragma unroll
            for (int sI = 0; sI < 16; ++sI) {
                f32x4 cm[4]; float z = bf2f(nk) * Gc;
#pragma unroll
                for (int q = 0; q < 4; ++q) cm[q] = nm4[q];
                if (sI < 15) { ROW4(nm4, 6, sI + 1); nk = KT[(sI + 1) * 72 + lane]; }
                MEMBAR();
#pragma unroll
                for (int t = sI + 1; t < 16; ++t) z -= cm[t >> 2][t & 3] * ahv[t];
                Z[sI] = z;
            }
            unsigned pz[8];
#pragma unroll
            for (int i = 0; i < 8; ++i) pz[i] = pk2(Z[2 * i], Z[2 * i + 1]);
            bf16_t* zd = ZT + ((size_t)task * 64 + lane) * 16;
            *(u32x4*)zd = (u32x4){pz[0], pz[1], pz[2], pz[3]}; *(u32x4*)(zd + 8) = (u32x4){pz[4], pz[5], pz[6], pz[7]};
            MEMBAR();
        }
#undef ROW4
        {
            unsigned pa[8];
#pragma unroll
            for (int i = 0; i < 8; ++i) pa[i] = pk2(ahv[2 * i], ahv[2 * i + 1]);
            bf16_t* ad = AHT + ((size_t)task * 64 + lane) * 16;
            *(u32x4*)ad = (u32x4){pa[0], pa[1], pa[2], pa[3]}; *(u32x4*)(ad + 8) = (u32x4){pa[4], pa[5], pa[6], pa[7]};
            if (g == 0) {
                unsigned pw[8];
#pragma unroll
                for (int i = 0; i < 8; ++i) pw[i] = pk2(SM[7 * 256 + (2 * i) * 16 + fr], SM[7 * 256 + (2 * i + 1) * 16 + fr]);
                bf16_t* wd = WYo + ((size_t)task * 16 + fr) * 16;
                *(u32x4*)wd = (u32x4){pw[0], pw[1], pw[2], pw[3]}; *(u32x4*)(wd + 8) = (u32x4){pw[4], pw[5], pw[6], pw[7]};
            }
        }
        __builtin_amdgcn_wave_barrier();
    }
    }
}

constexpr int RC_RD = 5, RC_SLOT = 10240;
__device__ __forceinline__ void rwkv_scan(const Ctx& c) {
    const int lane = c.lane, fr = lane & 15, g = lane >> 4;
    LAS unsigned char* ring = c.lds;
    for (int task = c.bid; task < 256; task += c.G) {
        const int b = task >> 5, h = (task >> 3) & 3, dir = (task >> 2) & 1, vs = task & 3;
        const size_t cbase = (size_t)((b * 4 + h) * 2 + dir) * 144;
        const unsigned char* KHT = c.w<unsigned char>(WS_KHT) + cbase * 2048 + lane * 16; const unsigned char* RH = c.w<unsigned char>(WS_RH) + cbase * 2048 + lane * 16;
        const unsigned char* AHT = c.w<unsigned char>(WS_AHT) + cbase * 2048 + lane * 16; const unsigned char* ZT = c.w<unsigned char>(WS_ZT) + cbase * 2048 + lane * 16;
        const unsigned char* X1 = lane < 16 ? c.w<unsigned char>(WS_GC) + cbase * 256 + lane * 16 : (lane < 48 ? c.w<unsigned char>(WS_WY) + cbase * 512 + (lane - 16) * 16 : c.w<unsigned char>(WS_VT2) + cbase * 2048 + vs * 512 + (lane - 48) * 16);
        const int x1s = lane < 16 ? 256 : (lane < 48 ? 512 : 2048);
        const unsigned char* X2 = lane < 16 ? c.w<unsigned char>(WS_VT2) + cbase * 2048 + vs * 512 + 256 + lane * 16 : c.w<unsigned char>(WS_GC) + cbase * 256 + (lane & 15) * 16;
        const int x2s = lane < 16 ? 2048 : 256;
        bf16_t* YSp = c.w<bf16_t>(WS_YS) + (size_t)dir * MTOK * 256 + h * 64 + vs * 16 + fr;
#define RC_NB(ci_) (dir == 0 ? (ci_) : ((ci_) < 16 ? 15 - (ci_) : 159 - (ci_)))
#define RC_DMA(ci_, slot_) do { int cc_ = (ci_); cc_ = cc_ < 144 ? cc_ : 143; const int nb_ = RC_NB(cc_); LAS unsigned char* d_ = ring + (slot_) * RC_SLOT; \
        _Pragma("unroll") for (int k_ = 0; k_ < 2; ++k_) { \
            __builtin_amdgcn_global_load_lds((const unsigned*)(KHT + (size_t)nb_ * 2048 + k_ * 1024), (LAS unsigned*)(d_ + k_ * 1024), 16, 0, 0); \
            __builtin_amdgcn_global_load_lds((const unsigned*)(RH + (size_t)nb_ * 2048 + k_ * 1024), (LAS unsigned*)(d_ + 2048 + k_ * 1024), 16, 0, 0); \
            __builtin_amdgcn_global_load_lds((const unsigned*)(AHT + (size_t)nb_ * 2048 + k_ * 1024), (LAS unsigned*)(d_ + 4096 + k_ * 1024), 16, 0, 0); \
            __builtin_amdgcn_global_load_lds((const unsigned*)(ZT + (size_t)nb_ * 2048 + k_ * 1024), (LAS unsigned*)(d_ + 6144 + k_ * 1024), 16, 0, 0); } \
        __builtin_amdgcn_global_load_lds((const unsigned*)(X1 + (size_t)nb_ * x1s), (LAS unsigned*)(d_ + 8192), 16, 0, 0); \
        __builtin_amdgcn_global_load_lds((const unsigned*)(X2 + (size_t)nb_ * x2s), (LAS unsigned*)(d_ + 9216), 16, 0, 0); } while (0)
        f32x4 S[4];
#pragma unroll
        for (int m = 0; m < 4; ++m) S[m] = (f32x4){0.f, 0.f, 0.f, 0.f};
#pragma unroll 1
        for (int q = 0; q < RC_RD; ++q) RC_DMA(q, q);
        asm volatile("s_waitcnt vmcnt(0)" ::: "memory");
        int slot = 0;
#pragma unroll 1
        for (int ci = 0; ci < 144; ++ci) {
            const int nb = RC_NB(ci); const int row0 = b * TPB + nb * 16;
            asm volatile("s_waitcnt vmcnt(%0)" :: "n"((RC_RD - 1) * 14 + 4) : "memory");
            const LAS bf16_t* sp = (const LAS bf16_t*)(ring + slot * RC_SLOT);
            u32x2 kh[2][2], rh[2][2], ah[4], zt[4], wy, vt; f32x4 gc[4];
#pragma unroll
            for (int k = 0; k < 2; ++k) { kh[k][0] = *(const LAS u32x2*)(sp + fr * 64 + 32 * k + 4 * g); kh[k][1] = *(const LAS u32x2*)(sp + fr * 64 + 32 * k + 16 + 4 * g);
                rh[k][0] = *(const LAS u32x2*)(sp + 1024 + fr * 64 + 32 * k + 4 * g); rh[k][1] = *(const LAS u32x2*)(sp + 1024 + fr * 64 + 32 * k + 16 + 4 * g); }
#pragma unroll
            for (int m = 0; m < 4; ++m) { ah[m] = *(const LAS u32x2*)(sp + 2048 + (16 * m + fr) * 16 + 4 * g); zt[m] = *(const LAS u32x2*)(sp + 3072 + (16 * m + fr) * 16 + 4 * g);
                gc[m] = *(const LAS f32x4*)((const LAS float*)(sp + 4096) + 16 * m + 4 * g); }
            wy = *(const LAS u32x2*)(sp + 4096 + 128 + fr * 16 + 4 * g);
            vt = *(const LAS u32x2*)(sp + 4096 + 384 + fr * 16 + 4 * g);
            asm volatile("s_waitcnt lgkmcnt(0)" ::: "memory");
            RC_DMA(ci + RC_RD, slot);
            union { u32x4 u; bf16x8 v; } B0, B1, A;
            union { u32x2 u; bf16x4 v; } a4, b4, w4;
            B0.u = (u32x4){pk2m(S[0][0], S[0][1]), pk2m(S[0][2], S[0][3]), pk2m(S[1][0], S[1][1]), pk2m(S[1][2], S[1][3])};
            B1.u = (u32x4){pk2m(S[2][0], S[2][1]), pk2m(S[2][2], S[2][3]), pk2m(S[3][0], S[3][1]), pk2m(S[3][2], S[3][3])};
            b4.u = vt;
            f32x4 w = {0.f, 0.f, 0.f, 0.f}, y = {0.f, 0.f, 0.f, 0.f};
            A.u = (u32x4){kh[0][0].x, kh[0][0].y, kh[0][1].x, kh[0][1].y}; w = __builtin_amdgcn_mfma_f32_16x16x32_bf16(A.v, B0.v, w, 0, 0, 0);
            A.u = (u32x4){kh[1][0].x, kh[1][0].y, kh[1][1].x, kh[1][1].y}; w = __builtin_amdgcn_mfma_f32_16x16x32_bf16(A.v, B1.v, w, 0, 0, 0);
            A.u = (u32x4){rh[0][0].x, rh[0][0].y, rh[0][1].x, rh[0][1].y}; y = __builtin_amdgcn_mfma_f32_16x16x32_bf16(A.v, B0.v, y, 0, 0, 0);
            A.u = (u32x4){rh[1][0].x, rh[1][0].y, rh[1][1].x, rh[1][1].y}; y = __builtin_amdgcn_mfma_f32_16x16x32_bf16(A.v, B1.v, y, 0, 0, 0);
            a4.u = wy; y = __builtin_amdgcn_mfma_f32_16x16x16bf16_1k(a4.v, b4.v, y, 0, 0, 0);
            w4.u = (u32x2){pk2m(-w[0], -w[1]), pk2m(-w[2], -w[3])};
#pragma unroll
            for (int m = 0; m < 4; ++m) {
                f32x4 d = {0.f, 0.f, 0.f, 0.f};
                a4.u = zt[m]; d = __builtin_amdgcn_mfma_f32_16x16x16bf16_1k(a4.v, b4.v, d, 0, 0, 0);
                a4.u = ah[m]; d = __builtin_amdgcn_mfma_f32_16x16x16bf16_1k(a4.v, w4.v, d, 0, 0, 0);
                S[m] = S[m] * gc[m] + d;
            }
#pragma unroll
            for (int j = 0; j < 4; ++j) { const int t = 4 * g + j; YSp[(size_t)(row0 + (dir ? 15 - t : t)) * 256] = f2bf(y[j]); }
            slot = slot + 1 == RC_RD ? 0 : slot + 1;
        }
        asm volatile("s_waitcnt vmcnt(0)" ::: "memory");
#undef RC_NB
#undef RC_DMA
    }
}

__device__ __forceinline__ void hgrn_scan(const Ctx& c) {
    const int lane = c.lane, fr = lane & 15, g = lane >> 4;
    for (int task = c.bid; task < 256; task += c.G) {
        const int b = task >> 5, h = (task >> 3) & 3, dir = (task >> 2) & 1, vs = task & 3;
        const bf16_t* QIN = c.w<bf16_t>(WS_QIN) + (size_t)dir * MTOK * 256 + h * 64;
        const bf16_t* KOT = c.w<bf16_t>(WS_KOT) + (((size_t)(dir * 8 + b) * 4 + h) * NBLK16) * 1024;
        const bf16_t* IT = c.w<bf16_t>(WS_IT) + (((size_t)(b * 4 + h)) * NBLK16) * 1024;
        const float* DEC = c.w<float>(WS_DEC) + (((size_t)(dir * 8 + b) * 4 + h) * NBLK16) * 64;
        bf16_t* O2 = c.w<bf16_t>(WS_O2) + (size_t)dir * MTOK * 256 + h * 64 + vs * 16 + fr;
        f32x4 S[4];
#pragma unroll
        for (int m = 0; m < 4; ++m) S[m] = (f32x4){0.f, 0.f, 0.f, 0.f};
        u32x2 q00[4], q01[4], q10[4], q11[4]; f32x4 dc[4][4]; bf16x4 ka[4][4], ib[4];
#define HG_NB(ci_) (dir == 0 ? (ci_) : ((ci_) < 16 ? 15 - (ci_) : 159 - (ci_)))
#define HG_LOAD(ci_, st_) do { int cc_ = (ci_); cc_ = cc_ < NBLK16 ? cc_ : NBLK16 - 1; const int nb_ = HG_NB(cc_); const bf16_t* qp_ = QIN + (size_t)(b * TPB + nb_ * 16 + fr) * 256 + 4 * g; \
        q00[st_] = *(const u32x2*)qp_; q01[st_] = *(const u32x2*)(qp_ + 16); q10[st_] = *(const u32x2*)(qp_ + 32); q11[st_] = *(const u32x2*)(qp_ + 48); \
        _Pragma("unroll") for (int m_ = 0; m_ < 4; ++m_) { dc[st_][m_] = *(const f32x4*)(DEC + (size_t)nb_ * 64 + 16 * m_ + 4 * g); ka[st_][m_] = *(const bf16x4*)(KOT + (size_t)nb_ * 1024 + (16 * m_ + fr) * 16 + 4 * g); } \
        ib[st_] = *(const bf16x4*)(IT + (size_t)nb_ * 1024 + (vs * 16 + fr) * 16 + 4 * g); MEMBAR(); } while (0)
#define HG_STEP(ci_, st_) do { const int nb_ = HG_NB(ci_); const int row0_ = b * TPB + nb_ * 16; \
        union { u32x4 u; bf16x8 v; } A0, A1, B0, B1; \
        A0.u = (u32x4){q00[st_].x, q00[st_].y, q01[st_].x, q01[st_].y}; A1.u = (u32x4){q10[st_].x, q10[st_].y, q11[st_].x, q11[st_].y}; \
        B0.u = (u32x4){pk2m(S[0][0], S[0][1]), pk2m(S[0][2], S[0][3]), pk2m(S[1][0], S[1][1]), pk2m(S[1][2], S[1][3])}; \
        B1.u = (u32x4){pk2m(S[2][0], S[2][1]), pk2m(S[2][2], S[2][3]), pk2m(S[3][0], S[3][1]), pk2m(S[3][2], S[3][3])}; \
        f32x4 o = (f32x4){0.f, 0.f, 0.f, 0.f}; \
        o = __builtin_amdgcn_mfma_f32_16x16x32_bf16(A0.v, B0.v, o, 0, 0, 0); o = __builtin_amdgcn_mfma_f32_16x16x32_bf16(A1.v, B1.v, o, 0, 0, 0); \
        _Pragma("unroll") for (int j_ = 0; j_ < 4; ++j_) O2[(size_t)(row0_ + 4 * g + j_) * 256] = f2bf(o[j_]); \
        _Pragma("unroll") for (int m_ = 0; m_ < 4; ++m_) { S[m_] = S[m_] * dc[st_][m_]; S[m_] = __builtin_amdgcn_mfma_f32_16x16x16bf16_1k(ka[st_][m_], ib[st_], S[m_], 0, 0, 0); } } while (0)
        HG_LOAD(0, 0); HG_LOAD(1, 1); HG_LOAD(2, 2);
#pragma unroll 1
        for (int ci = 0; ci < NBLK16; ci += 4) {
            HG_LOAD(ci + 3, 3); HG_STEP(ci, 0);
            HG_LOAD(ci + 4, 0); HG_STEP(ci + 1, 1);
            HG_LOAD(ci + 5, 1); HG_STEP(ci + 2, 2);
            HG_LOAD(ci + 6, 2); HG_STEP(ci + 3, 3);
        }
#undef HG_NB
#undef HG_LOAD
#undef HG_STEP
    }
}

template <bool LAT> __device__ __forceinline__ void attn_unit(const Ctx& c, int l, int b, int h, int r, int jb) {
    const int lane = c.lane, fr = lane & 15, g = lane >> 4;
    const size_t bh = (size_t)(b * 8 + h);
    const bf16_t* Q = c.w<bf16_t>(WS_QN) + bh * TPB * 64; const bf16_t* K = c.w<bf16_t>(WS_KN) + bh * TPB * 64; const bf16_t* V = c.w<bf16_t>(WS_VT) + bh * 64 * TPB;
    const int q0 = LAT ? CTX + r * 64 + jb * 16 : jb * 16;
    const bf16x8 qf0 = *(const bf16x8*)(Q + (size_t)(q0 + fr) * 64 + 8 * g), qf1 = *(const bf16x8*)(Q + (size_t)(q0 + fr) * 64 + 32 + 8 * g);
    constexpr int NT = LAT ? 32 : 16, NB = NT / 8;
    int r_start = r - 4; r_start = r_start < 0 ? 0 : (r_start > 24 ? 24 : r_start);
    int k_start = 16 * jb - 8; k_start = k_start < 0 ? 0 : (k_start > 32 ? 32 : k_start);
    const bf16_t* kbase = K + (size_t)(fr >> 3) * 512 + (fr & 7) * 32 + g * 8;
#define KEY0(t) ((t) < 16 ? (t) * 16 : CTX + (r_start + (((t) - 16) >> 1)) * 64 + k_start + 16 * ((t) & 1))
    f32x4 sc[NT];
    bf16x8 kf[2][8][2];
#define K_ISSUE(bt, buf) do { _Pragma("unroll") for (int i_ = 0; i_ < 8; ++i_) { const bf16_t* kp_ = kbase + (size_t)(KEY0((bt) * 8 + i_) >> 3) * 512; \
        kf[buf][i_][0] = *(const bf16x8*)kp_; kf[buf][i_][1] = *(const bf16x8*)(kp_ + 256); } MEMBAR(); } while (0)
#define K_COMP(bt, buf) do { _Pragma("unroll") for (int i_ = 0; i_ < 8; ++i_) { f32x4 a_ = (f32x4){0.f, 0.f, 0.f, 0.f}; \
        a_ = __builtin_amdgcn_mfma_f32_16x16x32_bf16(kf[buf][i_][0], qf0, a_, 0, 0, 0); a_ = __builtin_amdgcn_mfma_f32_16x16x32_bf16(kf[buf][i_][1], qf1, a_, 0, 0, 0); sc[(bt) * 8 + i_] = a_; } MEMBAR(); } while (0)
    K_ISSUE(0, 0); K_ISSUE(1, 1);
    K_COMP(0, 0);
    if (LAT) { K_ISSUE(2, 0); K_COMP(1, 1); K_ISSUE(3, 1); K_COMP(2, 0); K_COMP(3, 1); }
    else K_COMP(1, 1);
#undef K_ISSUE
#undef K_COMP
    if (LAT) {
        const int qc = 16 * jb + fr; int w_start = qc - 8; w_start = w_start < 0 ? 0 : (w_start > 48 ? 48 : w_start);
        const float* rpb = c.a->in[25] + (size_t)(l * 8 + h) * 15 * 31;
        float bias[16][4];
#pragma unroll
        for (int t = 16; t < NT; ++t) {
            const int rrow = (t - 16) >> 1, hf = t & 1; const int ridx = r_start + rrow - r + 7;
#pragma unroll
            for (int j = 0; j < 4; ++j) { const int kc = k_start + 16 * hf + 4 * g + j; int cidx = kc - qc + 15; cidx = cidx < 0 ? 0 : (cidx > 30 ? 30 : cidx); bias[t - 16][j] = rpb[ridx * 31 + cidx]; }
        }
        MEMBAR();
#pragma unroll
        for (int t = 16; t < NT; ++t)
#pragma unroll
            for (int j = 0; j < 4; ++j) { const int kc = k_start + 16 * (t & 1) + 4 * g + j; const bool ok = kc >= w_start && kc < w_start + 16; sc[t][j] = ok ? sc[t][j] + bias[t - 16][j] : -1e30f; }
    }
    float m = -3e38f;
#pragma unroll
    for (int t = 0; t < NT; ++t) m = fmaxf(m, fmaxf(fmaxf(sc[t][0], sc[t][1]), fmaxf(sc[t][2], sc[t][3])));
    m = fmaxf(m, shx(m, 16)); m = fmaxf(m, shx(m, 32));
    float ls = 0.f;
    u32x4 pa[NT / 2];
#pragma unroll
    for (int ks = 0; ks < NT / 2; ++ks) {
        float p[8];
#pragma unroll
        for (int j = 0; j < 4; ++j) { p[j] = __expf(sc[2 * ks][j] - m); p[4 + j] = __expf(sc[2 * ks + 1][j] - m); }
#pragma unroll
        for (int j = 0; j < 8; ++j) ls += p[j];
        pa[ks] = (u32x4){pk2m(p[0], p[1]), pk2m(p[2], p[3]), pk2m(p[4], p[5]), pk2m(p[6], p[7])};
    }
    ls += shx(ls, 16); ls += shx(ls, 32);
    f32x4 o[4];
#pragma unroll
    for (int n = 0; n < 4; ++n) o[n] = (f32x4){0.f, 0.f, 0.f, 0.f};
    const bf16_t* vbase = V + (size_t)(g >> 1) * 512 + fr * 8 + (g & 1) * 4;
    u32x2 vf[2][2][4][2];
#define V_ISSUE(bt, buf) do { _Pragma("unroll") for (int i_ = 0; i_ < 2; ++i_) { const int ta_ = 2 * ((bt) * 2 + i_); const int tok_ = KEY0(ta_); \
        _Pragma("unroll") for (int n_ = 0; n_ < 4; ++n_) { const bf16_t* vp_ = vbase + n_ * 128 + (size_t)(tok_ >> 3) * 512; vf[buf][i_][n_][0] = *(const u32x2*)vp_; vf[buf][i_][n_][1] = *(const u32x2*)(vp_ + 1024); } } MEMBAR(); } while (0)
#define V_COMP(bt, buf) do { _Pragma("unroll") for (int i_ = 0; i_ < 2; ++i_) { union { u32x4 u; bf16x8 v; } pa_; pa_.u = pa[(bt) * 2 + i_]; \
        _Pragma("unroll") for (int n_ = 0; n_ < 4; ++n_) { union { u32x4 u; bf16x8 v; } vf_; vf_.u = (u32x4){vf[buf][i_][n_][0].x, vf[buf][i_][n_][0].y, vf[buf][i_][n_][1].x, vf[buf][i_][n_][1].y}; \
            o[n_] = __builtin_amdgcn_mfma_f32_16x16x32_bf16(pa_.v, vf_.v, o[n_], 0, 0, 0); } } MEMBAR(); } while (0)
    V_ISSUE(0, 0); V_ISSUE(1, 1);
    V_COMP(0, 0); V_ISSUE(2, 0); V_COMP(1, 1); V_ISSUE(3, 1); V_COMP(2, 0);
    if (LAT) { V_ISSUE(4, 0); V_COMP(3, 1); V_ISSUE(5, 1); V_COMP(4, 0); V_ISSUE(6, 0); V_COMP(5, 1); V_ISSUE(7, 1); V_COMP(6, 0); V_COMP(7, 1); }
    else V_COMP(3, 1);
#undef V_ISSUE
#undef V_COMP
#undef KEY0
    bf16_t* MIX = c.w<bf16_t>(WS_MIX);
#pragma unroll
    for (int j = 0; j < 4; ++j) {
        const float li = 1.f / shidx(ls, 4 * g + j);
        bf16_t* dst = MIX + (size_t)(b * TPB + q0 + 4 * g + j) * D + 512 + h * 64 + fr;
#pragma unroll
        for (int n = 0; n < 4; ++n) dst[16 * n] = f2bf(o[n][j] * li);
    }
}

__device__ __forceinline__ void phase_mix(const Ctx& c, int l) {
#pragma unroll 1
    for (int rep = 0; rep < (REP_PHASE == 41 ? 2 : 1); ++rep) if (c.wave == 0) { __builtin_amdgcn_s_setprio(3); rwkv_scan(c); __builtin_amdgcn_s_setprio(0); }
#pragma unroll 1
    for (int rep = 0; rep < (REP_PHASE == 42 ? 2 : 1); ++rep) if (c.wave == 1) { __builtin_amdgcn_s_setprio(3); hgrn_scan(c); __builtin_amdgcn_s_setprio(0); }
    if (c.G == 256) {
        const int x = c.bid & 7;
        unsigned* head = c.w<unsigned>(WS_CTL) + CW_ATT + (l * 8 + x) * 64;
        unsigned un = 0;
        if (c.lane == 0) un = __hip_atomic_fetch_add(head, 1u, __ATOMIC_RELAXED, __HIP_MEMORY_SCOPE_AGENT);
        for (;;) {
            const unsigned u = (unsigned)__builtin_amdgcn_readfirstlane((int)un);
            if (u >= 8 * 144) break;
            if (c.lane == 0) un = __hip_atomic_fetch_add(head, 1u, __ATOMIC_RELAXED, __HIP_MEMORY_SCOPE_AGENT);
            const int p = (int)u / 144, q = (int)u - p * 144, gp = p * 8 + x, b = gp >> 3, h = gp & 7;
            if (q < 128) attn_unit<true>(c, l, b, h, q >> 2, q & 3);
            else if (l < DEPTH - 1) attn_unit<false>(c, l, b, h, 0, q - 128);
        }
    } else {
        for (int u = c.bid * 8 + c.wave; u < 8192 + 1024; u += c.G * 8) {
            if (u < 8192) attn_unit<true>(c, l, u >> 10, (u >> 7) & 7, (u >> 2) & 31, u & 3);
            else { const int v = u - 8192; attn_unit<false>(c, l, v >> 7, (v >> 4) & 7, 0, v & 15); }
        }
    }
}

__device__ __forceinline__ void cvt_moe_group(const Ctx& c, int l, int task4) {
    LAS float* T = (LAS float*)c.lds;
    bf16_t* W1 = c.w<bf16_t>(WS_W1); bf16_t* W2 = c.w<bf16_t>(WS_W2);
    CvtJob jb[4];
#pragma unroll
    for (int q = 0; q < 4; ++q) {
        const int task = task4 * 4 + q; const int e = task / 384; int t = task - e * 384;
        if (t < 256) { const int up = t >> 7; t &= 127; const int kt = t >> 3, nt = t & 7; const int n0 = nt * 64, drow = (n0 >> 7) * 256 + (n0 & 127) + up * 128;
            jb[q].src = c.a->in[up ? 31 : 30] + (((size_t)l * 32 + e) * 1024 + kt * 64) * 512 + n0; jb[q].src_ld = 512; jb[q].dst = W1 + ((size_t)e * 1024 + drow) * 1024 + kt * 64; jb[q].dst_ld = 1024;
        } else { t -= 256; const int kt = t >> 4, nt = t & 15;
            jb[q].src = c.a->in[32] + (((size_t)l * 32 + e) * 512 + kt * 64) * 1024 + nt * 64; jb[q].src_ld = 1024; jb[q].dst = W2 + ((size_t)e * 1024 + nt * 64) * 512 + kt * 64; jb[q].dst_ld = 512;
        }
    }
    cvt_tile4(c, T, jb);
}

__device__ __forceinline__ void phase_post(const Ctx& c, int l) {
    const bf16_t* P = c.w<bf16_t>(WS_P); bf16_t* MIX = c.w<bf16_t>(WS_MIX);
    const bf16_t* O1 = c.w<bf16_t>(WS_O1); const bf16_t* O2 = c.w<bf16_t>(WS_O2); const bf16_t* YS = c.w<bf16_t>(WS_YS);
    const bf16_t* GG = c.w<bf16_t>(WS_G); const bf16_t* BON = c.w<bf16_t>(WS_BON);
    const int lane = c.lane;
    {
        const int ch = lane * 4, stride = c.G * 8;
        const f32x4 gn = *(const f32x4*)(c.a->in[11] + (size_t)l * 256 + ch), lg = *(const f32x4*)(c.a->in[21] + (size_t)l * 256 + ch), lb = *(const f32x4*)(c.a->in[22] + (size_t)l * 256 + ch);
        u32x2 pa, pbo, pgg, pgp, pb0, pb1, py0, py1;
#define POST_LOAD(r_) do { const size_t rr_ = (size_t)(r_); pa = *(const u32x2*)(O1 + rr_ * 256 + ch); pb0 = *(const u32x2*)(O2 + rr_ * 256 + ch); pb1 = *(const u32x2*)(O2 + ((size_t)MTOK + rr_) * 256 + ch); \
        pgp = *(const u32x2*)(P + rr_ * PT + PA_G + ch); py0 = *(const u32x2*)(YS + rr_ * 256 + ch); py1 = *(const u32x2*)(YS + ((size_t)MTOK + rr_) * 256 + ch); \
        pbo = *(const u32x2*)(BON + rr_ * 256 + ch); pgg = *(const u32x2*)(GG + rr_ * 256 + ch); } while (0)
        const bool lat_only = (l == DEPTH - 1); const int nrows = lat_only ? NB * SEQ : MTOK;
#define POST_ROW(i_) (lat_only ? ((i_) >> 11) * TPB + CTX + ((i_) & (SEQ - 1)) : (i_))
        POST_LOAD(POST_ROW(c.bid * 8 + c.wave));
        for (int ri = c.bid * 8 + c.wave; ri < nrows; ri += stride) {
            const int row = POST_ROW(ri);
            const u32x2 gp = pgp;
            const f32x4 a = {bflo(pa.x), bfhi(pa.x), bflo(pa.y), bfhi(pa.y)}, bo = {bflo(pbo.x), bfhi(pbo.x), bflo(pbo.y), bfhi(pbo.y)}, gg = {bflo(pgg.x), bfhi(pgg.x), bflo(pgg.y), bfhi(pgg.y)};
            const f32x4 b0 = {bflo(pb0.x), bfhi(pb0.x), bflo(pb0.y), bfhi(pb0.y)}, b1 = {bflo(pb1.x), bfhi(pb1.x), bflo(pb1.y), bfhi(pb1.y)};
            const f32x4 y0 = {bflo(py0.x), bfhi(py0.x), bflo(py0.y), bfhi(py0.y)}, y1 = {bflo(py1.x), bfhi(py1.x), bflo(py1.y), bfhi(py1.y)};
            POST_LOAD(ri + stride < nrows ? POST_ROW(ri + stride) : row);
            {
                const f32x4 o = a + b0 + b1;
                float ss = o[0] * o[0] + o[1] * o[1] + o[2] * o[2] + o[3] * o[3]; ss = red16(ss);
                const float inv = rsqrtf(ss * (1.f / 64.f) + 1e-6f);
                const float g0 = bflo(gp.x), g1 = bfhi(gp.x), g2 = bflo(gp.y), g3 = bfhi(gp.y);
                u32x2 w; w.x = pk2(o[0] * inv * gn[0] * g0 * sigm(g0), o[1] * inv * gn[1] * g1 * sigm(g1)); w.y = pk2(o[2] * inv * gn[2] * g2 * sigm(g2), o[3] * inv * gn[3] * g3 * sigm(g3));
                *(u32x2*)(MIX + (size_t)row * D + ch) = w;
            }
            {
                const f32x4 y = y0 + y1;
                float sm = y[0] + y[1] + y[2] + y[3]; sm = red16(sm); const float mean = sm * (1.f / 64.f);
                const f32x4 dv = y - mean;
                float vs = dv[0] * dv[0] + dv[1] * dv[1] + dv[2] * dv[2] + dv[3] * dv[3]; vs = red16(vs);
                const float inv = rsqrtf(vs * (1.f / 64.f) + 64e-5f);
                const f32x4 r = (dv * inv * lg + lb + bo) * gg;
                u32x2 w; w.x = pk2(r[0], r[1]); w.y = pk2(r[2], r[3]);
                *(u32x2*)(MIX + (size_t)row * D + 256 + ch) = w;
            }
        }
#undef POST_LOAD
#undef POST_ROW
    }
    __syncthreads();
    {
        const int first = c.G == 256 ? 384 : 0, nhere = (l < DEPTH - 1 && c.G == 256) ? 0 : 2048;
        for (int i = first + c.bid; i < nhere; i += c.G) cvt_moe_group(c, l, 96 * (i >> 6) + (i & 63));
    }
}

constexpr int WG_OFF = 140288;
__device__ __forceinline__ void phase_norm2(const Ctx& c, int l) {
    const float* MOD = c.w<float>(WS_MOD); const float* X = c.w<float>(WS_X); bf16_t* H = c.w<bf16_t>(WS_H);
    int4* ROUTE = c.w<int4>(WS_ROUTE); int* LIST = c.w<int>(WS_LIST); float* LISTW = c.w<float>(WS_LISTW);
    unsigned* CNT = c.w<unsigned>(WS_CTL) + CW_CNT + l * 64;
    const float* brg = c.a->in[27] + l * 4; const float* bre = c.a->in[29] + l * 32;
    LAS float* WE = (LAS float*)c.lds; LAS float* WG = (LAS float*)(c.lds + WG_OFF);
    LAS unsigned* lcnt = (LAS unsigned*)(c.lds + MISC_OFF + 1024); LAS unsigned* lbase = lcnt + 32; LAS int* rinfo = (LAS int*)(lcnt + 64);
    const int lane = c.lane;
    {
        const f32x4* wre4 = (const f32x4*)(c.a->in[28] + (size_t)l * 1024 * 32); const f32x4* wrg4 = (const f32x4*)(c.a->in[26] + (size_t)l * 1024 * 4);
        f32x4 wv[18];
#pragma unroll
        for (int i = 0; i < 16; ++i) wv[i] = wre4[c.tid + i * 512];
#pragma unroll
        for (int i = 0; i < 2; ++i) wv[16 + i] = wrg4[c.tid + i * 512];
#pragma unroll
        for (int i = 0; i < 16; ++i) { const int idx = c.tid + i * 512; const int k = idx >> 3, c4 = idx & 7, slot = ((k >> 8) * 4 + (k & 3)) * 64 + ((k >> 2) & 63);
            *(LAS f32x4*)(WE + ((size_t)((c4 >> 1) * 1024 + slot)) * 8 + (c4 & 1) * 4) = wv[i]; }
#pragma unroll
        for (int i = 0; i < 2; ++i) { const int k = c.tid + i * 512; const int slot = ((k >> 8) * 4 + (k & 3)) * 64 + ((k >> 2) & 63); *(LAS f32x4*)(WG + slot * 4) = wv[16 + i]; }
        if (c.tid < 32) lcnt[c.tid] = 0u;
    }
    __syncthreads();
    int nrow = 0;
    const int stride = c.G * 8;
    f32x4 gn4[4], xc[4], shc[4], scc[4];
    {
        const float* gain = c.a->in[5] + (size_t)l * D; const int row0 = c.bid * 8 + c.wave; const int b0 = row0 / TPB, s0 = row0 - b0 * TPB;
        const float* md0 = MOD + ((size_t)l * 9 + (s0 < CTX ? 8 : b0)) * 6144;
#pragma unroll
        for (int j = 0; j < 4; ++j) { const int col = lane * 4 + 256 * j; gn4[j] = *(const f32x4*)(gain + col);
            xc[j] = *(const f32x4*)(X + (size_t)row0 * D + col); shc[j] = *(const f32x4*)(md0 + 3072 + col); scc[j] = *(const f32x4*)(md0 + 4096 + col); }
    }
    for (int row = c.bid * 8 + c.wave; row < MTOK; row += stride) {
        const int b = row / TPB, s = row - b * TPB;
        f32x4 x[4], shv[4], scv[4];
#pragma unroll
        for (int j = 0; j < 4; ++j) { x[j] = xc[j]; shv[j] = shc[j]; scv[j] = scc[j]; }
        {
            const int rn = row + stride < MTOK ? row + stride : row; const int bn = rn / TPB, sn = rn - bn * TPB;
            const float* mdn = MOD + ((size_t)l * 9 + (sn < CTX ? 8 : bn)) * 6144;
#pragma unroll
            for (int j = 0; j < 4; ++j) { const int col = lane * 4 + 256 * j;
                xc[j] = *(const f32x4*)(X + (size_t)rn * D + col); shc[j] = *(const f32x4*)(mdn + 3072 + col); scc[j] = *(const f32x4*)(mdn + 4096 + col); }
        }
        if (l == DEPTH - 1 && s < CTX) continue;
        float ss = 0.f;
#pragma unroll
        for (int j = 0; j < 4; ++j) ss += x[j][0] * x[j][0] + x[j][1] * x[j][1] + x[j][2] * x[j][2] + x[j][3] * x[j][3];
        ss = red64(ss);
        const float inv = rsqrtf(ss * (1.f / 1024.f) + 1e-6f);
        f32x4 hv[4];
#pragma unroll
        for (int j = 0; j < 4; ++j) { const int col = lane * 4 + 256 * j;
            hv[j] = x[j] * inv * gn4[j] * (1.f + scv[j]) + shv[j];
            u32x2 o; o.x = pk2(hv[j][0], hv[j][1]); o.y = pk2(hv[j][2], hv[j][3]); *(u32x2*)(H + (size_t)row * D + col) = o; }
        f32x4 gl4 = {0.f, 0.f, 0.f, 0.f};
#pragma unroll
        for (int j = 0; j < 4; ++j)
#pragma unroll
            for (int e = 0; e < 4; ++e) gl4 += *(const LAS f32x4*)(WG + ((j * 4 + e) * 64 + lane) * 4) * hv[j][e];
        float gl[4];
#pragma unroll
        for (int q = 0; q < 4; ++q) gl[q] = red64(gl4[q]) + brg[q];
        int gs = 0; float gm = gl[0];
#pragma unroll
        for (int q = 1; q < 4; ++q) if (gl[q] > gm) { gm = gl[q]; gs = q; }
        gs = __builtin_amdgcn_readfirstlane(gs);
        const float gw = 1.f / (expf(gl[0] - gm) + expf(gl[1] - gm) + expf(gl[2] - gm) + expf(gl[3] - gm));
        f32x4 e0 = {0.f, 0.f, 0.f, 0.f}, e1 = e0;
        const LAS float* we = WE + ((size_t)gs * 1024 + lane) * 8;
#pragma unroll
        for (int j = 0; j < 4; ++j)
#pragma unroll
            for (int e = 0; e < 4; ++e) { const LAS float* wp = we + (j * 4 + e) * 64 * 8; e0 += *(const LAS f32x4*)wp * hv[j][e]; e1 += *(const LAS f32x4*)(wp + 4) * hv[j][e]; }
        float el[8];
#pragma unroll
        for (int q = 0; q < 4; ++q) { el[q] = red64(e0[q]) + bre[gs * 8 + q]; el[4 + q] = red64(e1[q]) + bre[gs * 8 + 4 + q]; }
        int i0 = 0; float m0 = el[0];
#pragma unroll
        for (int q = 1; q < 8; ++q) if (el[q] > m0) { m0 = el[q]; i0 = q; }
        int i1 = -1; float m1 = -3e38f;
#pragma unroll
        for (int q = 0; q < 8; ++q) if (q != i0 && el[q] > m1) { m1 = el[q]; i1 = q; }
        if (i1 < 0) i1 = (i0 + 1) & 7;
        const float p1 = expf(m1 - m0);
        const float wa = gw / (1.f + p1), wb = gw * p1 / (1.f + p1);
        if (lane == 0) {
            const int ea = gs * 8 + i0, eb = gs * 8 + i1;
            const int ra = (int)__hip_atomic_fetch_add(lcnt + ea, 1u, __ATOMIC_RELAXED, __HIP_MEMORY_SCOPE_WORKGROUP);
            const int rb = (int)__hip_atomic_fetch_add(lcnt + eb, 1u, __ATOMIC_RELAXED, __HIP_MEMORY_SCOPE_WORKGROUP);
            LAS int* ri = rinfo + (c.wave * 16 + nrow) * 8;
            ri[0] = ea; ri[1] = ra; ri[2] = eb; ri[3] = rb; ri[4] = __float_as_int(wa); ri[5] = __float_as_int(wb); ri[6] = row;
        }
        ++nrow;
    }
    __syncthreads();
    if (c.tid < 32) { const unsigned n = lcnt[c.tid]; lbase[c.tid] = n ? atomicAdd(CNT + c.tid, n) : 0u; }
    __syncthreads();
    if (lane < nrow) {
        const LAS int* ri = rinfo + (c.wave * 16 + lane) * 8;
        const int ea = ri[0], eb = ri[2], row = ri[6]; const int pa = (int)lbase[ea] + ri[1], pb = (int)lbase[eb] + ri[3];
        LIST[(size_t)ea * MTOK + pa] = row; LISTW[(size_t)ea * MTOK + pa] = __int_as_float(ri[4]);
        LIST[(size_t)eb * MTOK + pb] = row; LISTW[(size_t)eb * MTOK + pb] = __int_as_float(ri[5]);
        ROUTE[row] = make_int4(ea, pa, eb, pb);
    }
}

constexpr int NPHASE = 2 + 9 * DEPTH;

__global__ void __launch_bounds__(512, 2) mk_fwd(Args a) {
    extern __shared__ __attribute__((aligned(16))) unsigned char lds_raw[];
    Ctx c;
    c.a.in.a = (const __attribute__((address_space(4))) Args*)__builtin_amdgcn_kernarg_segment_ptr(); c.out = (float*)a.out; c.ws = a.ws; c.lds = (LAS unsigned char*)lds_raw;
    const int wave0 = __builtin_amdgcn_readfirstlane((int)threadIdx.x >> 6);
    { int t_; asm volatile("v_mbcnt_lo_u32_b32 %0, -1, 0\n\tv_mbcnt_hi_u32_b32 %0, -1, %0" : "=v"(t_)); c.tid = wave0 * 64 + t_; }
    c.lane = c.tid & 63; c.wave = wave0; c.bid = blockIdx.x; c.G = gridDim.x;
    const int lo = a.lo, hi = a.hi;
    if (c.tid < 4) ((LAS unsigned*)(c.lds + MISC_OFF))[c.tid] = 0u;
    __syncthreads();
    XcdBarrier bar; bar.bar = c.w<unsigned>(WS_CTL); bar.x = 0; bar.st = (volatile LAS unsigned*)(c.lds + MISC_OFF);
    if (hi - lo > 1) bar = xcd_barrier_post(c.w<unsigned>(WS_CTL), (volatile LAS unsigned*)(c.lds + MISC_OFF), (unsigned)c.tid);
#ifndef PH_ONLY
#define PH_ONLY -1
#endif
#define PHON(j) (PH_ONLY < 0 || PH_ONLY == (j))
#define IN(k) (lo <= (k) && (k) < hi)
#define SEAM(k) do { if (IN((k) + 1)) xcd_barrier(bar, (unsigned)c.tid); } while (0)
#define FRESH() do { const __attribute__((address_space(4))) Args* ap_ = (const __attribute__((address_space(4))) Args*)__builtin_amdgcn_kernarg_segment_ptr(); \
        GAS unsigned char* wp_ = ap_->ws; int t_; asm volatile("v_mbcnt_lo_u32_b32 %0, -1, 0\n\tv_mbcnt_hi_u32_b32 %0, -1, %0" : "=v"(t_)); t_ += wave0 * 64; asm volatile("" : "+s"(ap_), "+s"(wp_)); \
        c.a.in.a = ap_; c.out = (float*)ap_->out; c.ws = wp_; c.tid = t_; c.lane = t_ & 63; c.wave = __builtin_amdgcn_readfirstlane(t_ >> 6); } while (0)
#if REP_PHASE >= 0 && REP_PHASE <= 10
#define SITE(j, pidx, ...) if (PHON(j) && IN(pidx)) { int nrep_ = (REP_PHASE == (j)) ? 2 : 1; asm volatile("" : "+s"(nrep_)); \
        for (int rep_ = 0; rep_ < nrep_; ++rep_) { FRESH(); { __VA_ARGS__ } if (rep_ + 1 < nrep_) xcd_barrier(bar, (unsigned)c.tid); } SEAM(pidx); }
#else
#define SITE(j, pidx, ...) if (PHON(j) && IN(pidx)) { FRESH(); { __VA_ARGS__ } SEAM(pidx); }
#endif
    SITE(0, 0, phase_prologue(c);)
#pragma unroll 1
    for (int l = 0; l < DEPTH; ++l) {
        const int p0 = 1 + 9 * l;
        SITE(1, p0 + 0, phase_norm1(c, l);)
        SITE(2, p0 + 1,
            pg8::StaticOrder S; S.init(c.w<bf16_t>(WS_H), c.w<bf16_t>(WS_WIN) + (size_t)l * 4096 * 1024, MTOK, 4096, 1024, c.G, c.bid);
            pg8::EpiBf16Rows E{c.w<bf16_t>(WS_P), PT, PT};
            pg8::gemm_phase(c.lds, c.tid, S, E);
            if (c.G == 256 && c.bid >= 128) { __syncthreads();
                for (int j = 0; j < 3; ++j) { const int i = (c.bid - 128) * 3 + j; cvt_moe_group(c, l, 96 * (i >> 6) + (i & 63)); } })
        SITE(3, p0 + 2, phase_prep(c, l); __syncthreads(); if (REP_PHASE == 31) { FRESH(); phase_prep(c, l); __syncthreads(); }
                        FRESH(); phase_prep_hgrn(c, l); __syncthreads(); if (REP_PHASE == 32) { FRESH(); phase_prep_hgrn(c, l); __syncthreads(); }
                        FRESH(); phase_prep_rwkv(c, l); if (REP_PHASE == 33) { __syncthreads(); FRESH(); phase_prep_rwkv(c, l); }
)
        SITE(4, p0 + 3, phase_mix(c, l);)
        SITE(5, p0 + 4, phase_post(c, l);)
        SITE(6, p0 + 5,
            pg8::StaticOrder S; S.init(c.w<bf16_t>(WS_MIX), c.w<bf16_t>(WS_WOUT) + (size_t)l * 1024 * 1024, MTOK, 1024, 1024, c.G, c.bid, l == DEPTH - 1);
            pg8::EpiX E{c.w<float>(WS_X), c.w<float>(WS_MOD) + (size_t)l * 9 * 6144 + 2048};
            pg8::gemm_phase(c.lds, c.tid, S, E);
            if (l < DEPTH - 1 && c.G == 256 && c.bid >= 32) { __syncthreads();
                for (int j = 0; j < 8; ++j) { const int i = 384 + (c.bid - 32) * 8 + j; if (i < 2048) cvt_moe_group(c, l, 96 * (i >> 6) + (i & 63)); } })
        SITE(7, p0 + 6, phase_norm2(c, l);)
        SITE(8, p0 + 7,
            build_tpre(c, l);
            pg8::MoeOrder<true> S{(const char*)c.w<bf16_t>(WS_H), (const char*)c.w<bf16_t>(WS_W1), 1024, c.w<int>(WS_LIST), (const LAS int*)(c.lds + MISC_OFF + 64), (const LAS int*)(c.lds + MISC_OFF + 256), c.G, c.bid};
            pg8::EpiHid E{c.w<bf16_t>(WS_HID), c.w<float>(WS_LISTW)};
            pg8::gemm_phase(c.lds, c.tid, S, E);
            {
                unsigned* tk = c.w<unsigned>(WS_CTL) + CW_CVT + l * 64; LAS int* tl = (LAS int*)(c.lds + MISC_OFF + 32);
                for (;;) { __syncthreads();
                    if (c.tid == 0) *tl = (int)__hip_atomic_fetch_add(tk, 1u, __ATOMIC_RELAXED, __HIP_MEMORY_SCOPE_AGENT);
                    __syncthreads();
                    const int j = __builtin_amdgcn_readfirstlane(*tl); if (j >= 1024) break;
                    cvt_moe_group(c, l, 96 * (j >> 5) + 64 + (j & 31)); } })
        SITE(9, p0 + 8,
            build_tpre(c, l);
            pg8::MoeOrder<false> S{(const char*)c.w<bf16_t>(WS_HID), (const char*)c.w<bf16_t>(WS_W2), 512, c.w<int>(WS_LIST), (const LAS int*)(c.lds + MISC_OFF + 64), (const LAS int*)(c.lds + MISC_OFF + 256), c.G, c.bid};
            pg8::EpiBf16Rows E{c.w<bf16_t>(WS_Y), 1024, 1024};
            pg8::gemm_phase(c.lds, c.tid, S, E);)
    }
    SITE(10, NPHASE - 1, phase_norm1(c, DEPTH);)
#undef SITE
#undef IN
#undef SEAM
}

extern "C" void kernel_launch(void* const* d_in, const int* in_sizes, int n_in, void* d_out, int out_size, void* d_ws, size_t ws_size, hipStream_t stream) {
    static int grid = 0;
    if (grid == 0) {
        if (n_in != 33 || ws_size < WS_END2) { fprintf(stderr, "kernel_launch: unexpected n_in %d / ws %zu (need %zu)\n", n_in, ws_size, (size_t)WS_END2); grid = -1; return; }
        int dev = 0, cus = 0, per_cu = 0;
        hipGetDevice(&dev); hipDeviceGetAttribute(&cus, hipDeviceAttributeMultiprocessorCount, dev);
        if (hipFuncSetAttribute((const void*)mk_fwd, hipFuncAttributeMaxDynamicSharedMemorySize, LDS_BYTES) != hipSuccess) { fprintf(stderr, "kernel_launch: hipFuncSetAttribute failed\n"); grid = -1; return; }
        hipOccupancyMaxActiveBlocksPerMultiprocessor(&per_cu, (const void*)mk_fwd, 512, LDS_BYTES);
        (void)hipGetLastError();
        if (per_cu < 1) fprintf(stderr, "kernel_launch: occupancy query reports %d\n", per_cu);
        grid = cus > 0 ? cus : 256;
    }
    if (grid < 0) return;
    hipMemsetAsync((char*)d_ws + WS_CTL, 0, CTL_BYTES, stream);
    Args a{};
    for (int i = 0; i < 33; ++i) a.in.p[i] = (const GAS float*)d_in[i];
    a.out = (GAS float*)d_out; a.ws = (GAS unsigned char*)d_ws;
#if MK_SPLIT
    for (int p = 0; p < NPHASE; ++p) { a.lo = p; a.hi = p + 1; hipLaunchKernelGGL(mk_fwd, dim3(grid), dim3(512), LDS_BYTES, stream, a); }
#else
    a.lo = 0; a.hi = NPHASE; hipLaunchKernelGGL(mk_fwd, dim3(grid), dim3(512), LDS_BYTES, stream, a);
#endif
}
```

```cpp
#include <hip/hip_runtime.h>
#include <cstdio>
#include <cstdint>

#ifndef MK_SPLIT
#define MK_SPLIT 0
#endif

#ifndef REP_PHASE
#define REP_PHASE -1
#endif

#define LAS __attribute__((address_space(3)))
typedef unsigned short bf16_t;
typedef short  bf16x8 __attribute__((ext_vector_type(8)));
typedef short  bf16x4 __attribute__((ext_vector_type(4)));
typedef float  f32x4  __attribute__((ext_vector_type(4)));
typedef unsigned u32x4 __attribute__((ext_vector_type(4)));
typedef unsigned u32x2 __attribute__((ext_vector_type(2)));

constexpr int D = 1024, NB = 8, SEQ = 2048, CTX = 256, TPB = 2304, MTOK = NB * TPB, DEPTH = 4, PT = 3968;
constexpr int NEXP = 32, DF = 512, HIDROWS = 45056;
constexpr int NBLK16 = TPB / 16;
constexpr int PA_Q = 0, PA_FF = 256, PA_FB = 512, PA_I = 768, PA_G = 1024, PB0 = 1280, PC_Q = 2432, PC_K = 2944, PC_V = 3456;

constexpr size_t WS_CTL = 0, CTL_BYTES = 65536;
constexpr size_t WS_MOD = 65536;
constexpr size_t WS_LB = WS_MOD + 884736;
constexpr size_t WS_ROPE = WS_LB + 8192;
constexpr size_t WS_LORA = WS_ROPE + 8192;
constexpr size_t LORA_L = 196608;
constexpr size_t WS_ROUTE = WS_LORA + 4 * LORA_L;
constexpr size_t WS_LIST = WS_ROUTE + 294912;
constexpr size_t WS_LISTW = WS_LIST + 2359296;
constexpr size_t WS_WIN = 8388608;
constexpr size_t WS_WOUT = WS_WIN + 33554432;
constexpr size_t WS_W1 = WS_WOUT + 8388608;
constexpr size_t WS_W2 = WS_W1 + 67108864;
constexpr size_t WS_X = WS_W2 + 33554432;
constexpr size_t WS_H = WS_X + 75497472;
constexpr size_t WS_MIX = WS_H + 37748736;
constexpr size_t WS_P = WS_MIX + 37748736;
constexpr size_t WS_MR = WS_P + 146276352;
constexpr size_t SZ_T512 = 18874368;
constexpr size_t WS_QN = WS_MR, WS_KN = WS_QN + SZ_T512, WS_VT = WS_KN + SZ_T512;
constexpr size_t WS_QIN = WS_VT + SZ_T512;
constexpr size_t WS_KOT = WS_QIN + SZ_T512;
constexpr size_t WS_IT = WS_KOT + SZ_T512;
constexpr size_t WS_DEC = WS_IT + 9437184;
constexpr size_t WS_O1 = WS_DEC + 2359296;
constexpr size_t WS_O2 = WS_O1 + SZ_T512;
constexpr size_t WS_RW = WS_O2 + 2 * SZ_T512;
constexpr size_t WS_G = WS_RW + 226492416;
constexpr size_t WS_BON = WS_G + SZ_T512;
constexpr size_t WS_YS = WS_BON + SZ_T512;
constexpr size_t WS_END = WS_YS + 2 * SZ_T512;
constexpr size_t WS_Y = WS_P, WS_HID = WS_MR;
constexpr size_t WS_KHT = WS_W1;
constexpr size_t WS_AHT = WS_KHT + 18874368;
constexpr size_t WS_GC = WS_AHT + 18874368;
constexpr size_t WS_RH = WS_W1 + 75497472;
constexpr size_t WS_WY = WS_RH + 18874368;
constexpr size_t WS_ZT = WS_H;
constexpr size_t WS_VT2 = WS_H + 18874368;
static_assert(WS_WY + 4718592 <= WS_X, "chunk buffers");
static_assert(WS_END < (size_t)1000 * 1000 * 1000, "workspace");
constexpr int CW_CNT = 4096;
constexpr int CW_CVT = 12288;
constexpr int CW_ATT = 8192;

constexpr int LDS_BYTES = 163840, MISC_OFF = 131072;

#define XB_TMO      128
#define XB_XCNT(j)  (256  + 64 * (j))
#define XB_XSUB(j)  (1280 + 64 * (j))
#define XB_XGEN(j)  (2304 + 64 * (j))
#define XB_TOP      3328
#define XB_TOPGEN   3392
#define XCD_BAR_WORDS 3456
#define XB_SPIN_CAP (1u << 18)
__device__ __forceinline__ unsigned xb_ld(unsigned* p)              { return __hip_atomic_load(p, __ATOMIC_RELAXED, __HIP_MEMORY_SCOPE_AGENT); }
__device__ __forceinline__ unsigned xb_add(unsigned* p, unsigned v) { return __hip_atomic_fetch_add(p, v, __ATOMIC_RELAXED, __HIP_MEMORY_SCOPE_AGENT); }
__device__ __forceinline__ unsigned xb_xcc_id() { return (unsigned)__builtin_amdgcn_s_getreg((3 << 11) | 20) & 0xFu; }
#define XB_SPIN(cond, bar) do { unsigned _sp = 0; while (cond) { __builtin_amdgcn_s_sleep(1); \
    if ((++_sp & 255u) == 0u) { if (xb_ld(&(bar)[XB_TMO])) break; if (_sp > XB_SPIN_CAP) { atomicAdd(&(bar)[XB_TMO], 1u); break; } } } } while (0)
struct XcdBarrier { unsigned* bar; unsigned x; volatile LAS unsigned* st; };
__device__ __forceinline__ XcdBarrier xcd_barrier_post(unsigned* bar, volatile LAS unsigned* st, const unsigned tidx) {
    XcdBarrier b; b.bar = bar; b.x = xb_xcc_id(); b.st = st;
    if (tidx == 0) (void)xb_add(&bar[XB_XCNT(b.x)], 1u);
    return b;
}
__device__ __forceinline__ void xcd_barrier_complete(unsigned* bar, unsigned x, unsigned& nloc, unsigned& nx) {
    const unsigned G = gridDim.x * gridDim.y * gridDim.z;
    unsigned sum, cnt, mine, sp = 0u;
    for (;;) {
        sum = 0u; cnt = 0u; mine = 0u;
#pragma unroll
        for (unsigned j = 0; j < 16; ++j) { const unsigned c = xb_ld(&bar[XB_XCNT(j)]); sum += c; cnt += (c > 0u) ? 1u : 0u; mine = (j == x) ? c : mine; }
        if (sum == G) break;
        __builtin_amdgcn_s_sleep(1);
        if ((++sp & 255u) == 0u) { if (xb_ld(&bar[XB_TMO])) break; if (sp > XB_SPIN_CAP) { atomicAdd(&bar[XB_TMO], 1u); break; } }
    }
    nloc = mine > 0u ? mine : 1u; nx = cnt > 0u ? cnt : 1u;
}
__device__ __forceinline__ void xcd_barrier(const XcdBarrier& b, const unsigned tidx) {
    asm volatile("s_waitcnt vmcnt(0)" ::: "memory");
    __syncthreads();
    if (tidx == 0) {
        unsigned* bar = b.bar;
        __builtin_amdgcn_s_waitcnt(0);
        unsigned nloc = b.st[0], nx = b.st[1];
        if (nloc == 0u) { xcd_barrier_complete(bar, b.x, nloc, nx); b.st[0] = nloc; b.st[1] = nx; }
        const unsigned old = xb_add(&bar[XB_XSUB(b.x)], 1u);
        const unsigned gen = old / nloc;
        if (old + 1u == (gen + 1u) * nloc) {
            __builtin_amdgcn_fence(__ATOMIC_RELEASE, "agent");
            asm volatile("s_waitcnt vmcnt(0)" ::: "memory");
            const unsigned og = xb_add(&bar[XB_TOP], 1u);
            const unsigned tg = og / nx;
            if (og + 1u == (tg + 1u) * nx) xb_add(&bar[XB_TOPGEN], 1u);
            else XB_SPIN(xb_ld(&bar[XB_TOPGEN]) == tg, bar);
            __builtin_amdgcn_fence(__ATOMIC_ACQUIRE, "agent");
            xb_add(&bar[XB_XGEN(b.x)], 1u);
            asm volatile("s_waitcnt vmcnt(0)" ::: "memory");
        } else {
            XB_SPIN(xb_ld(&bar[XB_XGEN(b.x)]) == gen, bar);
            __builtin_amdgcn_fence(__ATOMIC_ACQUIRE, "agent");
            asm volatile("s_waitcnt vmcnt(0)" ::: "memory");
        }
    }
    __syncthreads();
}

__device__ __forceinline__ float bf2f(bf16_t b) { return __uint_as_float(((unsigned)b) << 16); }
__device__ __forceinline__ float bflo(unsigned u) { return __uint_as_float(u << 16); }
__device__ __forceinline__ float bfhi(unsigned u) { return __uint_as_float(u & 0xffff0000u); }
typedef float f32x2c __attribute__((ext_vector_type(2)));
typedef __bf16 bf16x2c __attribute__((ext_vector_type(2)));
__device__ __forceinline__ unsigned pk2(float lo, float hi) { const f32x2c v = {lo, hi}; const bf16x2c b = __builtin_convertvector(v, bf16x2c); return __builtin_bit_cast(unsigned, b); }
__device__ __forceinline__ unsigned pk2m(float lo, float hi) { return pk2(lo, hi); }
__device__ __forceinline__ bf16_t f2bf(float f) { return (bf16_t)pk2(f, f); }
__device__ __forceinline__ float sigm(float x) { return 1.f / (1.f + __expf(-x)); }
template <int CTRL> __device__ __forceinline__ float dppf(float x) { return __int_as_float(__builtin_amdgcn_update_dpp(0, __float_as_int(x), CTRL, 0xF, 0xF, true)); }
__device__ __forceinline__ float red4(float x) { x += dppf<0xB1>(x); x += dppf<0x4E>(x); return x; }
__device__ __forceinline__ float red8(float x) { x = red4(x); x += dppf<0x141>(x); return x; }
__device__ __forceinline__ float red16(float x) { x = red8(x); x += dppf<0x140>(x); return x; }
__device__ __forceinline__ int lane_now() { int t; asm volatile("v_mbcnt_lo_u32_b32 %0, -1, 0\n\tv_mbcnt_hi_u32_b32 %0, -1, %0" : "=v"(t)); return t; }
__device__ __forceinline__ float shx(float x, int m) { return __int_as_float(__builtin_amdgcn_ds_bpermute((lane_now() ^ m) << 2, __float_as_int(x))); }
__device__ __forceinline__ float shidx(float x, int idx) { return __int_as_float(__builtin_amdgcn_ds_bpermute(idx << 2, __float_as_int(x))); }
__device__ __forceinline__ float red64(float x) { x = red16(x); x += shx(x, 16); x += shx(x, 32); return x; }

#if defined(__HIP_DEVICE_COMPILE__)
#define GAS __attribute__((address_space(1)))
#else
#define GAS
#endif
struct InPtrs { const GAS float* p[33]; };
struct Args { InPtrs in; GAS float* out; GAS unsigned char* ws; int lo, hi; };
struct InView {
    const __attribute__((address_space(4))) Args* a;
    __device__ __forceinline__ const float* operator[](int i) const { return (const float*)a->in.p[i]; }
};
struct ArgView { InView in; __device__ __forceinline__ const ArgView* operator->() const { return this; } };
#define MEMBAR() asm volatile("" ::: "memory")
struct Ctx {
    ArgView a; float* out; GAS unsigned char* ws; LAS unsigned char* lds;
    int tid, lane, wave, bid, G;
    template <class T> __device__ __forceinline__ T* w(size_t off) const { return (T*)(ws + off); }
};

namespace pg8 {
constexpr int MISC_OFF = 131072; constexpr int BM = 256, BK = 64, HALF = 128, HTB = HALF * BK * 2, STAGE_BYTES = 8 * HTB, NXCD = 8, WGM = 8;
__device__ __forceinline__ int lds_byte(int r, int c) { const int st = (r >> 4) * 2 + (c >> 5), rr = r & 15, cc = c & 31, ob = rr * 64 + cc * 2; return st * 1024 + (ob ^ (((ob >> 9) & 1) << 5)); }
__device__ __forceinline__ void stage_rc(int b, int& R, int& C) { const int st = b / 1024, sb = b % 1024, swz = sb ^ (((sb >> 9) & 1) << 5); R = (st >> 1) * 16 + swz / 64; C = (st & 1) * 32 + (swz % 64) / 2; }
__device__ __forceinline__ int perm32(int rho) { const int n = rho >> 4, i = rho & 15; return 8 * (i >> 2) + 4 * n + (i & 3); }
struct Unit { int pm, pn, e, mt, cnt; };

struct StaticOrder {
    static constexpr bool GATHER_A = false;
    const char* A; const char* Bt; int K; int nM, nN, nwg, G, c; bool skip_ctx;
    __device__ __forceinline__ void init(const void* A_, const void* Bt_, int M, int N, int K_, int G_, int c_, bool skip_ctx_ = false) { A = (const char*)A_; Bt = (const char*)Bt_; K = K_; skip_ctx = skip_ctx_; nM = skip_ctx_ ? 64 : M / BM; nN = N / BM; nwg = nM * nN; G = G_; c = c_; }
    __device__ __forceinline__ bool next(int i, Unit& u) const {
        const long L = (long)i * G + c; if (L >= nwg) return false;
        int wgid = (int)L; { const int q = nwg / NXCD, r = nwg % NXCD, xcd = wgid % NXCD, off = wgid / NXCD; wgid = (xcd < r ? xcd * (q + 1) : r * (q + 1) + (xcd - r) * q) + off; }
        const int nig = WGM * nN, gid = wgid / nig, fm = gid * WGM, gsz = (nM - fm) < WGM ? (nM - fm) : WGM;
        u.pm = fm + ((wgid % nig) % gsz); u.pn = (wgid % nig) / gsz; u.e = 0; u.mt = 0; u.cnt = 0;
        if (skip_ctx) u.pm = u.pm + (u.pm >> 3) + 1;
        return true;
    }
    __device__ __forceinline__ const char* a_base(const Unit& u) const { return A + (size_t)u.pm * BM * K * 2; }
    __device__ __forceinline__ const char* b_base(const Unit& u) const { return Bt + (size_t)u.pn * BM * K * 2; }
    __device__ __forceinline__ void a_offs(const Unit&, int tid, unsigned (&vo)[2][2]) const {
#pragma unroll
        for (int i = 0; i < 2; ++i) { int R, C; stage_rc(tid * 16 + i * 8192, R, C);
#pragma unroll
            for (int h = 0; h < 2; ++h) vo[h][i] = (unsigned)((h * HALF + R) * K + C) * 2u; }
    }
};
template <bool GATHER> struct MoeOrder {
    static constexpr bool GATHER_A = GATHER;
    const char* A; const char* Bt; int K; const int* list; const LAS int* tp; const LAS int* cn; int G, c;
    __device__ __forceinline__ bool next(int i, Unit& u) const {
        if ((G & 7) == 0) {
            const int xcd = c & 7; int j = i * (G >> 3) + (c >> 3);
#pragma unroll 1
            for (int q = 0; q < 4; ++q) { const int e = xcd + 8 * q; const int t0 = __builtin_amdgcn_readfirstlane(tp[e]), t1 = __builtin_amdgcn_readfirstlane(tp[e + 1]); const int nu = 4 * (t1 - t0);
                if (j < nu) { u.e = e; u.mt = j >> 2; u.pn = j & 3; u.pm = t0 + u.mt; u.cnt = __builtin_amdgcn_readfirstlane(cn[e]); return true; }
                j -= nu; }
            return false;
        }
        const int L = i * G + c; if (L >= 4 * __builtin_amdgcn_readfirstlane(tp[32])) return false;
        const int tile = L >> 2; u.pn = L & 3; u.pm = tile;
        int e = 0;
#pragma unroll 1
        for (; e < 31; ++e) if (tile < __builtin_amdgcn_readfirstlane(tp[e + 1])) break;
        u.e = e; u.mt = tile - __builtin_amdgcn_readfirstlane(tp[e]); u.cnt = __builtin_amdgcn_readfirstlane(cn[e]); return true;
    }
    __device__ __forceinline__ const char* a_base(const Unit& u) const { return GATHER ? A : A + (size_t)u.pm * BM * K * 2; }
    __device__ __forceinline__ const char* b_base(const Unit& u) const { return Bt + ((size_t)u.e * 1024 + (size_t)u.pn * BM) * K * 2; }
    __device__ __forceinline__ void a_offs(const Unit& u, int tid, unsigned (&vo)[2][2]) const {
#pragma unroll
        for (int i = 0; i < 2; ++i) { int R, C; stage_rc(tid * 16 + i * 8192, R, C);
#pragma unroll
            for (int h = 0; h < 2; ++h) {
                int row = h * HALF + R;
                if (GATHER) { const int idx = u.mt * BM + row; row = idx < u.cnt ? list[(size_t)u.e * MTOK + idx] : 0; }
                vo[h][i] = (unsigned)(row * K + C) * 2u;
            } }
    }
};

struct EpiBf16Rows {
    static constexpr bool PERM = true;
    bf16_t* O; int ldc; int ncols;
    __device__ __forceinline__ void operator()(const f32x4 (&acc)[2][2][4][2], const Unit& u, int wr, int wc, int fr, int fq) const {
        const int row0 = u.pm * BM + wr * 64 + fr, col0 = u.pn * BM + wc * 32 + 8 * fq;
#pragma unroll
        for (int ai = 0; ai < 2; ++ai)
#pragma unroll
            for (int m = 0; m < 4; ++m) { bf16_t* rowp = O + (size_t)(row0 + ai * HALF + m * 16) * ldc + col0;
#pragma unroll
                for (int bj = 0; bj < 2; ++bj) { if (u.pn * BM + bj * HALF >= ncols) continue;
                    const f32x4 v0 = acc[ai][bj][m][0], v1 = acc[ai][bj][m][1];
                    u32x4 w; w.x = pk2(v0[0], v0[1]); w.y = pk2(v0[2], v0[3]); w.z = pk2(v1[0], v1[1]); w.w = pk2(v1[2], v1[3]);
                    *(u32x4*)(rowp + bj * HALF) = w; } }
    }
};
struct EpiX {
    static constexpr bool PERM = false;
    float* X; const float* gate;
    __device__ __forceinline__ void operator()(const f32x4 (&acc)[2][2][4][2], const Unit& u, int wr, int wc, int fr, int fq) const {
        const int row0 = u.pm * BM + wr * 64 + fr, col0 = u.pn * BM + wc * 32 + 4 * fq;
        const int bb = u.pm / 9, mrow = (u.pm - bb * 9 == 0) ? 8 : bb;
        const float* g = gate + (size_t)mrow * 6144 + col0;
        f32x4 gv[2][2];
#pragma unroll
        for (int bj = 0; bj < 2; ++bj)
#pragma unroll
            for (int n = 0; n < 2; ++n) gv[bj][n] = *(const f32x4*)(g + bj * HALF + n * 16);
#pragma unroll
        for (int ai = 0; ai < 2; ++ai)
#pragma unroll
            for (int m = 0; m < 4; ++m) { float* rowp = X + (size_t)(row0 + ai * HALF + m * 16) * D + col0;
#pragma unroll
                for (int bj = 0; bj < 2; ++bj)
#pragma unroll
                    for (int n = 0; n < 2; ++n) { f32x4* p = (f32x4*)(rowp + bj * HALF + n * 16); *p = *p + gv[bj][n] * acc[ai][bj][m][n]; } }
    }
};
struct EpiHid {
    static constexpr bool PERM = true;
    bf16_t* O; const float* listw;
    __device__ __forceinline__ void operator()(const f32x4 (&acc)[2][2][4][2], const Unit& u, int wr, int wc, int fr, int fq) const {
        const int col0 = u.pn * HALF + wc * 32 + 8 * fq;
#pragma unroll
        for (int ai = 0; ai < 2; ++ai)
#pragma unroll
            for (int m = 0; m < 4; ++m) {
                const int r = ai * HALF + wr * 64 + m * 16 + fr, idx = u.mt * BM + r;
                const float w = idx < u.cnt ? listw[(size_t)u.e * MTOK + idx] : 0.f;
                const f32x4 g0 = acc[ai][0][m][0], g1 = acc[ai][0][m][1], u0 = acc[ai][1][m][0], u1 = acc[ai][1][m][1];
                float h[8];
#pragma unroll
                for (int j = 0; j < 4; ++j) { h[j] = g0[j] * sigm(g0[j]) * u0[j] * w; h[4 + j] = g1[j] * sigm(g1[j]) * u1[j] * w; }
                u32x4 o; o.x = pk2(h[0], h[1]); o.y = pk2(h[2], h[3]); o.z = pk2(h[4], h[5]); o.w = pk2(h[6], h[7]);
                *(u32x4*)(O + (size_t)(u.pm * BM + r) * DF + col0) = o;
                asm volatile("" ::: "memory"); }
    }
};

template <class Epi, class Sched>
__device__ __forceinline__ void gemm_phase(LAS unsigned char* lds, const int tid, const Sched& S, const Epi& E) {
    const int wid = __builtin_amdgcn_readfirstlane(tid >> 6), lane = tid & 63, wr = wid >> 2, wc = wid & 3, fr = lane & 15, fq = lane >> 4;
    const int K = S.K, nt = K / BK;
    unsigned voffB[2];
#pragma unroll
    for (int i = 0; i < 2; ++i) { int Rr, Cc; stage_rc(tid * 16 + i * 8192, Rr, Cc); const int Rb = Epi::PERM ? ((Rr & ~31) + perm32(Rr & 31)) : Rr; voffB[i] = (unsigned)(Rb * K + Cc) * 2u; }
    const size_t kstep = (size_t)(BK * 2);
    const size_t hstep = (size_t)HALF * K * 2;
    const unsigned ldsw = (unsigned)wid * 1024u;
    const int aoff = lds_byte(wr * 64 + fr, fq * 8), boff = lds_byte(wc * 32 + fr, fq * 8);
#define PG8_SA(b, h) (((b) * 2 + (h)) * HTB)
#define PG8_SB(b, h) ((4 + (b) * 2 + (h)) * HTB)
#define PG8_STAGE2(bufoff, gbase, o0, o1) do { \
        __builtin_amdgcn_global_load_lds((const unsigned*)((const char*)(gbase) + (o0)), (LAS unsigned*)(lds + (bufoff) + ldsw), 16, 0, 0); \
        __builtin_amdgcn_global_load_lds((const unsigned*)((const char*)(gbase) + (o1)), (LAS unsigned*)(lds + (bufoff) + ldsw + 8192), 16, 0, 0); } while (0)
#define PG8_STAGEB(bufoff, gbase) PG8_STAGE2(bufoff, gbase, voffB[0], voffB[1])
#define PG8_LDA(dst, b, h) do { _Pragma("unroll") for (int m = 0; m < 4; ++m) _Pragma("unroll") for (int k = 0; k < 2; ++k) dst[m][k] = *(const LAS bf16x8*)(lds + PG8_SA(b, h) + aoff + m * 2048 + k * 1024); } while (0)
#define PG8_LDB(dst, b, h) do { _Pragma("unroll") for (int n = 0; n < 2; ++n) _Pragma("unroll") for (int k = 0; k < 2; ++k) dst[n][k] = *(const LAS bf16x8*)(lds + PG8_SB(b, h) + boff + n * 2048 + k * 1024); } while (0)
#define PG8_MMA(ai, bj, At, Bt) do { __builtin_amdgcn_s_setprio(1); _Pragma("unroll") for (int m = 0; m < 4; ++m) _Pragma("unroll") for (int n = 0; n < 2; ++n) _Pragma("unroll") for (int k = 0; k < 2; ++k) \
        acc[ai][bj][m][n] = __builtin_amdgcn_mfma_f32_16x16x32_bf16(Bt[n][k], At[m][k], acc[ai][bj][m][n], 0, 0, 0); __builtin_amdgcn_s_setprio(0); } while (0)
#define PG8_WAIT_V(n) asm volatile("s_waitcnt vmcnt(" #n ")" ::: "memory")
#define PG8_WAIT_L(n) asm volatile("s_waitcnt lgkmcnt(" #n ")" ::: "memory")
#define PG8_BAR __builtin_amdgcn_s_barrier()
#define PG8_SCHED __builtin_amdgcn_sched_barrier(0)
    Unit cur, nxt; int ui = 0;
    if (!S.next(0, cur)) return;
    f32x4 acc[2][2][4][2];
#pragma unroll
    for (int a = 0; a < 2; ++a)
#pragma unroll
        for (int b = 0; b < 2; ++b)
#pragma unroll
            for (int m = 0; m < 4; ++m)
#pragma unroll
                for (int n = 0; n < 2; ++n) acc[a][b][m][n] = (f32x4){0.f, 0.f, 0.f, 0.f};
    bf16x8 At[4][2], B0[2][2], B1[2][2];
    unsigned vo[2][2];
    LAS u32x4* stash = (LAS u32x4*)(lds + MISC_OFF + 1024) + tid;
    S.a_offs(cur, tid, vo);
    const char* cA = S.a_base(cur); const char* cB = S.b_base(cur);
    PG8_STAGEB(PG8_SB(0, 0), cB); PG8_STAGE2(PG8_SA(0, 0), cA, vo[0][0], vo[0][1]); PG8_STAGEB(PG8_SB(0, 1), cB + hstep); PG8_STAGE2(PG8_SA(0, 1), cA, vo[1][0], vo[1][1]);
    if (wr == 1) PG8_BAR;
    PG8_WAIT_V(4); PG8_BAR;
    PG8_STAGEB(PG8_SB(1, 0), cB + kstep); PG8_STAGE2(PG8_SA(1, 0), cA + kstep, vo[0][0], vo[0][1]); PG8_STAGEB(PG8_SB(1, 1), cB + hstep + kstep);
    PG8_WAIT_V(6); PG8_BAR;
    for (;;) {
        const bool has_next = S.next(ui + 1, nxt);
        const char* nA = cA; const char* nB = cB;
        if (has_next) { nA = S.a_base(nxt); nB = S.b_base(nxt); }
        if constexpr (Sched::GATHER_A) { unsigned nvo[2][2];
            if (has_next) S.a_offs(nxt, tid, nvo); else { nvo[0][0] = vo[0][0]; nvo[0][1] = vo[0][1]; nvo[1][0] = vo[1][0]; nvo[1][1] = vo[1][1]; }
            *stash = (u32x4){nvo[0][0], nvo[0][1], nvo[1][0], nvo[1][1]}; }
        for (int t = 0; t < nt; t += 2) {
            const bool last = (t == nt - 2);
            const char* a1 = cA + (size_t)(t + 1) * kstep;
            const char* a2 = last ? nA : cA + (size_t)(t + 2) * kstep; const char* b2 = last ? nB : cB + (size_t)(t + 2) * kstep;
            const char* a3 = a2 + kstep; const char* b3 = b2 + kstep;
            unsigned s00 = vo[0][0], s01 = vo[0][1], s10 = vo[1][0], s11 = vo[1][1];
            if constexpr (Sched::GATHER_A) { if (last) { const u32x4 nv = *stash; s00 = nv.x; s01 = nv.y; s10 = nv.z; s11 = nv.w; } }
            PG8_LDB(B0, 0, 0); PG8_SCHED; PG8_LDA(At, 0, 0); PG8_STAGE2(PG8_SA(1, 1), a1, vo[1][0], vo[1][1]);
            PG8_WAIT_L(8); PG8_BAR; PG8_WAIT_L(0); PG8_MMA(0, 0, At, B0); PG8_BAR; PG8_SCHED;
            PG8_LDB(B1, 0, 1); PG8_STAGEB(PG8_SB(0, 0), b2);
            PG8_BAR; PG8_WAIT_L(0); PG8_MMA(0, 1, At, B1); PG8_BAR;
            PG8_LDA(At, 0, 1); PG8_STAGE2(PG8_SA(0, 0), a2, s00, s01);
            PG8_BAR; PG8_WAIT_L(0); PG8_MMA(1, 0, At, B0); PG8_BAR; PG8_SCHED;
            PG8_STAGEB(PG8_SB(0, 1), b2 + hstep);
            PG8_WAIT_V(6); PG8_BAR; PG8_MMA(1, 1, At, B1); PG8_BAR;
            PG8_LDB(B0, 1, 0); PG8_SCHED; PG8_LDA(At, 1, 0); PG8_STAGE2(PG8_SA(0, 1), a2, s10, s11);
            PG8_WAIT_L(8); PG8_BAR; PG8_WAIT_L(0); PG8_MMA(0, 0, At, B0); PG8_BAR; PG8_SCHED;
            PG8_LDB(B1, 1, 1); PG8_STAGEB(PG8_SB(1, 0), b3);
            PG8_BAR; PG8_WAIT_L(0); PG8_MMA(0, 1, At, B1); PG8_BAR;
            PG8_LDA(At, 1, 1); PG8_STAGE2(PG8_SA(1, 0), a3, s00, s01);
            PG8_BAR; PG8_WAIT_L(0); PG8_MMA(1, 0, At, B0); PG8_BAR; PG8_SCHED;
            PG8_STAGEB(PG8_SB(1, 1), b3 + hstep);
            PG8_WAIT_V(6); PG8_BAR; PG8_MMA(1, 1, At, B1); PG8_BAR;
        }
        E(acc, cur, wr, wc, fr, fq);
        if (!has_next) break;
#pragma unroll
        for (int a = 0; a < 2; ++a)
#pragma unroll
            for (int b = 0; b < 2; ++b)
#pragma unroll
                for (int m = 0; m < 4; ++m)
#pragma unroll
                    for (int n = 0; n < 2; ++n) acc[a][b][m][n] = (f32x4){0.f, 0.f, 0.f, 0.f};
        cur = nxt; cA = nA; cB = nB; ++ui;
        if constexpr (Sched::GATHER_A) { const u32x4 nv = *stash; vo[0][0] = nv.x; vo[0][1] = nv.y; vo[1][0] = nv.z; vo[1][1] = nv.w; }
    }
    PG8_WAIT_V(0);
    if (wr == 0) PG8_BAR;
    PG8_BAR;
#undef PG8_SA
#undef PG8_SB
#undef PG8_STAGE2
#undef PG8_STAGEB
#undef PG8_LDA
#undef PG8_LDB
#undef PG8_MMA
#undef PG8_WAIT_V
#undef PG8_WAIT_L
#undef PG8_BAR
#undef PG8_SCHED
}
}

__device__ __forceinline__ void cvt_tile(const Ctx& c, LAS float* T, const float* src, int src_ld, bf16_t* dst, int dst_ld) {
    const int ty = c.tid >> 4, tx = c.tid & 15;
#pragma unroll
    for (int i = 0; i < 2; ++i) { const int k = ty + 32 * i; const float4 v = *(const float4*)(src + (size_t)k * src_ld + tx * 4);
        T[k * 65 + tx * 4 + 0] = v.x; T[k * 65 + tx * 4 + 1] = v.y; T[k * 65 + tx * 4 + 2] = v.z; T[k * 65 + tx * 4 + 3] = v.w; }
    __syncthreads();
    const int tn = c.tid >> 3, tk = c.tid & 7;
    float v[8];
#pragma unroll
    for (int j = 0; j < 8; ++j) v[j] = T[(tk * 8 + j) * 65 + tn];
    u32x4 o; o.x = pk2(v[0], v[1]); o.y = pk2(v[2], v[3]); o.z = pk2(v[4], v[5]); o.w = pk2(v[6], v[7]);
    *(u32x4*)(dst + (size_t)tn * dst_ld + tk * 8) = o;
    __syncthreads();
}

struct CvtJob { const float* src; bf16_t* dst; int src_ld, dst_ld; };
__device__ __forceinline__ void cvt_tile4(const Ctx& c, LAS float* T, const CvtJob (&jb)[4]) {
    const int ty = c.tid >> 4, tx = c.tid & 15;
    float4 v[4][2];
#pragma unroll
    for (int q = 0; q < 4; ++q)
#pragma unroll
        for (int i = 0; i < 2; ++i) v[q][i] = *(const float4*)(jb[q].src + (size_t)(ty + 32 * i) * jb[q].src_ld + tx * 4);
#pragma unroll
    for (int q = 0; q < 4; ++q)
#pragma unroll
        for (int i = 0; i < 2; ++i) { LAS float* t = T + q * 4160 + (ty + 32 * i) * 65 + tx * 4; t[0] = v[q][i].x; t[1] = v[q][i].y; t[2] = v[q][i].z; t[3] = v[q][i].w; }
    __syncthreads();
    const int tn = c.tid >> 3, tk = c.tid & 7;
#pragma unroll
    for (int q = 0; q < 4; ++q) {
        float w[8];
#pragma unroll
        for (int j = 0; j < 8; ++j) w[j] = T[q * 4160 + (tk * 8 + j) * 65 + tn];
        u32x4 o; o.x = pk2(w[0], w[1]); o.y = pk2(w[2], w[3]); o.z = pk2(w[4], w[5]); o.w = pk2(w[6], w[7]);
        *(u32x4*)(jb[q].dst + (size_t)tn * jb[q].dst_ld + tk * 8) = o;
    }
    __syncthreads();
}

__device__ __forceinline__ void phase_prologue(const Ctx& c) {
    {
        LAS float* Ssm = (LAS float*)c.lds; LAS float* red = Ssm + 9 * 1024;
        for (int i = c.tid; i < 9 * 1024; i += 512) { const int r = i >> 10, k = i & 1023; const float v = r < 8 ? c.a->in[1][r * 1024 + k] : c.a->in[3][k]; Ssm[i] = v * sigm(v); }
        __syncthreads();
        float* MOD = c.w<float>(WS_MOD);
        for (int task = c.bid; task < 384; task += c.G) {
            const int l = task / 96, c0 = (task % 96) * 64, kg = c.tid >> 6, col = c.tid & 63;
            const float* wp = c.a->in[6] + ((size_t)l * 1024 + kg * 128) * 6144 + c0 + col;
            float acc[9];
#pragma unroll
            for (int r = 0; r < 9; ++r) acc[r] = 0.f;
#pragma unroll 4
            for (int k = 0; k < 128; ++k) { const float wv = wp[(size_t)k * 6144];
#pragma unroll
                for (int r = 0; r < 9; ++r) acc[r] += Ssm[r * 1024 + kg * 128 + k] * wv; }
#pragma unroll
            for (int r = 0; r < 9; ++r) red[(kg * 9 + r) * 64 + col] = acc[r];
            __syncthreads();
            for (int i = c.tid; i < 576; i += 512) { const int r = i >> 6, cc = i & 63; float s = 0.f;
#pragma unroll
                for (int k2 = 0; k2 < 8; ++k2) s += red[(k2 * 9 + r) * 64 + cc];
                MOD[((size_t)l * 9 + r) * 6144 + c0 + cc] = s + c.a->in[7][l * 6144 + c0 + cc]; }
            __syncthreads();
        }
    }
    if (c.bid == 0) {
        const int d = c.tid >> 8, ch = c.tid & 255; const float* lg = c.a->in[10] + (size_t)d * 4 * 256 + ch;
        const float a0 = lg[0], a1 = lg[256], a2 = lg[512], a3 = lg[768]; const float mx = fmaxf(fmaxf(a0, a1), fmaxf(a2, a3));
        const float e0 = expf(a0 - mx), e1 = expf(a1 - mx), e2 = expf(a2 - mx), e3 = expf(a3 - mx), inv = 1.f / (e0 + e1 + e2 + e3);
        float* LB = c.w<float>(WS_LB) + (size_t)d * 4 * 256 + ch;
        LB[0] = 0.f; LB[256] = e1 * inv; LB[512] = (e1 + e2) * inv; LB[768] = (e1 + e2 + e3) * inv;
    }
    if (c.bid == 1 % c.G) {
        float* RT = c.w<float>(WS_ROPE);
        for (int i = c.tid; i < 64 * 16; i += 512) { const int pos = i >> 4, j = i & 15; const float inv = exp2f(-(float)j * (13.287712379549449f / 16.f)); const float ang = (float)pos * inv;
            RT[i * 2] = __cosf(ang); RT[i * 2 + 1] = __sinf(ang); }
    }
    {
        __syncthreads();
        LAS float* T = (LAS float*)c.lds;
        constexpr int PER_L = 992 + 256 + 24;
        for (int task4 = c.bid; task4 < PER_L; task4 += c.G) {
            CvtJob jb[4];
#pragma unroll
            for (int q = 0; q < 4; ++q) {
                const int task = task4 * 4 + q; const int l = task / PER_L; int t = task - l * PER_L;
                if (t < 992) { const int kt = t / 62, nt = t % 62;
                    jb[q].src = c.a->in[8] + ((size_t)l * 1024 + kt * 64) * PT + nt * 64; jb[q].src_ld = PT; jb[q].dst = c.w<bf16_t>(WS_WIN) + ((size_t)l * 4096 + nt * 64) * 1024 + kt * 64; jb[q].dst_ld = 1024;
                } else if (t < 992 + 256) { t -= 992; const int kt = t >> 4, nt = t & 15;
                    jb[q].src = c.a->in[9] + ((size_t)l * 1024 + kt * 64) * 1024 + nt * 64; jb[q].src_ld = 1024; jb[q].dst = c.w<bf16_t>(WS_WOUT) + ((size_t)l * 1024 + nt * 64) * 1024 + kt * 64; jb[q].dst_ld = 1024;
                } else { t -= 992 + 256; bf16_t* lo = c.w<bf16_t>(WS_LORA + (size_t)l * LORA_L);
                    if (t < 8) { const int d = t >> 2, nt = t & 3;
                        jb[q].src = c.a->in[14] + ((size_t)(l * 2 + d) * 64) * 256 + nt * 64; jb[q].src_ld = 256; jb[q].dst = lo + (size_t)d * 16384 + (size_t)nt * 64 * 64; jb[q].dst_ld = 64;
                    } else if (t < 16) { t -= 8; const int d = t >> 2, nt = t & 3;
                        jb[q].src = c.a->in[16] + ((size_t)(l * 2 + d) * 64) * 256 + nt * 64; jb[q].src_ld = 256; jb[q].dst = lo + 32768 + (size_t)d * 16384 + (size_t)nt * 64 * 64; jb[q].dst_ld = 64;
                    } else { t -= 16; const int kt = t >> 2, nt = t & 3;
                        jb[q].src = c.a->in[17] + ((size_t)l * 128 + kt * 64) * 256 + nt * 64; jb[q].src_ld = 256; jb[q].dst = lo + 65536 + (size_t)nt * 64 * 128 + kt * 64; jb[q].dst_ld = 128;
                    }
                }
            }
            cvt_tile4(c, T, jb);
        }
        u32x4* z = c.w<u32x4>(WS_WIN);
        for (int i = c.bid * 512 + c.tid; i < 4 * 16384; i += c.G * 512) { const int l = i >> 14, o = i & 16383; z[((size_t)l * 4096 + 3968) * 128 + o] = (u32x4){0u, 0u, 0u, 0u}; }
    }
}

__device__ __forceinline__ void build_tpre(const Ctx& c, int l) {
    LAS int* tp = (LAS int*)(c.lds + MISC_OFF + 64); LAS int* cn = (LAS int*)(c.lds + MISC_OFF + 256);
    __syncthreads();
    if (c.tid < 32) cn[c.tid] = (int)__hip_atomic_load(c.w<unsigned>(WS_CTL) + CW_CNT + l * 64 + c.tid, __ATOMIC_RELAXED, __HIP_MEMORY_SCOPE_AGENT);
    __syncthreads();
    if (c.tid == 0) { int s = 0; for (int e = 0; e < 32; ++e) { tp[e] = s; s += (cn[e] + 255) >> 8; } tp[32] = s; }
    __syncthreads();
}

__device__ __forceinline__ void phase_norm1(const Ctx& c, int l) {
    LAS int* tp = (LAS int*)(c.lds + MISC_OFF + 64);
    if (l > 0) build_tpre(c, l - 1);
    const float* MOD = c.w<float>(WS_MOD); float* X = c.w<float>(WS_X); const bf16_t* Y = c.w<bf16_t>(WS_Y); bf16_t* H = c.w<bf16_t>(WS_H);
    const int4* ROUTE = c.w<int4>(WS_ROUTE);
    const int stride = c.G * 8, lane = c.lane;
    constexpr int NR = 3;
    for (int rowb = c.bid * 8 + c.wave; rowb < MTOK; rowb += NR * stride) {
        f32x4 x[NR][4]; int4 rt[NR]; bool act[NR]; int mrow[NR];
#pragma unroll
        for (int u = 0; u < NR; ++u) { const int row = rowb + u * stride; const int rr = row < MTOK ? row : rowb; const int b = rr / TPB, s = rr - b * TPB;
            act[u] = row < MTOK && !(l == DEPTH && s < CTX); mrow[u] = s < CTX ? 8 : b;
            const float* xs = l > 0 ? X + (size_t)rr * D : (s < CTX ? c.a->in[2] + ((size_t)b * CTX + s) * D : c.a->in[0] + ((size_t)b * SEQ + (s - CTX)) * D);
#pragma unroll
            for (int j = 0; j < 4; ++j) x[u][j] = *(const f32x4*)(xs + lane * 4 + 256 * j);
            rt[u] = l > 0 ? ROUTE[rr] : make_int4(0, 0, 0, 0); }
        if (l > 0) {
            u32x2 y0[NR][4], y1[NR][4];
#pragma unroll
            for (int u = 0; u < NR; ++u) { const int e0 = act[u] ? rt[u].x : 0, e1 = act[u] ? rt[u].z : 0, p0 = act[u] ? rt[u].y : 0, p1 = act[u] ? rt[u].w : 0;
                const size_t r0 = (size_t)tp[e0] * 256 + p0, r1 = (size_t)tp[e1] * 256 + p1;
#pragma unroll
                for (int j = 0; j < 4; ++j) { y0[u][j] = *(const u32x2*)(Y + r0 * D + lane * 4 + 256 * j); y1[u][j] = *(const u32x2*)(Y + r1 * D + lane * 4 + 256 * j); } }
#pragma unroll
            for (int u = 0; u < NR; ++u) { const float* g2 = MOD + ((size_t)(l - 1) * 9 + mrow[u]) * 6144 + 5120;
#pragma unroll
                for (int j = 0; j < 4; ++j) { const f32x4 g = *(const f32x4*)(g2 + lane * 4 + 256 * j);
                    x[u][j][0] += g[0] * (bflo(y0[u][j].x) + bflo(y1[u][j].x)); x[u][j][1] += g[1] * (bfhi(y0[u][j].x) + bfhi(y1[u][j].x));
                    x[u][j][2] += g[2] * (bflo(y0[u][j].y) + bflo(y1[u][j].y)); x[u][j][3] += g[3] * (bfhi(y0[u][j].y) + bfhi(y1[u][j].y)); } }
        }
#pragma unroll
        for (int u = 0; u < NR; ++u) {
            if (!act[u]) continue;
            const int row = rowb + u * stride; const int b = row / TPB, s = row - b * TPB;
            if (l == DEPTH) {
                float* o = c.out + ((size_t)b * SEQ + (s - CTX)) * D;
#pragma unroll
                for (int j = 0; j < 4; ++j) *(f32x4*)(o + lane * 4 + 256 * j) = x[u][j];
                continue;
            }
#pragma unroll
            for (int j = 0; j < 4; ++j) *(f32x4*)(X + (size_t)row * D + lane * 4 + 256 * j) = x[u][j];
            float ss = 0.f;
#pragma unroll
            for (int j = 0; j < 4; ++j) ss += x[u][j][0] * x[u][j][0] + x[u][j][1] * x[u][j][1] + x[u][j][2] * x[u][j][2] + x[u][j][3] * x[u][j][3];
            ss = red64(ss);
            const float inv = rsqrtf(ss * (1.f / 1024.f) + 1e-6f);
            const float* gain = c.a->in[4] + (size_t)l * D; const float* md = MOD + ((size_t)l * 9 + mrow[u]) * 6144;
#pragma unroll
            for (int j = 0; j < 4; ++j) { const int col = lane * 4 + 256 * j;
                const f32x4 gn = *(const f32x4*)(gain + col), sh = *(const f32x4*)(md + col), sc = *(const f32x4*)(md + 1024 + col);
                const f32x4 h = x[u][j] * inv * gn * (1.f + sc) + sh;
                u32x2 o; o.x = pk2(h[0], h[1]); o.y = pk2(h[2], h[3]); *(u32x2*)(H + (size_t)row * D + col) = o; }
        }
    }
}

__device__ __forceinline__ void phase_prep(const Ctx& c, int l) {
    const bf16_t* P = c.w<bf16_t>(WS_P);
    const int gw = c.bid * 8 + c.wave, nw = c.G * 8, lane = c.lane;
    {
        const float* RT = c.w<float>(WS_ROPE); bf16_t* QN = c.w<bf16_t>(WS_QN); bf16_t* KN = c.w<bf16_t>(WS_KN);
        const int hd = lane >> 3, sub = lane & 7;
        u32x2 nq[2][2];
#define QK_LOAD(r_) do { _Pragma("unroll") for (int w_ = 0; w_ < 2; ++w_) { const bf16_t* pq_ = P + (size_t)(r_) * PT + (w_ ? PC_K : PC_Q) + hd * 64 + sub * 4; \
            nq[w_][0] = *(const u32x2*)pq_; nq[w_][1] = *(const u32x2*)(pq_ + 32); } } while (0)
        QK_LOAD(gw < MTOK ? gw : 0);
        for (int row = gw; row < MTOK; row += nw) {
            const int b = row / TPB, s = row - b * TPB; const bool lat = s >= CTX; const int t = s - CTX, pr = t >> 6, pc = t & 63;
            const int pos = sub < 4 ? pr : pc, jj0 = (sub & 3) * 4;
            u32x2 cq[2][2];
#pragma unroll
            for (int w_ = 0; w_ < 2; ++w_) { cq[w_][0] = nq[w_][0]; cq[w_][1] = nq[w_][1]; }
            QK_LOAD(row + nw < MTOK ? row + nw : row);
#pragma unroll
            for (int which = 0; which < 2; ++which) {
                const u32x2 a = cq[which][0], bq = cq[which][1];
                float x1[4] = {bflo(a.x), bfhi(a.x), bflo(a.y), bfhi(a.y)}, x2[4] = {bflo(bq.x), bfhi(bq.x), bflo(bq.y), bfhi(bq.y)};
                float ss = 0.f;
#pragma unroll
                for (int j = 0; j < 4; ++j) ss += x1[j] * x1[j] + x2[j] * x2[j];
                ss = red8(ss);
                const float inv = rsqrtf(ss * (1.f / 64.f) + 1e-6f);
                const float* gn = c.a->in[which ? 24 : 23] + l * 64 + sub * 4;
                float y1[4], y2[4];
#pragma unroll
                for (int j = 0; j < 4; ++j) { const float u1 = x1[j] * inv * gn[j], u2 = x2[j] * inv * gn[32 + j];
                    if (lat) { const float cs = RT[(pos * 16 + jj0 + j) * 2], sn = RT[(pos * 16 + jj0 + j) * 2 + 1]; y1[j] = u1 * cs - u2 * sn; y2[j] = u2 * cs + u1 * sn; }
                    else { y1[j] = u1; y2[j] = u2; }
                    if (!which) { y1[j] *= 0.125f; y2[j] *= 0.125f; } }
                u32x2 o1, o2; o1.x = pk2(y1[0], y1[1]); o1.y = pk2(y1[2], y1[3]); o2.x = pk2(y2[0], y2[1]); o2.y = pk2(y2[2], y2[3]);
                if (which) {
                    bf16_t* dst = KN + ((size_t)(b * 8 + hd)) * TPB * 64 + (size_t)(s >> 3) * 512 + (s & 7) * 32 + (sub >> 1) * 8 + (sub & 1) * 4;
                    *(u32x2*)dst = o1; *(u32x2*)(dst + 256) = o2;
                } else {
                    bf16_t* dst = QN + (((size_t)(b * 8 + hd)) * TPB + s) * 64 + sub * 4;
                    *(u32x2*)dst = o1; *(u32x2*)(dst + 32) = o2;
                }
            }
        }
    }
    {
        LAS bf16_t* T = (LAS bf16_t*)(c.lds + c.wave * 9216);
        bf16_t* VT = c.w<bf16_t>(WS_VT);
        for (int task = gw; task < NB * 8 * 36; task += nw) {
            const int b = task / 288, h = (task / 36) & 7, tb = task % 36;
#pragma unroll
            for (int i = 0; i < 8; ++i) { const int tok = i * 8 + (lane >> 3), ch = lane & 7;
                const u32x4 v = *(const u32x4*)(P + (size_t)(b * TPB + tb * 64 + tok) * PT + PC_V + h * 64 + ch * 8);
                *(LAS u32x4*)(T + tok * 72 + ch * 8) = v; }
            __builtin_amdgcn_wave_barrier();
            unsigned pk[32];
#pragma unroll
            for (int i = 0; i < 32; ++i) pk[i] = (unsigned)T[(2 * i) * 72 + lane] | ((unsigned)T[(2 * i + 1) * 72 + lane] << 16);
            bf16_t* dst = VT + (size_t)(b * 8 + h) * 64 * TPB + (size_t)(tb * 8) * 512 + (lane >> 4) * 128 + (lane & 15) * 8;
#pragma unroll
            for (int i = 0; i < 8; ++i) *(u32x4*)(dst + i * 512) = (u32x4){pk[4 * i], pk[4 * i + 1], pk[4 * i + 2], pk[4 * i + 3]};
            __builtin_amdgcn_wave_barrier();
        }
    }
}
__device__ __forceinline__ void phase_prep_hgrn(const Ctx& c, int l) {
    const bf16_t* P = c.w<bf16_t>(WS_P);
    const int gw = c.bid * 8 + c.wave, nw = c.G * 8;
    {
        LAS bf16_t* QT = (LAS bf16_t*)(c.lds + (c.wave < 7 ? c.wave * 8192 : 132096)); LAS bf16_t* KTl = QT + 16 * 72; LAS bf16_t* IV = KTl + 16 * 72;
        const float* LB = c.w<float>(WS_LB);
        bf16_t* QIN = c.w<bf16_t>(WS_QIN); bf16_t* KOT = c.w<bf16_t>(WS_KOT); bf16_t* IT = c.w<bf16_t>(WS_IT); float* DEC = c.w<float>(WS_DEC); bf16_t* O1 = c.w<bf16_t>(WS_O1);
        const bool bal = (c.G == 256);
        const int t_lo = bal ? (c.bid < 128 ? c.bid * 12 : 1536 + (c.bid - 128) * 24) + c.wave : gw;
        const int t_hi = bal ? (c.bid < 128 ? c.bid * 12 + 12 : 1536 + (c.bid - 128) * 24 + 24) : NB * 4 * NBLK16;
        const int t_st = bal ? 8 : nw;
        bf16_t nqr[16], nir[16], nfr[16], nbr[16];
#define HG_TLOAD(task_) do { const int tk_ = (task_); const int b_ = tk_ / (4 * NBLK16), h_ = (tk_ / NBLK16) & 3, nb_ = tk_ % NBLK16; \
            const bf16_t* pr_ = P + (size_t)(b_ * TPB + nb_ * 16) * PT + h_ * 64 + c.lane; \
            _Pragma("unroll") for (int t_ = 0; t_ < 16; ++t_) { nqr[t_] = pr_[(size_t)t_ * PT + PA_Q]; nir[t_] = pr_[(size_t)t_ * PT + PA_I]; nfr[t_] = pr_[(size_t)t_ * PT + PA_FF]; nbr[t_] = pr_[(size_t)t_ * PT + PA_FB]; } } while (0)
        if (t_lo < t_hi) HG_TLOAD(t_lo);
        for (int task = t_lo; task < t_hi; task += t_st) {
            int lane = c.lane; asm volatile("" : "+v"(lane));
            const int fr = lane & 15, g = lane >> 4;
            const int b = task / (4 * NBLK16), h = (task / NBLK16) & 3, nb = task % NBLK16; const int row0 = b * TPB + nb * 16;
            float q[16]; bf16_t ffr[16], fbr[16];
            {
                float iv[16];
#pragma unroll
                for (int t = 0; t < 16; ++t) { q[t] = bf2f(nqr[t]); iv[t] = bf2f(nir[t]); ffr[t] = nfr[t]; fbr[t] = nbr[t]; }
                HG_TLOAD(task + t_st < t_hi ? task + t_st : task);
                unsigned pk[8];
#pragma unroll
                for (int i = 0; i < 8; ++i) pk[i] = pk2(iv[2 * i], iv[2 * i + 1]);
                bf16_t* dst = IT + (((size_t)(b * 4 + h) * NBLK16 + nb) * 64 + lane) * 16;
                *(u32x4*)dst = (u32x4){pk[0], pk[1], pk[2], pk[3]}; *(u32x4*)(dst + 8) = (u32x4){pk[4], pk[5], pk[6], pk[7]};
                *(LAS u32x4*)(IV + lane * 24) = (u32x4){pk[0], pk[1], pk[2], pk[3]}; *(LAS u32x4*)(IV + lane * 24 + 8) = (u32x4){pk[4], pk[5], pk[6], pk[7]};
            }
            f32x4 oacc[4];
#pragma unroll
            for (int n = 0; n < 4; ++n) oacc[n] = (f32x4){0.f, 0.f, 0.f, 0.f};
#pragma unroll 1
            for (int dir = 0; dir < 2; ++dir) {
                const float lb = LB[((size_t)dir * 4 + l) * 256 + h * 64 + lane];
                float kf[16], cum[16];
#pragma unroll
                for (int t = 0; t < 16; ++t) { const float fp = bf2f(dir ? fbr[t] : ffr[t]);
                    const float f = lb + (1.f - lb) * sigm(fp); cum[t] = __logf(fmaxf(f, 1e-20f)); kf[t] = (1.f - lb) * sigm(-fp); }
                if (dir == 0) {
#pragma unroll
                    for (int t = 1; t < 16; ++t) cum[t] += cum[t - 1];
                } else {
#pragma unroll
                    for (int t = 14; t >= 0; --t) cum[t] += cum[t + 1];
                }
                const float cend = dir ? cum[0] : cum[15], cmid = dir ? cum[8] : cum[7];
                const size_t blk = ((size_t)(dir * 8 + b) * 4 + h) * NBLK16 + nb;
                DEC[blk * 64 + lane] = __expf(cend);
                unsigned pko[8];
#pragma unroll
                for (int t = 0; t < 16; ++t) {
                    const float qi = q[t] * __expf(cum[t]), ko = kf[t] * __expf(cend - cum[t]);
                    QIN[((size_t)dir * MTOK + row0 + t) * 256 + h * 64 + lane] = f2bf(qi);
                    if (t & 1) pko[t >> 1] |= (unsigned)f2bf(ko) << 16; else pko[t >> 1] = (unsigned)f2bf(ko);
                    QT[t * 72 + lane] = f2bf(q[t] * __expf(fminf(fmaxf(cum[t] - cmid, -80.f), 80.f)));
                    KTl[t * 72 + lane] = f2bf(kf[t] * __expf(fminf(fmaxf(cmid - cum[t], -80.f), 80.f)));
                }
                { bf16_t* dst = KOT + (blk * 64 + lane) * 16;
                  *(u32x4*)dst = (u32x4){pko[0], pko[1], pko[2], pko[3]}; *(u32x4*)(dst + 8) = (u32x4){pko[4], pko[5], pko[6], pko[7]}; }
                MEMBAR();
                __builtin_amdgcn_wave_barrier();
                f32x4 sT = {0.f, 0.f, 0.f, 0.f};
#pragma unroll
                for (int ks = 0; ks < 2; ++ks) {
                    const bf16x8 aK = *(const LAS bf16x8*)(KTl + fr * 72 + ks * 32 + g * 8), bQ = *(const LAS bf16x8*)(QT + fr * 72 + ks * 32 + g * 8);
                    sT = __builtin_amdgcn_mfma_f32_16x16x32_bf16(aK, bQ, sT, 0, 0, 0);
                }
                float sm[4];
#pragma unroll
                for (int j = 0; j < 4; ++j) { const int sI = 4 * g + j; const bool ok = dir ? (sI >= fr) : (sI <= fr); sm[j] = ok ? sT[j] : 0.f; }
                union { u32x2 u; bf16x4 v; } aS; aS.u = (u32x2){pk2m(sm[0], sm[1]), pk2m(sm[2], sm[3])};
#pragma unroll
                for (int n = 0; n < 4; ++n) { const bf16x4 bI = *(const LAS bf16x4*)(IV + (16 * n + fr) * 24 + 4 * g);
                    oacc[n] = __builtin_amdgcn_mfma_f32_16x16x16bf16_1k(aS.v, bI, oacc[n], 0, 0, 0); }
                MEMBAR();
                __builtin_amdgcn_wave_barrier();
            }
#pragma unroll
            for (int n = 0; n < 4; ++n)
#pragma unroll
                for (int j = 0; j < 4; ++j) O1[(size_t)(row0 + 4 * g + j) * 256 + h * 64 + 16 * n + fr] = f2bf(oacc[n][j]);
        }
    }
}
__device__ __forceinline__ void rwkv_chunk_task(const Ctx& c, const int task);
__device__ __forceinline__ int rw_img_off(int hd) { return hd < 4 ? 89344 + hd * 9216 : (hd < 7 ? 131136 + (hd - 4) * 9216 : 49408); }
__device__ __forceinline__ int rw_sm_off(int wv) { return wv < 6 ? wv * 8192 : (wv == 6 ? 76800 : 58624); }
constexpr int SPS = 772;
__device__ __forceinline__ void rwkv_chunk_task(const Ctx& c, const int task);
__device__ __forceinline__ void phase_prep_rwkv(const Ctx& c, int l) {
    const bf16_t* P = c.w<bf16_t>(WS_P);
    const int lane = c.lane;
    {
        LAS float* SP = (LAS float*)c.lds;
        LAS float* SPL = (LAS float*)(c.lds + 49408);
        LAS float* KKI = (LAS float*)(c.lds + 73984);
        LAS float* BONP = KKI + 64;
        LAS float* GCL = (LAS float*)(c.lds + 74752);
        LAS bf16_t* ACT = (LAS bf16_t*)(c.lds + 76800);
        const float* mu = c.a->in[12] + (size_t)l * 1152;
        const float* kks = c.a->in[18] + l * 256; const float* k_a = c.a->in[19] + l * 256; const float* r_k = c.a->in[20] + l * 256;
        const bf16_t* lo = c.w<bf16_t>(WS_LORA + (size_t)l * LORA_L);
        bf16_t* GG = c.w<bf16_t>(WS_G); bf16_t* BON = c.w<bf16_t>(WS_BON); float* GCo = c.w<float>(WS_GC); bf16_t* VT2 = c.w<bf16_t>(WS_VT2);
        const int fr = lane & 15, g = lane >> 4;
        for (int tile = c.bid; tile < MTOK / 16; tile += c.G) {
            const int r0 = tile * 16; const int b = r0 / TPB, s0 = r0 - b * TPB;
#pragma unroll
            for (int it = 0; it < 5; ++it) {
                const int idx = c.tid + it * 512;
                if (idx < 16 * 144) {
                    const int t = idx / 144, ch = (idx - t * 144) * 8; const int s = s0 + t;
                    const bf16_t* pp = P + (size_t)(r0 + t) * PT + PB0 + ch;
                    const u32x4 zero4 = {0u, 0u, 0u, 0u};
                    const u32x4 p4 = *(const u32x4*)pp;
                    const u32x4 m4 = (s != 0 && s != CTX) ? *(const u32x4*)(pp - PT) : zero4;
                    const u32x4 n4 = (s != CTX - 1 && s != TPB - 1) ? *(const u32x4*)(pp + PT) : zero4;
                    const f32x4 mu0 = *(const f32x4*)(mu + ch), mu1 = *(const f32x4*)(mu + ch + 4);
                    f32x4 o0, o1;
#pragma unroll
                    for (int e = 0; e < 4; ++e) {
                        const unsigned pw = p4[e], mw = m4[e], nw = n4[e];
                        const float pl = bflo(pw), ph = bfhi(pw);
                        const float vl = pl + (0.5f * (bflo(mw) + bflo(nw)) - pl) * (e < 2 ? mu0[2 * e] : mu1[2 * e - 4]);
                        const float vh = ph + (0.5f * (bfhi(mw) + bfhi(nw)) - ph) * (e < 2 ? mu0[2 * e + 1] : mu1[2 * e - 3]);
                        if (e < 2) { o0[2 * e] = vl; o0[2 * e + 1] = vh; } else { o1[2 * e - 4] = vl; o1[2 * e - 3] = vh; }
                    }
                    LAS float* sd = ch < 768 ? SP + t * SPS + ch : SPL + t * 384 + (ch - 768);
                    *(LAS f32x4*)sd = o0; *(LAS f32x4*)(sd + 4) = o1;
                }
            }
            __syncthreads();
            {
#pragma unroll
                for (int it = 0; it < 6; ++it) { const int idx = c.tid + it * 512; const int t = idx / 192, c2 = (idx - t * 192) * 2;
                    const float x0 = SPL[t * 384 + c2], x1 = SPL[t * 384 + c2 + 1];
                    float y0, y1;
                    if (c2 < 128) { y0 = 1.f - 2.f / (__expf(2.f * x0) + 1.f); y1 = 1.f - 2.f / (__expf(2.f * x1) + 1.f); }
                    else if (c2 < 256) { y0 = x0; y1 = x1; }
                    else { y0 = sigm(x0); y1 = sigm(x1); }
                    *(LAS unsigned*)(ACT + t * 392 + c2) = pk2(y0, y1); }
            }
            {
#pragma unroll
                for (int tt = 0; tt < 2; ++tt) { const int t = c.wave * 2 + tt; float ss = 0.f;
#pragma unroll
                    for (int j = 0; j < 4; ++j) { const float v = SP[t * SPS + 256 + lane * 4 + j] * kks[lane * 4 + j]; ss += v * v; }
                    ss = red16(ss);
                    if (fr == 0) KKI[t * 4 + g] = 1.f / fmaxf(sqrtf(ss), 1e-12f); }
            }
            __syncthreads();
            float bpart[4] = {0.f, 0.f, 0.f, 0.f};
#pragma unroll 1
            for (int nn = 0; nn < 2; ++nn) {
                const int nt = c.wave * 2 + nn, ch = nt * 16 + fr, hh = nt >> 2;
                f32x4 aw[2], aa[2], ag = (f32x4){0.f, 0.f, 0.f, 0.f};
#pragma unroll
                for (int d = 0; d < 2; ++d) { aw[d] = (f32x4){0.f, 0.f, 0.f, 0.f}; aa[d] = aw[d]; }
#pragma unroll
                for (int d = 0; d < 2; ++d)
#pragma unroll
                    for (int ks = 0; ks < 2; ++ks) {
                        const bf16x8 fa = *(const LAS bf16x8*)(ACT + fr * 392 + d * 64 + ks * 32 + g * 8), fb = *(const LAS bf16x8*)(ACT + fr * 392 + 128 + d * 64 + ks * 32 + g * 8);
                        const bf16x8 bw = *(const bf16x8*)(lo + (size_t)d * 16384 + (size_t)ch * 64 + ks * 32 + g * 8);
                        const bf16x8 ba = *(const bf16x8*)(lo + 32768 + (size_t)d * 16384 + (size_t)ch * 64 + ks * 32 + g * 8);
                        aw[d] = __builtin_amdgcn_mfma_f32_16x16x32_bf16(fa, bw, aw[d], 0, 0, 0);
                        aa[d] = __builtin_amdgcn_mfma_f32_16x16x32_bf16(fb, ba, aa[d], 0, 0, 0);
                    }
#pragma unroll
                for (int ks = 0; ks < 4; ++ks) {
                    const bf16x8 fg = *(const LAS bf16x8*)(ACT + fr * 392 + 256 + ks * 32 + g * 8);
                    const bf16x8 bg = *(const bf16x8*)(lo + 65536 + (size_t)ch * 128 + ks * 32 + g * 8);
                    ag = __builtin_amdgcn_mfma_f32_16x16x32_bf16(fg, bg, ag, 0, 0, 0);
                }
                const float kksc = kks[ch], kac = k_a[ch], rkc = r_k[ch];
                const float w0f = c.a->in[13][(size_t)(l * 2 + 0) * 256 + ch], w0b = c.a->in[13][(size_t)(l * 2 + 1) * 256 + ch];
                const float a0f = c.a->in[15][(size_t)(l * 2 + 0) * 256 + ch], a0b = c.a->in[15][(size_t)(l * 2 + 1) * 256 + ch];
                float ld[2][4], kdv[2][4], akv[2][4], kkv[4], rrv[4], vvv[4];
#pragma unroll
                for (int j = 0; j < 4; ++j) {
                    const int t = 4 * g + j; const size_t row = (size_t)r0 + t;
                    const float rr = SP[t * SPS + ch], kk0 = SP[t * SPS + 256 + ch], vv = SP[t * SPS + 512 + ch];
                    const float kk = kk0 * kksc * KKI[t * 4 + hh];
                    kkv[j] = kk; rrv[j] = rr; vvv[j] = vv;
                    float kdsum = 0.f;
#pragma unroll
                    for (int d = 0; d < 2; ++d) {
                        const float wl = (d ? w0b : w0f) + aw[d][j];
                        const float xx = -wl; const float sp = fmaxf(xx, 0.f) + __logf(1.f + __expf(-fabsf(xx)));
                        const float wlog = -sp - 0.5f; ld[d][j] = -__expf(wlog);
                        const float a = sigm((d ? a0b : a0f) + aa[d][j]);
                        const float kd = kk0 * (1.f + (a - 1.f) * kac);
                        kdv[d][j] = kd; akv[d][j] = a * kk; kdsum += kd;
                    }
                    GG[row * 256 + ch] = f2bf(ag[j]);
                    bpart[j] += rr * kdsum * rkc;
                }
                const int k = ch & 63;
#pragma unroll
                for (int d = 0; d < 2; ++d) {
                    const float tot = (ld[d][0] + ld[d][1]) + (ld[d][2] + ld[d][3]);
                    const float T0 = shidx(tot, fr), T1 = shidx(tot, fr + 16), T2 = shidx(tot, fr + 32), T3 = shidx(tot, fr + 48);
                    float run = d ? ((g < 3 ? T3 : 0.f) + (g < 2 ? T2 : 0.f) + (g < 1 ? T1 : 0.f)) : ((g > 0 ? T0 : 0.f) + (g > 1 ? T1 : 0.f) + (g > 2 ? T2 : 0.f));
                    const int hd = hh * 2 + d;
                    LAS bf16_t* ALT = (LAS bf16_t*)(c.lds + rw_img_off(hd)); LAS bf16_t* KT = ALT + 16 * 72; LAS bf16_t* KAP = KT + 16 * 72; LAS bf16_t* RT = KAP + 16 * 72;
#pragma unroll
                    for (int jj = 0; jj < 4; ++jj) {
                        const int j = d ? 3 - jj : jj; const int tq = d ? 15 - (4 * g + j) : 4 * g + j;
                        const float Gp = __expf(run); run += ld[d][j]; const float G = __expf(run), iG = __expf(-run);
                        ALT[tq * 72 + k] = f2bf(akv[d][j] * iG); KT[tq * 72 + k] = f2bf(kdv[d][j] * iG); KAP[tq * 72 + k] = f2bf(Gp * kkv[j]); RT[tq * 72 + k] = f2bf(G * rrv[j]);
                    }
                    const size_t task = (size_t)((b * 4 + hh) * 2 + d) * 144 + (s0 >> 4);
                    if (g == 0) { const float gc = __expf((T0 + T1) + (T2 + T3)); GCL[hd * 64 + k] = gc; GCo[task * 64 + k] = gc; }
                    u32x2 pv; if (d) { pv.x = pk2(vvv[3], vvv[2]); pv.y = pk2(vvv[1], vvv[0]); } else { pv.x = pk2(vvv[0], vvv[1]); pv.y = pk2(vvv[2], vvv[3]); }
                    *(u32x2*)(VT2 + (task * 64 + k) * 16 + (d ? 12 - 4 * g : 4 * g)) = pv;
                }
            }
#pragma unroll
            for (int j = 0; j < 4; ++j) { const float s = red16(bpart[j]); if (fr == 0) BONP[(4 * g + j) * 8 + c.wave] = s; }
            __syncthreads();
            for (int idx = c.tid; idx < 16 * 256; idx += 512) { const int t = idx >> 8, ch = idx & 255, hh = ch >> 6;
                BON[((size_t)r0 + t) * 256 + ch] = f2bf((BONP[t * 8 + hh * 2] + BONP[t * 8 + hh * 2 + 1]) * SP[t * SPS + 512 + ch]); }
            __syncthreads();
            rwkv_chunk_task(c, ((b * 4 + (c.wave >> 1)) * 2 + (c.wave & 1)) * 144 + (s0 >> 4));
            if (REP_PHASE == 35) rwkv_chunk_task(c, ((b * 4 + (c.wave >> 1)) * 2 + (c.wave & 1)) * 144 + (s0 >> 4));
            __syncthreads();
        }
    }
}

__device__ __forceinline__ void rwkv_chunk_task(const Ctx& c, const int task) {
    const int wv = c.wave;
    {
    int lane = c.lane; asm volatile("" : "+v"(lane));
    const int fr = lane & 15, g = lane >> 4;
    LAS bf16_t* ALT = (LAS bf16_t*)(c.lds + rw_img_off(wv)); LAS bf16_t* KT = ALT + 16 * 72; LAS bf16_t* KAP = KT + 16 * 72; LAS bf16_t* RT = KAP + 16 * 72;
    LAS float* SM = (LAS float*)(c.lds + rw_sm_off(wv));
    bf16_t* KHT = c.w<bf16_t>(WS_KHT); bf16_t* AHT = c.w<bf16_t>(WS_AHT); float* GCo = c.w<float>(WS_GC); bf16_t* RH = c.w<bf16_t>(WS_RH); bf16_t* WYo = c.w<bf16_t>(WS_WY); bf16_t* ZT = c.w<bf16_t>(WS_ZT);
    {
        const float Gc = ((const LAS float*)(c.lds + 74752))[wv * 64 + lane];
        {
            f32x4 dN = {0.f, 0.f, 0.f, 0.f}, dM = dN, dNR = dN, dMR = dN;
#pragma unroll
            for (int ks = 0; ks < 2; ++ks) {
                const bf16x8 aA = *(const LAS bf16x8*)(ALT + fr * 72 + ks * 32 + g * 8), aK = *(const LAS bf16x8*)(KT + fr * 72 + ks * 32 + g * 8);
                const bf16x8 bP = *(const LAS bf16x8*)(KAP + fr * 72 + ks * 32 + g * 8), bR = *(const LAS bf16x8*)(RT + fr * 72 + ks * 32 + g * 8);
                dN = __builtin_amdgcn_mfma_f32_16x16x32_bf16(aA, bP, dN, 0, 0, 0); dM = __builtin_amdgcn_mfma_f32_16x16x32_bf16(aK, bP, dM, 0, 0, 0);
                dNR = __builtin_amdgcn_mfma_f32_16x16x32_bf16(aA, bR, dNR, 0, 0, 0); dMR = __builtin_amdgcn_mfma_f32_16x16x32_bf16(aK, bR, dMR, 0, 0, 0);
            }
#pragma unroll
            for (int j = 0; j < 4; ++j) { const int sI = 4 * g + j;
                SM[0 * 256 + sI * 16 + fr] = sI < fr ? dN[j] : 0.f; SM[1 * 256 + sI * 16 + fr] = sI < fr ? dM[j] : 0.f;
                SM[2 * 256 + sI * 16 + fr] = sI <= fr ? dNR[j] : 0.f; SM[3 * 256 + sI * 16 + fr] = sI <= fr ? dMR[j] : 0.f; }
        }
        __builtin_amdgcn_wave_barrier();
        {
            const int role = g & 1;
            float X[16];
#define ROW4(dst, mat, r_) do { _Pragma("unroll") for (int q_ = 0; q_ < 4; ++q_) dst[q_] = *(const LAS f32x4*)(SM + (mat) * 256 + (r_) * 16 + 4 * q_); } while (0)
            {
                f32x4 nr[4]; float nrhs = role ? SM[2 * 256 + 15 * 16 + fr] : (15 == fr ? 1.f : 0.f);
                ROW4(nr, 0, 15);
#pragma unroll
                for (int sI = 15; sI >= 0; --sI) {
                    f32x4 cr[4]; float acc = nrhs;
#pragma unroll
                    for (int q = 0; q < 4; ++q) cr[q] = nr[q];
                    if (sI > 0) { ROW4(nr, 0, sI - 1); nrhs = role ? SM[2 * 256 + (sI - 1) * 16 + fr] : (sI - 1 == fr ? 1.f : 0.f); }
                    MEMBAR();
#pragma unroll
                    for (int j = sI + 1; j < 16; ++j) acc -= cr[j >> 2][j & 3] * X[j];
                    X[sI] = acc;
                }
            }
            {
                f32x4 nr[4]; float nmr = SM[3 * 256 + 0 * 16 + fr];
                ROW4(nr, 1, 0);
#pragma unroll
                for (int sI = 0; sI < 16; ++sI) {
                    f32x4 cr[4]; const float mr = nmr;
#pragma unroll
                    for (int q = 0; q < 4; ++q) cr[q] = nr[q];
                    if (sI < 15) { ROW4(nr, 1, sI + 1); nmr = SM[3 * 256 + (sI + 1) * 16 + fr]; }
                    MEMBAR();
                    float om = 0.f;
#pragma unroll
                    for (int j = sI + 1; j < 16; ++j) om += cr[j >> 2][j & 3] * X[j];
                    const float oo = role ? mr - om : om;
                    SM[(4 + role) * 256 + sI * 16 + fr] = X[sI]; SM[(6 + role) * 256 + sI * 16 + fr] = oo;
                }
            }
        }
        __builtin_amdgcn_wave_barrier();
        float Kh[16], ahv[16];
        {
            float Rh[16];
#pragma unroll
            for (int t = 0; t < 16; ++t) { Kh[t] = 0.f; Rh[t] = bf2f(RT[t * 72 + lane]); }
            f32x4 nt4[4], ng4[4]; bf16_t nk = KAP[0 * 72 + lane];
            ROW4(nt4, 4, 0); ROW4(ng4, 5, 0);
            MEMBAR();
#pragma unroll
            for (int sI = 0; sI < 16; ++sI) {
                f32x4 ct[4], cg[4]; const float kps = bf2f(nk);
#pragma unroll
                for (int q = 0; q < 4; ++q) { ct[q] = nt4[q]; cg[q] = ng4[q]; }
                if (sI < 15) { ROW4(nt4, 4, sI + 1); ROW4(ng4, 5, sI + 1); nk = KAP[(sI + 1) * 72 + lane]; }
                MEMBAR();
#pragma unroll
                for (int t = sI; t < 16; ++t) { Kh[t] += kps * ct[t >> 2][t & 3]; Rh[t] -= kps * cg[t >> 2][t & 3]; }
            }
            bf16_t* rd = RH + (size_t)task * 1024 + lane; bf16_t* kd2 = KHT + (size_t)task * 1024 + lane;
#pragma unroll
            for (int t = 0; t < 16; ++t) { rd[t * 64] = f2bf(Rh[t]); kd2[t * 64] = f2bf(Kh[t]); }
            MEMBAR();
        }
        {
            float Z[16];
#pragma unroll
            for (int t = 0; t < 16; ++t) ahv[t] = bf2f(ALT[t * 72 + lane]) * Gc;
            f32x4 nm4[4]; bf16_t nk = KT[0 * 72 + lane];
            ROW4(nm4, 6, 0);
            MEMBAR();
#pragma unroll
            for (int sI = 0; sI < 16; ++sI) {
                f32x4 cm[4]; float z = bf2f(nk) * Gc;
#pragma unroll
                for (int q = 0; q < 4; ++q) cm[q] = nm4[q];
                if (sI < 15) { ROW4(nm4, 6, sI + 1); nk = KT[(sI + 1) * 72 + lane]; }
                MEMBAR();
#pragma unroll
                for (int t = sI + 1; t < 16; ++t) z -= cm[t >> 2][t & 3] * ahv[t];
                Z[sI] = z;
            }
            unsigned pz[8];
#pragma unroll
            for (int i = 0; i < 8; ++i) pz[i] = pk2(Z[2 * i], Z[2 * i + 1]);
            bf16_t* zd = ZT + ((size_t)task * 64 + lane) * 16;
            *(u32x4*)zd = (u32x4){pz[0], pz[1], pz[2], pz[3]}; *(u32x4*)(zd + 8) = (u32x4){pz[4], pz[5], pz[6], pz[7]};
            MEMBAR();
        }
#undef ROW4
        {
            unsigned pa[8];
#pragma unroll
            for (int i = 0; i < 8; ++i) pa[i] = pk2(ahv[2 * i], ahv[2 * i + 1]);
            bf16_t* ad = AHT + ((size_t)task * 64 + lane) * 16;
            *(u32x4*)ad = (u32x4){pa[0], pa[1], pa[2], pa[3]}; *(u32x4*)(ad + 8) = (u32x4){pa[4], pa[5], pa[6], pa[7]};
            if (g == 0) {
                unsigned pw[8];
#pragma unroll
                for (int i = 0; i < 8; ++i) pw[i] = pk2(SM[7 * 256 + (2 * i) * 16 + fr], SM[7 * 256 + (2 * i + 1) * 16 + fr]);
                bf16_t* wd = WYo + ((size_t)task * 16 + fr) * 16;
                *(u32x4*)wd = (u32x4){pw[0], pw[1], pw[2], pw[3]}; *(u32x4*)(wd + 8) = (u32x4){pw[4], pw[5], pw[6], pw[7]};
            }
        }
        __builtin_amdgcn_wave_barrier();
    }
    }
}

constexpr int RC_RD = 5, RC_SLOT = 10240;
__device__ __forceinline__ void rwkv_scan(const Ctx& c) {
    const int lane = c.lane, fr = lane & 15, g = lane >> 4;
    LAS unsigned char* ring = c.lds;
    for (int task = c.bid; task < 256; task += c.G) {
        const int b = task >> 5, h = (task >> 3) & 3, dir = (task >> 2) & 1, vs = task & 3;
        const size_t cbase = (size_t)((b * 4 + h) * 2 + dir) * 144;
        const unsigned char* KHT = c.w<unsigned char>(WS_KHT) + cbase * 2048 + lane * 16; const unsigned char* RH = c.w<unsigned char>(WS_RH) + cbase * 2048 + lane * 16;
        const unsigned char* AHT = c.w<unsigned char>(WS_AHT) + cbase * 2048 + lane * 16; const unsigned char* ZT = c.w<unsigned char>(WS_ZT) + cbase * 2048 + lane * 16;
        const unsigned char* X1 = lane < 16 ? c.w<unsigned char>(WS_GC) + cbase * 256 + lane * 16 : (lane < 48 ? c.w<unsigned char>(WS_WY) + cbase * 512 + (lane - 16) * 16 : c.w<unsigned char>(WS_VT2) + cbase * 2048 + vs * 512 + (lane - 48) * 16);
        const int x1s = lane < 16 ? 256 : (lane < 48 ? 512 : 2048);
        const unsigned char* X2 = lane < 16 ? c.w<unsigned char>(WS_VT2) + cbase * 2048 + vs * 512 + 256 + lane * 16 : c.w<unsigned char>(WS_GC) + cbase * 256 + (lane & 15) * 16;
        const int x2s = lane < 16 ? 2048 : 256;
        bf16_t* YSp = c.w<bf16_t>(WS_YS) + (size_t)dir * MTOK * 256 + h * 64 + vs * 16 + fr;
#define RC_NB(ci_) (dir == 0 ? (ci_) : ((ci_) < 16 ? 15 - (ci_) : 159 - (ci_)))
#define RC_DMA(ci_, slot_) do { int cc_ = (ci_); cc_ = cc_ < 144 ? cc_ : 143; const int nb_ = RC_NB(cc_); LAS unsigned char* d_ = ring + (slot_) * RC_SLOT; \
        _Pragma("unroll") for (int k_ = 0; k_ < 2; ++k_) { \
            __builtin_amdgcn_global_load_lds((const unsigned*)(KHT + (size_t)nb_ * 2048 + k_ * 1024), (LAS unsigned*)(d_ + k_ * 1024), 16, 0, 0); \
            __builtin_amdgcn_global_load_lds((const unsigned*)(RH + (size_t)nb_ * 2048 + k_ * 1024), (LAS unsigned*)(d_ + 2048 + k_ * 1024), 16, 0, 0); \
            __builtin_amdgcn_global_load_lds((const unsigned*)(AHT + (size_t)nb_ * 2048 + k_ * 1024), (LAS unsigned*)(d_ + 4096 + k_ * 1024), 16, 0, 0); \
            __builtin_amdgcn_global_load_lds((const unsigned*)(ZT + (size_t)nb_ * 2048 + k_ * 1024), (LAS unsigned*)(d_ + 6144 + k_ * 1024), 16, 0, 0); } \
        __builtin_amdgcn_global_load_lds((const unsigned*)(X1 + (size_t)nb_ * x1s), (LAS unsigned*)(d_ + 8192), 16, 0, 0); \
        __builtin_amdgcn_global_load_lds((const unsigned*)(X2 + (size_t)nb_ * x2s), (LAS unsigned*)(d_ + 9216), 16, 0, 0); } while (0)
        f32x4 S[4];
#pragma unroll
        for (int m = 0; m < 4; ++m) S[m] = (f32x4){0.f, 0.f, 0.f, 0.f};
#pragma unroll 1
        for (int q = 0; q < RC_RD; ++q) RC_DMA(q, q);
        asm volatile("s_waitcnt vmcnt(0)" ::: "memory");
        int slot = 0;
#pragma unroll 1
        for (int ci = 0; ci < 144; ++ci) {
            const int nb = RC_NB(ci); const int row0 = b * TPB + nb * 16;
            asm volatile("s_waitcnt vmcnt(%0)" :: "n"((RC_RD - 1) * 14 + 4) : "memory");
            const LAS bf16_t* sp = (const LAS bf16_t*)(ring + slot * RC_SLOT);
            u32x2 kh[2][2], rh[2][2], ah[4], zt[4], wy, vt; f32x4 gc[4];
#pragma unroll
            for (int k = 0; k < 2; ++k) { kh[k][0] = *(const LAS u32x2*)(sp + fr * 64 + 32 * k + 4 * g); kh[k][1] = *(const LAS u32x2*)(sp + fr * 64 + 32 * k + 16 + 4 * g);
                rh[k][0] = *(const LAS u32x2*)(sp + 1024 + fr * 64 + 32 * k + 4 * g); rh[k][1] = *(const LAS u32x2*)(sp + 1024 + fr * 64 + 32 * k + 16 + 4 * g); }
#pragma unroll
            for (int m = 0; m < 4; ++m) { ah[m] = *(const LAS u32x2*)(sp + 2048 + (16 * m + fr) * 16 + 4 * g); zt[m] = *(const LAS u32x2*)(sp + 3072 + (16 * m + fr) * 16 + 4 * g);
                gc[m] = *(const LAS f32x4*)((const LAS float*)(sp + 4096) + 16 * m + 4 * g); }
            wy = *(const LAS u32x2*)(sp + 4096 + 128 + fr * 16 + 4 * g);
            vt = *(const LAS u32x2*)(sp + 4096 + 384 + fr * 16 + 4 * g);
            asm volatile("s_waitcnt lgkmcnt(0)" ::: "memory");
            RC_DMA(ci + RC_RD, slot);
            union { u32x4 u; bf16x8 v; } B0, B1, A;
            union { u32x2 u; bf16x4 v; } a4, b4, w4;
            B0.u = (u32x4){pk2m(S[0][0], S[0][1]), pk2m(S[0][2], S[0][3]), pk2m(S[1][0], S[1][1]), pk2m(S[1][2], S[1][3])};
            B1.u = (u32x4){pk2m(S[2][0], S[2][1]), pk2m(S[2][2], S[2][3]), pk2m(S[3][0], S[3][1]), pk2m(S[3][2], S[3][3])};
            b4.u = vt;
            f32x4 w = {0.f, 0.f, 0.f, 0.f}, y = {0.f, 0.f, 0.f, 0.f};
            A.u = (u32x4){kh[0][0].x, kh[0][0].y, kh[0][1].x, kh[0][1].y}; w = __builtin_amdgcn_mfma_f32_16x16x32_bf16(A.v, B0.v, w, 0, 0, 0);
            A.u = (u32x4){kh[1][0].x, kh[1][0].y, kh[1][1].x, kh[1][1].y}; w = __builtin_amdgcn_mfma_f32_16x16x32_bf16(A.v, B1.v, w, 0, 0, 0);
            A.u = (u32x4){rh[0][0].x, rh[0][0].y, rh[0][1].x, rh[0][1].y}; y = __builtin_amdgcn_mfma_f32_16x16x32_bf16(A.v, B0.v, y, 0, 0, 0);
            A.u = (u32x4){rh[1][0].x, rh[1][0].y, rh[1][1].x, rh[1][1].y}; y = __builtin_amdgcn_mfma_f32_16x16x32_bf16(A.v, B1.v, y, 0, 0, 0);
            a4.u = wy; y = __builtin_amdgcn_mfma_f32_16x16x16bf16_1k(a4.v, b4.v, y, 0, 0, 0);
            w4.u = (u32x2){pk2m(-w[0], -w[1]), pk2m(-w[2], -w[3])};
#pragma unroll
            for (int m = 0; m < 4; ++m) {
                f32x4 d = {0.f, 0.f, 0.f, 0.f};
                a4.u = zt[m]; d = __builtin_amdgcn_mfma_f32_16x16x16bf16_1k(a4.v, b4.v, d, 0, 0, 0);
                a4.u = ah[m]; d = __builtin_amdgcn_mfma_f32_16x16x16bf16_1k(a4.v, w4.v, d, 0, 0, 0);
                S[m] = S[m] * gc[m] + d;
            }
#pragma unroll
            for (int j = 0; j < 4; ++j) { const int t = 4 * g + j; YSp[(size_t)(row0 + (dir ? 15 - t : t)) * 256] = f2bf(y[j]); }
            slot = slot + 1 == RC_RD ? 0 : slot + 1;
        }
        asm volatile("s_waitcnt vmcnt(0)" ::: "memory");
#undef RC_NB
#undef RC_DMA
    }
}

__device__ __forceinline__ void hgrn_scan(const Ctx& c) {
    const int lane = c.lane, fr = lane & 15, g = lane >> 4;
    for (int task = c.bid; task < 256; task += c.G) {
        const int b = task >> 5, h = (task >> 3) & 3, dir = (task >> 2) & 1, vs = task & 3;
        const bf16_t* QIN = c.w<bf16_t>(WS_QIN) + (size_t)dir * MTOK * 256 + h * 64;
        const bf16_t* KOT = c.w<bf16_t>(WS_KOT) + (((size_t)(dir * 8 + b) * 4 + h) * NBLK16) * 1024;
        const bf16_t* IT = c.w<bf16_t>(WS_IT) + (((size_t)(b * 4 + h)) * NBLK16) * 1024;
        const float* DEC = c.w<float>(WS_DEC) + (((size_t)(dir * 8 + b) * 4 + h) * NBLK16) * 64;
        bf16_t* O2 = c.w<bf16_t>(WS_O2) + (size_t)dir * MTOK * 256 + h * 64 + vs * 16 + fr;
        f32x4 S[4];
#pragma unroll
        for (int m = 0; m < 4; ++m) S[m] = (f32x4){0.f, 0.f, 0.f, 0.f};
        u32x2 q00[4], q01[4], q10[4], q11[4]; f32x4 dc[4][4]; bf16x4 ka[4][4], ib[4];
#define HG_NB(ci_) (dir == 0 ? (ci_) : ((ci_) < 16 ? 15 - (ci_) : 159 - (ci_)))
#define HG_LOAD(ci_, st_) do { int cc_ = (ci_); cc_ = cc_ < NBLK16 ? cc_ : NBLK16 - 1; const int nb_ = HG_NB(cc_); const bf16_t* qp_ = QIN + (size_t)(b * TPB + nb_ * 16 + fr) * 256 + 4 * g; \
        q00[st_] = *(const u32x2*)qp_; q01[st_] = *(const u32x2*)(qp_ + 16); q10[st_] = *(const u32x2*)(qp_ + 32); q11[st_] = *(const u32x2*)(qp_ + 48); \
        _Pragma("unroll") for (int m_ = 0; m_ < 4; ++m_) { dc[st_][m_] = *(const f32x4*)(DEC + (size_t)nb_ * 64 + 16 * m_ + 4 * g); ka[st_][m_] = *(const bf16x4*)(KOT + (size_t)nb_ * 1024 + (16 * m_ + fr) * 16 + 4 * g); } \
        ib[st_] = *(const bf16x4*)(IT + (size_t)nb_ * 1024 + (vs * 16 + fr) * 16 + 4 * g); MEMBAR(); } while (0)
#define HG_STEP(ci_, st_) do { const int nb_ = HG_NB(ci_); const int row0_ = b * TPB + nb_ * 16; \
        union { u32x4 u; bf16x8 v; } A0, A1, B0, B1; \
        A0.u = (u32x4){q00[st_].x, q00[st_].y, q01[st_].x, q01[st_].y}; A1.u = (u32x4){q10[st_].x, q10[st_].y, q11[st_].x, q11[st_].y}; \
        B0.u = (u32x4){pk2m(S[0][0], S[0][1]), pk2m(S[0][2], S[0][3]), pk2m(S[1][0], S[1][1]), pk2m(S[1][2], S[1][3])}; \
        B1.u = (u32x4){pk2m(S[2][0], S[2][1]), pk2m(S[2][2], S[2][3]), pk2m(S[3][0], S[3][1]), pk2m(S[3][2], S[3][3])}; \
        f32x4 o = (f32x4){0.f, 0.f, 0.f, 0.f}; \
        o = __builtin_amdgcn_mfma_f32_16x16x32_bf16(A0.v, B0.v, o, 0, 0, 0); o = __builtin_amdgcn_mfma_f32_16x16x32_bf16(A1.v, B1.v, o, 0, 0, 0); \
        _Pragma("unroll") for (int j_ = 0; j_ < 4; ++j_) O2[(size_t)(row0_ + 4 * g + j_) * 256] = f2bf(o[j_]); \
        _Pragma("unroll") for (int m_ = 0; m_ < 4; ++m_) { S[m_] = S[m_] * dc[st_][m_]; S[m_] = __builtin_amdgcn_mfma_f32_16x16x16bf16_1k(ka[st_][m_], ib[st_], S[m_], 0, 0, 0); } } while (0)
        HG_LOAD(0, 0); HG_LOAD(1, 1); HG_LOAD(2, 2);
#pragma unroll 1
        for (int ci = 0; ci < NBLK16; ci += 4) {
            HG_LOAD(ci + 3, 3); HG_STEP(ci, 0);
            HG_LOAD(ci + 4, 0); HG_STEP(ci + 1, 1);
            HG_LOAD(ci + 5, 1); HG_STEP(ci + 2, 2);
            HG_LOAD(ci + 6, 2); HG_STEP(ci + 3, 3);
        }
#undef HG_NB
#undef HG_LOAD
#undef HG_STEP
    }
}

template <bool LAT> __device__ __forceinline__ void attn_unit(const Ctx& c, int l, int b, int h, int r, int jb) {
    const int lane = c.lane, fr = lane & 15, g = lane >> 4;
    const size_t bh = (size_t)(b * 8 + h);
    const bf16_t* Q = c.w<bf16_t>(WS_QN) + bh * TPB * 64; const bf16_t* K = c.w<bf16_t>(WS_KN) + bh * TPB * 64; const bf16_t* V = c.w<bf16_t>(WS_VT) + bh * 64 * TPB;
    const int q0 = LAT ? CTX + r * 64 + jb * 16 : jb * 16;
    const bf16x8 qf0 = *(const bf16x8*)(Q + (size_t)(q0 + fr) * 64 + 8 * g), qf1 = *(const bf16x8*)(Q + (size_t)(q0 + fr) * 64 + 32 + 8 * g);
    constexpr int NT = LAT ? 32 : 16, NB = NT / 8;
    int r_start = r - 4; r_start = r_start < 0 ? 0 : (r_start > 24 ? 24 : r_start);
    int k_start = 16 * jb - 8; k_start = k_start < 0 ? 0 : (k_start > 32 ? 32 : k_start);
    const bf16_t* kbase = K + (size_t)(fr >> 3) * 512 + (fr & 7) * 32 + g * 8;
#define KEY0(t) ((t) < 16 ? (t) * 16 : CTX + (r_start + (((t) - 16) >> 1)) * 64 + k_start + 16 * ((t) & 1))
    f32x4 sc[NT];
    bf16x8 kf[2][8][2];
#define K_ISSUE(bt, buf) do { _Pragma("unroll") for (int i_ = 0; i_ < 8; ++i_) { const bf16_t* kp_ = kbase + (size_t)(KEY0((bt) * 8 + i_) >> 3) * 512; \
        kf[buf][i_][0] = *(const bf16x8*)kp_; kf[buf][i_][1] = *(const bf16x8*)(kp_ + 256); } MEMBAR(); } while (0)
#define K_COMP(bt, buf) do { _Pragma("unroll") for (int i_ = 0; i_ < 8; ++i_) { f32x4 a_ = (f32x4){0.f, 0.f, 0.f, 0.f}; \
        a_ = __builtin_amdgcn_mfma_f32_16x16x32_bf16(kf[buf][i_][0], qf0, a_, 0, 0, 0); a_ = __builtin_amdgcn_mfma_f32_16x16x32_bf16(kf[buf][i_][1], qf1, a_, 0, 0, 0); sc[(bt) * 8 + i_] = a_; } MEMBAR(); } while (0)
    K_ISSUE(0, 0); K_ISSUE(1, 1);
    K_COMP(0, 0);
    if (LAT) { K_ISSUE(2, 0); K_COMP(1, 1); K_ISSUE(3, 1); K_COMP(2, 0); K_COMP(3, 1); }
    else K_COMP(1, 1);
#undef K_ISSUE
#undef K_COMP
    if (LAT) {
        const int qc = 16 * jb + fr; int w_start = qc - 8; w_start = w_start < 0 ? 0 : (w_start > 48 ? 48 : w_start);
        const float* rpb = c.a->in[25] + (size_t)(l * 8 + h) * 15 * 31;
        float bias[16][4];
#pragma unroll
        for (int t = 16; t < NT; ++t) {
            const int rrow = (t - 16) >> 1, hf = t & 1; const int ridx = r_start + rrow - r + 7;
#pragma unroll
            for (int j = 0; j < 4; ++j) { const int kc = k_start + 16 * hf + 4 * g + j; int cidx = kc - qc + 15; cidx = cidx < 0 ? 0 : (cidx > 30 ? 30 : cidx); bias[t - 16][j] = rpb[ridx * 31 + cidx]; }
        }
        MEMBAR();
#pragma unroll
        for (int t = 16; t < NT; ++t)
#pragma unroll
            for (int j = 0; j < 4; ++j) { const int kc = k_start + 16 * (t & 1) + 4 * g + j; const bool ok = kc >= w_start && kc < w_start + 16; sc[t][j] = ok ? sc[t][j] + bias[t - 16][j] : -1e30f; }
    }
    float m = -3e38f;
#pragma unroll
    for (int t = 0; t < NT; ++t) m = fmaxf(m, fmaxf(fmaxf(sc[t][0], sc[t][1]), fmaxf(sc[t][2], sc[t][3])));
    m = fmaxf(m, shx(m, 16)); m = fmaxf(m, shx(m, 32));
    float ls = 0.f;
    u32x4 pa[NT / 2];
#pragma unroll
    for (int ks = 0; ks < NT / 2; ++ks) {
        float p[8];
#pragma unroll
        for (int j = 0; j < 4; ++j) { p[j] = __expf(sc[2 * ks][j] - m); p[4 + j] = __expf(sc[2 * ks + 1][j] - m); }
#pragma unroll
        for (int j = 0; j < 8; ++j) ls += p[j];
        pa[ks] = (u32x4){pk2m(p[0], p[1]), pk2m(p[2], p[3]), pk2m(p[4], p[5]), pk2m(p[6], p[7])};
    }
    ls += shx(ls, 16); ls += shx(ls, 32);
    f32x4 o[4];
#pragma unroll
    for (int n = 0; n < 4; ++n) o[n] = (f32x4){0.f, 0.f, 0.f, 0.f};
    const bf16_t* vbase = V + (size_t)(g >> 1) * 512 + fr * 8 + (g & 1) * 4;
    u32x2 vf[2][2][4][2];
#define V_ISSUE(bt, buf) do { _Pragma("unroll") for (int i_ = 0; i_ < 2; ++i_) { const int ta_ = 2 * ((bt) * 2 + i_); const int tok_ = KEY0(ta_); \
        _Pragma("unroll") for (int n_ = 0; n_ < 4; ++n_) { const bf16_t* vp_ = vbase + n_ * 128 + (size_t)(tok_ >> 3) * 512; vf[buf][i_][n_][0] = *(const u32x2*)vp_; vf[buf][i_][n_][1] = *(const u32x2*)(vp_ + 1024); } } MEMBAR(); } while (0)
#define V_COMP(bt, buf) do { _Pragma("unroll") for (int i_ = 0; i_ < 2; ++i_) { union { u32x4 u; bf16x8 v; } pa_; pa_.u = pa[(bt) * 2 + i_]; \
        _Pragma("unroll") for (int n_ = 0; n_ < 4; ++n_) { union { u32x4 u; bf16x8 v; } vf_; vf_.u = (u32x4){vf[buf][i_][n_][0].x, vf[buf][i_][n_][0].y, vf[buf][i_][n_][1].x, vf[buf][i_][n_][1].y}; \
            o[n_] = __builtin_amdgcn_mfma_f32_16x16x32_bf16(pa_.v, vf_.v, o[n_], 0, 0, 0); } } MEMBAR(); } while (0)
    V_ISSUE(0, 0); V_ISSUE(1, 1);
    V_COMP(0, 0); V_ISSUE(2, 0); V_COMP(1, 1); V_ISSUE(3, 1); V_COMP(2, 0);
    if (LAT) { V_ISSUE(4, 0); V_COMP(3, 1); V_ISSUE(5, 1); V_COMP(4, 0); V_ISSUE(6, 0); V_COMP(5, 1); V_ISSUE(7, 1); V_COMP(6, 0); V_COMP(7, 1); }
    else V_COMP(3, 1);
#undef V_ISSUE
#undef V_COMP
#undef KEY0
    bf16_t* MIX = c.w<bf16_t>(WS_MIX);
#pragma unroll
    for (int j = 0; j < 4; ++j) {
        const float li = 1.f / shidx(ls, 4 * g + j);
        bf16_t* dst = MIX + (size_t)(b * TPB + q0 + 4 * g + j) * D + 512 + h * 64 + fr;
#pragma unroll
        for (int n = 0; n < 4; ++n) dst[16 * n] = f2bf(o[n][j] * li);
    }
}

__device__ __forceinline__ void phase_mix(const Ctx& c, int l) {
#pragma unroll 1
    for (int rep = 0; rep < (REP_PHASE == 41 ? 2 : 1); ++rep) if (c.wave == 0) { __builtin_amdgcn_s_setprio(3); rwkv_scan(c); __builtin_amdgcn_s_setprio(0); }
#pragma unroll 1
    for (int rep = 0; rep < (REP_PHASE == 42 ? 2 : 1); ++rep) if (c.wave == 1) { __builtin_amdgcn_s_setprio(3); hgrn_scan(c); __builtin_amdgcn_s_setprio(0); }
    if (c.G == 256) {
        const int x = c.bid & 7;
        unsigned* head = c.w<unsigned>(WS_CTL) + CW_ATT + (l * 8 + x) * 64;
        unsigned un = 0;
        if (c.lane == 0) un = __hip_atomic_fetch_add(head, 1u, __ATOMIC_RELAXED, __HIP_MEMORY_SCOPE_AGENT);
        for (;;) {
            const unsigned u = (unsigned)__builtin_amdgcn_readfirstlane((int)un);
            if (u >= 8 * 144) break;
            if (c.lane == 0) un = __hip_atomic_fetch_add(head, 1u, __ATOMIC_RELAXED, __HIP_MEMORY_SCOPE_AGENT);
            const int p = (int)u / 144, q = (int)u - p * 144, gp = p * 8 + x, b = gp >> 3, h = gp & 7;
            if (q < 128) attn_unit<true>(c, l, b, h, q >> 2, q & 3);
            else if (l < DEPTH - 1) attn_unit<false>(c, l, b, h, 0, q - 128);
        }
    } else {
        for (int u = c.bid * 8 + c.wave; u < 8192 + 1024; u += c.G * 8) {
            if (u < 8192) attn_unit<true>(c, l, u >> 10, (u >> 7) & 7, (u >> 2) & 31, u & 3);
            else { const int v = u - 8192; attn_unit<false>(c, l, v >> 7, (v >> 4) & 7, 0, v & 15); }
        }
    }
}

__device__ __forceinline__ void cvt_moe_group(const Ctx& c, int l, int task4) {
    LAS float* T = (LAS float*)c.lds;
    bf16_t* W1 = c.w<bf16_t>(WS_W1); bf16_t* W2 = c.w<bf16_t>(WS_W2);
    CvtJob jb[4];
#pragma unroll
    for (int q = 0; q < 4; ++q) {
        const int task = task4 * 4 + q; const int e = task / 384; int t = task - e * 384;
        if (t < 256) { const int up = t >> 7; t &= 127; const int kt = t >> 3, nt = t & 7; const int n0 = nt * 64, drow = (n0 >> 7) * 256 + (n0 & 127) + up * 128;
            jb[q].src = c.a->in[up ? 31 : 30] + (((size_t)l * 32 + e) * 1024 + kt * 64) * 512 + n0; jb[q].src_ld = 512; jb[q].dst = W1 + ((size_t)e * 1024 + drow) * 1024 + kt * 64; jb[q].dst_ld = 1024;
        } else { t -= 256; const int kt = t >> 4, nt = t & 15;
            jb[q].src = c.a->in[32] + (((size_t)l * 32 + e) * 512 + kt * 64) * 1024 + nt * 64; jb[q].src_ld = 1024; jb[q].dst = W2 + ((size_t)e * 1024 + nt * 64) * 512 + kt * 64; jb[q].dst_ld = 512;
        }
    }
    cvt_tile4(c, T, jb);
}

__device__ __forceinline__ void phase_post(const Ctx& c, int l) {
    const bf16_t* P = c.w<bf16_t>(WS_P); bf16_t* MIX = c.w<bf16_t>(WS_MIX);
    const bf16_t* O1 = c.w<bf16_t>(WS_O1); const bf16_t* O2 = c.w<bf16_t>(WS_O2); const bf16_t* YS = c.w<bf16_t>(WS_YS);
    const bf16_t* GG = c.w<bf16_t>(WS_G); const bf16_t* BON = c.w<bf16_t>(WS_BON);
    const int lane = c.lane;
    {
        const int ch = lane * 4, stride = c.G * 8;
        const f32x4 gn = *(const f32x4*)(c.a->in[11] + (size_t)l * 256 + ch), lg = *(const f32x4*)(c.a->in[21] + (size_t)l * 256 + ch), lb = *(const f32x4*)(c.a->in[22] + (size_t)l * 256 + ch);
        u32x2 pa, pbo, pgg, pgp, pb0, pb1, py0, py1;
#define POST_LOAD(r_) do { const size_t rr_ = (size_t)(r_); pa = *(const u32x2*)(O1 + rr_ * 256 + ch); pb0 = *(const u32x2*)(O2 + rr_ * 256 + ch); pb1 = *(const u32x2*)(O2 + ((size_t)MTOK + rr_) * 256 + ch); \
        pgp = *(const u32x2*)(P + rr_ * PT + PA_G + ch); py0 = *(const u32x2*)(YS + rr_ * 256 + ch); py1 = *(const u32x2*)(YS + ((size_t)MTOK + rr_) * 256 + ch); \
        pbo = *(const u32x2*)(BON + rr_ * 256 + ch); pgg = *(const u32x2*)(GG + rr_ * 256 + ch); } while (0)
        const bool lat_only = (l == DEPTH - 1); const int nrows = lat_only ? NB * SEQ : MTOK;
#define POST_ROW(i_) (lat_only ? ((i_) >> 11) * TPB + CTX + ((i_) & (SEQ - 1)) : (i_))
        POST_LOAD(POST_ROW(c.bid * 8 + c.wave));
        for (int ri = c.bid * 8 + c.wave; ri < nrows; ri += stride) {
            const int row = POST_ROW(ri);
            const u32x2 gp = pgp;
            const f32x4 a = {bflo(pa.x), bfhi(pa.x), bflo(pa.y), bfhi(pa.y)}, bo = {bflo(pbo.x), bfhi(pbo.x), bflo(pbo.y), bfhi(pbo.y)}, gg = {bflo(pgg.x), bfhi(pgg.x), bflo(pgg.y), bfhi(pgg.y)};
            const f32x4 b0 = {bflo(pb0.x), bfhi(pb0.x), bflo(pb0.y), bfhi(pb0.y)}, b1 = {bflo(pb1.x), bfhi(pb1.x), bflo(pb1.y), bfhi(pb1.y)};
            const f32x4 y0 = {bflo(py0.x), bfhi(py0.x), bflo(py0.y), bfhi(py0.y)}, y1 = {bflo(py1.x), bfhi(py1.x), bflo(py1.y), bfhi(py1.y)};
            POST_LOAD(ri + stride < nrows ? POST_ROW(ri + stride) : row);
            {
                const f32x4 o = a + b0 + b1;
                float ss = o[0] * o[0] + o[1] * o[1] + o[2] * o[2] + o[3] * o[3]; ss = red16(ss);
                const float inv = rsqrtf(ss * (1.f / 64.f) + 1e-6f);
                const float g0 = bflo(gp.x), g1 = bfhi(gp.x), g2 = bflo(gp.y), g3 = bfhi(gp.y);
                u32x2 w; w.x = pk2(o[0] * inv * gn[0] * g0 * sigm(g0), o[1] * inv * gn[1] * g1 * sigm(g1)); w.y = pk2(o[2] * inv * gn[2] * g2 * sigm(g2), o[3] * inv * gn[3] * g3 * sigm(g3));
                *(u32x2*)(MIX + (size_t)row * D + ch) = w;
            }
            {
                const f32x4 y = y0 + y1;
                float sm = y[0] + y[1] + y[2] + y[3]; sm = red16(sm); const float mean = sm * (1.f / 64.f);
                const f32x4 dv = y - mean;
                float vs = dv[0] * dv[0] + dv[1] * dv[1] + dv[2] * dv[2] + dv[3] * dv[3]; vs = red16(vs);
                const float inv = rsqrtf(vs * (1.f / 64.f) + 64e-5f);
                const f32x4 r = (dv * inv * lg + lb + bo) * gg;
                u32x2 w; w.x = pk2(r[0], r[1]); w.y = pk2(r[2], r[3]);
                *(u32x2*)(MIX + (size_t)row * D + 256 + ch) = w;
            }
        }
#undef POST_LOAD
#undef POST_ROW
    }
    __syncthreads();
    {
        const int nhere = (l < DEPTH - 1 && c.G == 256) ? 256 : 2048;
        for (int i = c.bid; i < nhere; i += c.G) cvt_moe_group(c, l, 96 * (i >> 6) + (i & 63));
    }
}

constexpr int WG_OFF = 140288;
__device__ __forceinline__ void phase_norm2(const Ctx& c, int l) {
    const float* MOD = c.w<float>(WS_MOD); const float* X = c.w<float>(WS_X); bf16_t* H = c.w<bf16_t>(WS_H);
    int4* ROUTE = c.w<int4>(WS_ROUTE); int* LIST = c.w<int>(WS_LIST); float* LISTW = c.w<float>(WS_LISTW);
    unsigned* CNT = c.w<unsigned>(WS_CTL) + CW_CNT + l * 64;
    const float* brg = c.a->in[27] + l * 4; const float* bre = c.a->in[29] + l * 32;
    LAS float* WE = (LAS float*)c.lds; LAS float* WG = (LAS float*)(c.lds + WG_OFF);
    LAS unsigned* lcnt = (LAS unsigned*)(c.lds + MISC_OFF + 1024); LAS unsigned* lbase = lcnt + 32; LAS int* rinfo = (LAS int*)(lcnt + 64);
    const int lane = c.lane;
    {
        const f32x4* wre4 = (const f32x4*)(c.a->in[28] + (size_t)l * 1024 * 32); const f32x4* wrg4 = (const f32x4*)(c.a->in[26] + (size_t)l * 1024 * 4);
        f32x4 wv[18];
#pragma unroll
        for (int i = 0; i < 16; ++i) wv[i] = wre4[c.tid + i * 512];
#pragma unroll
        for (int i = 0; i < 2; ++i) wv[16 + i] = wrg4[c.tid + i * 512];
#pragma unroll
        for (int i = 0; i < 16; ++i) { const int idx = c.tid + i * 512; const int k = idx >> 3, c4 = idx & 7, slot = ((k >> 8) * 4 + (k & 3)) * 64 + ((k >> 2) & 63);
            *(LAS f32x4*)(WE + ((size_t)((c4 >> 1) * 1024 + slot)) * 8 + (c4 & 1) * 4) = wv[i]; }
#pragma unroll
        for (int i = 0; i < 2; ++i) { const int k = c.tid + i * 512; const int slot = ((k >> 8) * 4 + (k & 3)) * 64 + ((k >> 2) & 63); *(LAS f32x4*)(WG + slot * 4) = wv[16 + i]; }
        if (c.tid < 32) lcnt[c.tid] = 0u;
    }
    __syncthreads();
    int nrow = 0;
    const int stride = c.G * 8;
    f32x4 gn4[4], xc[4], shc[4], scc[4];
    {
        const float* gain = c.a->in[5] + (size_t)l * D; const int row0 = c.bid * 8 + c.wave; const int b0 = row0 / TPB, s0 = row0 - b0 * TPB;
        const float* md0 = MOD + ((size_t)l * 9 + (s0 < CTX ? 8 : b0)) * 6144;
#pragma unroll
        for (int j = 0; j < 4; ++j) { const int col = lane * 4 + 256 * j; gn4[j] = *(const f32x4*)(gain + col);
            xc[j] = *(const f32x4*)(X + (size_t)row0 * D + col); shc[j] = *(const f32x4*)(md0 + 3072 + col); scc[j] = *(const f32x4*)(md0 + 4096 + col); }
    }
    for (int row = c.bid * 8 + c.wave; row < MTOK; row += stride) {
        const int b = row / TPB, s = row - b * TPB;
        f32x4 x[4], shv[4], scv[4];
#pragma unroll
        for (int j = 0; j < 4; ++j) { x[j] = xc[j]; shv[j] = shc[j]; scv[j] = scc[j]; }
        {
            const int rn = row + stride < MTOK ? row + stride : row; const int bn = rn / TPB, sn = rn - bn * TPB;
            const float* mdn = MOD + ((size_t)l * 9 + (sn < CTX ? 8 : bn)) * 6144;
#pragma unroll
            for (int j = 0; j < 4; ++j) { const int col = lane * 4 + 256 * j;
                xc[j] = *(const f32x4*)(X + (size_t)rn * D + col); shc[j] = *(const f32x4*)(mdn + 3072 + col); scc[j] = *(const f32x4*)(mdn + 4096 + col); }
        }
        if (l == DEPTH - 1 && s < CTX) continue;
        float ss = 0.f;
#pragma unroll
        for (int j = 0; j < 4; ++j) ss += x[j][0] * x[j][0] + x[j][1] * x[j][1] + x[j][2] * x[j][2] + x[j][3] * x[j][3];
        ss = red64(ss);
        const float inv = rsqrtf(ss * (1.f / 1024.f) + 1e-6f);
        f32x4 hv[4];
#pragma unroll
        for (int j = 0; j < 4; ++j) { const int col = lane * 4 + 256 * j;
            hv[j] = x[j] * inv * gn4[j] * (1.f + scv[j]) + shv[j];
            u32x2 o; o.x = pk2(hv[j][0], hv[j][1]); o.y = pk2(hv[j][2], hv[j][3]); *(u32x2*)(H + (size_t)row * D + col) = o; }
        f32x4 gl4 = {0.f, 0.f, 0.f, 0.f};
#pragma unroll
        for (int j = 0; j < 4; ++j)
#pragma unroll
            for (int e = 0; e < 4; ++e) gl4 += *(const LAS f32x4*)(WG + ((j * 4 + e) * 64 + lane) * 4) * hv[j][e];
        float gl[4];
#pragma unroll
        for (int q = 0; q < 4; ++q) gl[q] = red64(gl4[q]) + brg[q];
        int gs = 0; float gm = gl[0];
#pragma unroll
        for (int q = 1; q < 4; ++q) if (gl[q] > gm) { gm = gl[q]; gs = q; }
        gs = __builtin_amdgcn_readfirstlane(gs);
        const float gw = 1.f / (expf(gl[0] - gm) + expf(gl[1] - gm) + expf(gl[2] - gm) + expf(gl[3] - gm));
        f32x4 e0 = {0.f, 0.f, 0.f, 0.f}, e1 = e0;
        const LAS float* we = WE + ((size_t)gs * 1024 + lane) * 8;
#pragma unroll
        for (int j = 0; j < 4; ++j)
#pragma unroll
            for (int e = 0; e < 4; ++e) { const LAS float* wp = we + (j * 4 + e) * 64 * 8; e0 += *(const LAS f32x4*)wp * hv[j][e]; e1 += *(const LAS f32x4*)(wp + 4) * hv[j][e]; }
        float el[8];
#pragma unroll
        for (int q = 0; q < 4; ++q) { el[q] = red64(e0[q]) + bre[gs * 8 + q]; el[4 + q] = red64(e1[q]) + bre[gs * 8 + 4 + q]; }
        int i0 = 0; float m0 = el[0];
#pragma unroll
        for (int q = 1; q < 8; ++q) if (el[q] > m0) { m0 = el[q]; i0 = q; }
        int i1 = -1; float m1 = -3e38f;
#pragma unroll
        for (int q = 0; q < 8; ++q) if (q != i0 && el[q] > m1) { m1 = el[q]; i1 = q; }
        if (i1 < 0) i1 = (i0 + 1) & 7;
        const float p1 = expf(m1 - m0);
        const float wa = gw / (1.f + p1), wb = gw * p1 / (1.f + p1);
        if (lane == 0) {
            const int ea = gs * 8 + i0, eb = gs * 8 + i1;
            const int ra = (int)__hip_atomic_fetch_add(lcnt + ea, 1u, __ATOMIC_RELAXED, __HIP_MEMORY_SCOPE_WORKGROUP);
            const int rb = (int)__hip_atomic_fetch_add(lcnt + eb, 1u, __ATOMIC_RELAXED, __HIP_MEMORY_SCOPE_WORKGROUP);
            LAS int* ri = rinfo + (c.wave * 16 + nrow) * 8;
            ri[0] = ea; ri[1] = ra; ri[2] = eb; ri[3] = rb; ri[4] = __float_as_int(wa); ri[5] = __float_as_int(wb); ri[6] = row;
        }
        ++nrow;
    }
    __syncthreads();
    if (c.tid < 32) { const unsigned n = lcnt[c.tid]; lbase[c.tid] = n ? atomicAdd(CNT + c.tid, n) : 0u; }
    __syncthreads();
    if (lane < nrow) {
        const LAS int* ri = rinfo + (c.wave * 16 + lane) * 8;
        const int ea = ri[0], eb = ri[2], row = ri[6]; const int pa = (int)lbase[ea] + ri[1], pb = (int)lbase[eb] + ri[3];
        LIST[(size_t)ea * MTOK + pa] = row; LISTW[(size_t)ea * MTOK + pa] = __int_as_float(ri[4]);
        LIST[(size_t)eb * MTOK + pb] = row; LISTW[(size_t)eb * MTOK + pb] = __int_as_float(ri[5]);
        ROUTE[row] = make_int4(ea, pa, eb, pb);
    }
}

constexpr int NPHASE = 2 + 9 * DEPTH;

__global__ void __launch_bounds__(512, 2) mk_fwd(Args a) {
    extern __shared__ __attribute__((aligned(16))) unsigned char lds_raw[];
    Ctx c;
    c.a.in.a = (const __attribute__((address_space(4))) Args*)__builtin_amdgcn_kernarg_segment_ptr(); c.out = (float*)a.out; c.ws = a.ws; c.lds = (LAS unsigned char*)lds_raw;
    const int wave0 = __builtin_amdgcn_readfirstlane((int)threadIdx.x >> 6);
    { int t_; asm volatile("v_mbcnt_lo_u32_b32 %0, -1, 0\n\tv_mbcnt_hi_u32_b32 %0, -1, %0" : "=v"(t_)); c.tid = wave0 * 64 + t_; }
    c.lane = c.tid & 63; c.wave = wave0; c.bid = blockIdx.x; c.G = gridDim.x;
    const int lo = a.lo, hi = a.hi;
    if (c.tid < 4) ((LAS unsigned*)(c.lds + MISC_OFF))[c.tid] = 0u;
    __syncthreads();
    XcdBarrier bar; bar.bar = c.w<unsigned>(WS_CTL); bar.x = 0; bar.st = (volatile LAS unsigned*)(c.lds + MISC_OFF);
    if (hi - lo > 1) bar = xcd_barrier_post(c.w<unsigned>(WS_CTL), (volatile LAS unsigned*)(c.lds + MISC_OFF), (unsigned)c.tid);
#ifndef PH_ONLY
#define PH_ONLY -1
#endif
#define PHON(j) (PH_ONLY < 0 || PH_ONLY == (j))
#define IN(k) (lo <= (k) && (k) < hi)
#define SEAM(k) do { if (IN((k) + 1)) xcd_barrier(bar, (unsigned)c.tid); } while (0)
#define FRESH() do { const __attribute__((address_space(4))) Args* ap_ = (const __attribute__((address_space(4))) Args*)__builtin_amdgcn_kernarg_segment_ptr(); \
        GAS unsigned char* wp_ = ap_->ws; int t_; asm volatile("v_mbcnt_lo_u32_b32 %0, -1, 0\n\tv_mbcnt_hi_u32_b32 %0, -1, %0" : "=v"(t_)); t_ += wave0 * 64; asm volatile("" : "+s"(ap_), "+s"(wp_)); \
        c.a.in.a = ap_; c.out = (float*)ap_->out; c.ws = wp_; c.tid = t_; c.lane = t_ & 63; c.wave = __builtin_amdgcn_readfirstlane(t_ >> 6); } while (0)
#if REP_PHASE >= 0 && REP_PHASE <= 10
#define SITE(j, pidx, ...) if (PHON(j) && IN(pidx)) { int nrep_ = (REP_PHASE == (j)) ? 2 : 1; asm volatile("" : "+s"(nrep_)); \
        for (int rep_ = 0; rep_ < nrep_; ++rep_) { FRESH(); { __VA_ARGS__ } if (rep_ + 1 < nrep_) xcd_barrier(bar, (unsigned)c.tid); } SEAM(pidx); }
#else
#define SITE(j, pidx, ...) if (PHON(j) && IN(pidx)) { FRESH(); { __VA_ARGS__ } SEAM(pidx); }
#endif
    SITE(0, 0, phase_prologue(c);)
#pragma unroll 1
    for (int l = 0; l < DEPTH; ++l) {
        const int p0 = 1 + 9 * l;
        SITE(1, p0 + 0, phase_norm1(c, l);)
        SITE(2, p0 + 1,
            pg8::StaticOrder S; S.init(c.w<bf16_t>(WS_H), c.w<bf16_t>(WS_WIN) + (size_t)l * 4096 * 1024, MTOK, 4096, 1024, c.G, c.bid);
            pg8::EpiBf16Rows E{c.w<bf16_t>(WS_P), PT, PT};
            pg8::gemm_phase(c.lds, c.tid, S, E);)
        SITE(3, p0 + 2, phase_prep(c, l); __syncthreads(); if (REP_PHASE == 31) { FRESH(); phase_prep(c, l); __syncthreads(); }
                        FRESH(); phase_prep_hgrn(c, l); __syncthreads(); if (REP_PHASE == 32) { FRESH(); phase_prep_hgrn(c, l); __syncthreads(); }
                        FRESH(); phase_prep_rwkv(c, l); if (REP_PHASE == 33) { __syncthreads(); FRESH(); phase_prep_rwkv(c, l); }
)
        SITE(4, p0 + 3, phase_mix(c, l);)
        SITE(5, p0 + 4, phase_post(c, l);)
        SITE(6, p0 + 5,
            pg8::StaticOrder S; S.init(c.w<bf16_t>(WS_MIX), c.w<bf16_t>(WS_WOUT) + (size_t)l * 1024 * 1024, MTOK, 1024, 1024, c.G, c.bid, l == DEPTH - 1);
            pg8::EpiX E{c.w<float>(WS_X), c.w<float>(WS_MOD) + (size_t)l * 9 * 6144 + 2048};
            pg8::gemm_phase(c.lds, c.tid, S, E);
            if (l < DEPTH - 1 && c.G == 256 && c.bid >= 32) { __syncthreads();
                for (int j = 0; j < 8; ++j) { const int i = 256 + (c.bid - 32) * 8 + j; cvt_moe_group(c, l, 96 * (i >> 6) + (i & 63)); } })
        SITE(7, p0 + 6, phase_norm2(c, l);)
        SITE(8, p0 + 7,
            build_tpre(c, l);
            pg8::MoeOrder<true> S{(const char*)c.w<bf16_t>(WS_H), (const char*)c.w<bf16_t>(WS_W1), 1024, c.w<int>(WS_LIST), (const LAS int*)(c.lds + MISC_OFF + 64), (const LAS int*)(c.lds + MISC_OFF + 256), c.G, c.bid};
            pg8::EpiHid E{c.w<bf16_t>(WS_HID), c.w<float>(WS_LISTW)};
            pg8::gemm_phase(c.lds, c.tid, S, E);
            {
                unsigned* tk = c.w<unsigned>(WS_CTL) + CW_CVT + l * 64; LAS int* tl = (LAS int*)(c.lds + MISC_OFF + 32);
                for (;;) { __syncthreads();
                    if (c.tid == 0) *tl = (int)__hip_atomic_fetch_add(tk, 1u, __ATOMIC_RELAXED, __HIP_MEMORY_SCOPE_AGENT);
                    __syncthreads();
                    const int j = __builtin_amdgcn_readfirstlane(*tl); if (j >= 1024) break;
                    cvt_moe_group(c, l, 96 * (j >> 5) + 64 + (j & 31)); } })
        SITE(9, p0 + 8,
            build_tpre(c, l);
            pg8::MoeOrder<false> S{(const char*)c.w<bf16_t>(WS_HID), (const char*)c.w<bf16_t>(WS_W2), 512, c.w<int>(WS_LIST), (const LAS int*)(c.lds + MISC_OFF + 64), (const LAS int*)(c.lds + MISC_OFF + 256), c.G, c.bid};
            pg8::EpiBf16Rows E{c.w<bf16_t>(WS_Y), 1024, 1024};
            pg8::gemm_phase(c.lds, c.tid, S, E);)
    }
    SITE(10, NPHASE - 1, phase_norm1(c, DEPTH);)
#undef SITE
#undef IN
#undef SEAM
}

extern "C" void kernel_launch(void* const* d_in, const int* in_sizes, int n_in, void* d_out, int out_size, void* d_ws, size_t ws_size, hipStream_t stream) {
    static int grid = 0;
    if (grid == 0) {
        if (n_in != 33 || ws_size < WS_END) { fprintf(stderr, "kernel_launch: unexpected n_in %d / ws %zu (need %zu)\n", n_in, ws_size, (size_t)WS_END); grid = -1; return; }
        int dev = 0, cus = 0, per_cu = 0;
        hipGetDevice(&dev); hipDeviceGetAttribute(&cus, hipDeviceAttributeMultiprocessorCount, dev);
        if (hipFuncSetAttribute((const void*)mk_fwd, hipFuncAttributeMaxDynamicSharedMemorySize, LDS_BYTES) != hipSuccess) { fprintf(stderr, "kernel_launch: hipFuncSetAttribute failed\n"); grid = -1; return; }
        hipOccupancyMaxActiveBlocksPerMultiprocessor(&per_cu, (const void*)mk_fwd, 512, LDS_BYTES);
        (void)hipGetLastError();
        if (per_cu < 1) fprintf(stderr, "kernel_launch: occupancy query reports %d\n", per_cu);
        grid = cus > 0 ? cus : 256;
    }
    if (grid < 0) return;
    hipMemsetAsync((char*)d_ws + WS_CTL, 0, CTL_BYTES, stream);
    Args a{};
    for (int i = 0; i < 33; ++i) a.in.p[i] = (const GAS float*)d_in[i];
    a.out = (GAS float*)d_out; a.ws = (GAS unsigned char*)d_ws;
#if MK_SPLIT
    for (int p = 0; p < NPHASE; ++p) { a.lo = p; a.hi = p + 1; hipLaunchKernelGGL(mk_fwd, dim3(grid), dim3(512), LDS_BYTES, stream, a); }
#else
    a.lo = 0; a.hi = NPHASE; hipLaunchKernelGGL(mk_fwd, dim3(grid), dim3(512), LDS_BYTES, stream, a);
#endif
}
```

```cpp
#include <hip/hip_runtime.h>
#include <cstdio>
#include <cstdint>

#ifndef MK_SPLIT
#define MK_SPLIT 0
#endif

#ifndef REP_PHASE
#define REP_PHASE -1
#endif

#define LAS __attribute__((address_space(3)))
typedef unsigned short bf16_t;
typedef short  bf16x8 __attribute__((ext_vector_type(8)));
typedef short  bf16x4 __attribute__((ext_vector_type(4)));
typedef float  f32x4  __attribute__((ext_vector_type(4)));
typedef unsigned u32x4 __attribute__((ext_vector_type(4)));
typedef unsigned u32x2 __attribute__((ext_vector_type(2)));

constexpr int D = 1024, NB = 8, SEQ = 2048, CTX = 256, TPB = 2304, MTOK = NB * TPB, DEPTH = 4, PT = 3968;
constexpr int NEXP = 32, DF = 512, HIDROWS = 45056;
constexpr int NBLK16 = TPB / 16;
constexpr int PA_Q = 0, PA_FF = 256, PA_FB = 512, PA_I = 768, PA_G = 1024, PB0 = 1280, PC_Q = 2432, PC_K = 2944, PC_V = 3456;

constexpr size_t WS_CTL = 0, CTL_BYTES = 65536;
constexpr size_t WS_MOD = 65536;
constexpr size_t WS_LB = WS_MOD + 884736;
constexpr size_t WS_ROPE = WS_LB + 8192;
constexpr size_t WS_LORA = WS_ROPE + 8192;
constexpr size_t LORA_L = 196608;
constexpr size_t WS_ROUTE = WS_LORA + 4 * LORA_L;
constexpr size_t WS_LIST = WS_ROUTE + 294912;
constexpr size_t WS_LISTW = WS_LIST + 2359296;
constexpr size_t WS_WIN = 8388608;
constexpr size_t WS_WOUT = WS_WIN + 33554432;
constexpr size_t WS_W1 = WS_WOUT + 8388608;
constexpr size_t WS_W2 = WS_W1 + 67108864;
constexpr size_t WS_X = WS_W2 + 33554432;
constexpr size_t WS_H = WS_X + 75497472;
constexpr size_t WS_MIX = WS_H + 37748736;
constexpr size_t WS_P = WS_MIX + 37748736;
constexpr size_t WS_MR = WS_P + 146276352;
constexpr size_t SZ_T512 = 18874368;
constexpr size_t WS_QN = WS_MR, WS_KN = WS_QN + SZ_T512, WS_VT = WS_KN + SZ_T512;
constexpr size_t WS_QIN = WS_VT + SZ_T512;
constexpr size_t WS_KOT = WS_QIN + SZ_T512;
constexpr size_t WS_IT = WS_KOT + SZ_T512;
constexpr size_t WS_DEC = WS_IT + 9437184;
constexpr size_t WS_O1 = WS_DEC + 2359296;
constexpr size_t WS_O2 = WS_O1 + SZ_T512;
constexpr size_t WS_RW = WS_O2 + 2 * SZ_T512;
constexpr size_t WS_G = WS_RW + 226492416;
constexpr size_t WS_BON = WS_G + SZ_T512;
constexpr size_t WS_YS = WS_BON + SZ_T512;
constexpr size_t WS_END = WS_YS + 2 * SZ_T512;
constexpr size_t WS_Y = WS_P, WS_HID = WS_MR;
constexpr size_t WS_KHT = WS_W1;
constexpr size_t WS_AHT = WS_KHT + 18874368;
constexpr size_t WS_GC = WS_AHT + 18874368;
constexpr size_t WS_RH = WS_W1 + 75497472;
constexpr size_t WS_WY = WS_RH + 18874368;
constexpr size_t WS_ZT = WS_H;
constexpr size_t WS_VT2 = WS_H + 18874368;
static_assert(WS_WY + 4718592 <= WS_X, "chunk buffers");
static_assert(WS_END < (size_t)1000 * 1000 * 1000, "workspace");
constexpr int CW_CNT = 4096;
constexpr int CW_CVT = 12288;
constexpr int CW_ATT = 8192;

constexpr int LDS_BYTES = 163840, MISC_OFF = 131072;

#define XB_TMO      128
#define XB_XCNT(j)  (256  + 64 * (j))
#define XB_XSUB(j)  (1280 + 64 * (j))
#define XB_XGEN(j)  (2304 + 64 * (j))
#define XB_TOP      3328
#define XB_TOPGEN   3392
#define XCD_BAR_WORDS 3456
#define XB_SPIN_CAP (1u << 18)
__device__ __forceinline__ unsigned xb_ld(unsigned* p)              { return __hip_atomic_load(p, __ATOMIC_RELAXED, __HIP_MEMORY_SCOPE_AGENT); }
__device__ __forceinline__ unsigned xb_add(unsigned* p, unsigned v) { return __hip_atomic_fetch_add(p, v, __ATOMIC_RELAXED, __HIP_MEMORY_SCOPE_AGENT); }
__device__ __forceinline__ unsigned xb_xcc_id() { return (unsigned)__builtin_amdgcn_s_getreg((3 << 11) | 20) & 0xFu; }
#define XB_SPIN(cond, bar) do { unsigned _sp = 0; while (cond) { __builtin_amdgcn_s_sleep(1); \
    if ((++_sp & 255u) == 0u) { if (xb_ld(&(bar)[XB_TMO])) break; if (_sp > XB_SPIN_CAP) { atomicAdd(&(bar)[XB_TMO], 1u); break; } } } } while (0)
struct XcdBarrier { unsigned* bar; unsigned x; volatile LAS unsigned* st; };
__device__ __forceinline__ XcdBarrier xcd_barrier_post(unsigned* bar, volatile LAS unsigned* st, const unsigned tidx) {
    XcdBarrier b; b.bar = bar; b.x = xb_xcc_id(); b.st = st;
    if (tidx == 0) (void)xb_add(&bar[XB_XCNT(b.x)], 1u);
    return b;
}
__device__ __forceinline__ void xcd_barrier_complete(unsigned* bar, unsigned x, unsigned& nloc, unsigned& nx) {
    const unsigned G = gridDim.x * gridDim.y * gridDim.z;
    unsigned sum, cnt, mine, sp = 0u;
    for (;;) {
        sum = 0u; cnt = 0u; mine = 0u;
#pragma unroll
        for (unsigned j = 0; j < 16; ++j) { const unsigned c = xb_ld(&bar[XB_XCNT(j)]); sum += c; cnt += (c > 0u) ? 1u : 0u; mine = (j == x) ? c : mine; }
        if (sum == G) break;
        __builtin_amdgcn_s_sleep(1);
        if ((++sp & 255u) == 0u) { if (xb_ld(&bar[XB_TMO])) break; if (sp > XB_SPIN_CAP) { atomicAdd(&bar[XB_TMO], 1u); break; } }
    }
    nloc = mine > 0u ? mine : 1u; nx = cnt > 0u ? cnt : 1u;
}
__device__ __forceinline__ void xcd_barrier(const XcdBarrier& b, const unsigned tidx) {
    asm volatile("s_waitcnt vmcnt(0)" ::: "memory");
    __syncthreads();
    if (tidx == 0) {
        unsigned* bar = b.bar;
        __builtin_amdgcn_s_waitcnt(0);
        unsigned nloc = b.st[0], nx = b.st[1];
        if (nloc == 0u) { xcd_barrier_complete(bar, b.x, nloc, nx); b.st[0] = nloc; b.st[1] = nx; }
        const unsigned old = xb_add(&bar[XB_XSUB(b.x)], 1u);
        const unsigned gen = old / nloc;
        if (old + 1u == (gen + 1u) * nloc) {
            __builtin_amdgcn_fence(__ATOMIC_RELEASE, "agent");
            asm volatile("s_waitcnt vmcnt(0)" ::: "memory");
            const unsigned og = xb_add(&bar[XB_TOP], 1u);
            const unsigned tg = og / nx;
            if (og + 1u == (tg + 1u) * nx) xb_add(&bar[XB_TOPGEN], 1u);
            else XB_SPIN(xb_ld(&bar[XB_TOPGEN]) == tg, bar);
            __builtin_amdgcn_fence(__ATOMIC_ACQUIRE, "agent");
            xb_add(&bar[XB_XGEN(b.x)], 1u);
            asm volatile("s_waitcnt vmcnt(0)" ::: "memory");
        } else {
            XB_SPIN(xb_ld(&bar[XB_XGEN(b.x)]) == gen, bar);
            __builtin_amdgcn_fence(__ATOMIC_ACQUIRE, "agent");
            asm volatile("s_waitcnt vmcnt(0)" ::: "memory");
        }
    }
    __syncthreads();
}

__device__ __forceinline__ float bf2f(bf16_t b) { return __uint_as_float(((unsigned)b) << 16); }
__device__ __forceinline__ float bflo(unsigned u) { return __uint_as_float(u << 16); }
__device__ __forceinline__ float bfhi(unsigned u) { return __uint_as_float(u & 0xffff0000u); }
typedef float f32x2c __attribute__((ext_vector_type(2)));
typedef __bf16 bf16x2c __attribute__((ext_vector_type(2)));
__device__ __forceinline__ unsigned pk2(float lo, float hi) { const f32x2c v = {lo, hi}; const bf16x2c b = __builtin_convertvector(v, bf16x2c); return __builtin_bit_cast(unsigned, b); }
__device__ __forceinline__ unsigned pk2m(float lo, float hi) { return pk2(lo, hi); }
__device__ __forceinline__ bf16_t f2bf(float f) { return (bf16_t)pk2(f, f); }
__device__ __forceinline__ float sigm(float x) { return 1.f / (1.f + __expf(-x)); }
template <int CTRL> __device__ __forceinline__ float dppf(float x) { return __int_as_float(__builtin_amdgcn_update_dpp(0, __float_as_int(x), CTRL, 0xF, 0xF, true)); }
__device__ __forceinline__ float red4(float x) { x += dppf<0xB1>(x); x += dppf<0x4E>(x); return x; }
__device__ __forceinline__ float red8(float x) { x = red4(x); x += dppf<0x141>(x); return x; }
__device__ __forceinline__ float red16(float x) { x = red8(x); x += dppf<0x140>(x); return x; }
__device__ __forceinline__ int lane_now() { int t; asm volatile("v_mbcnt_lo_u32_b32 %0, -1, 0\n\tv_mbcnt_hi_u32_b32 %0, -1, %0" : "=v"(t)); return t; }
__device__ __forceinline__ float shx(float x, int m) { return __int_as_float(__builtin_amdgcn_ds_bpermute((lane_now() ^ m) << 2, __float_as_int(x))); }
__device__ __forceinline__ float shidx(float x, int idx) { return __int_as_float(__builtin_amdgcn_ds_bpermute(idx << 2, __float_as_int(x))); }
__device__ __forceinline__ float red64(float x) { x = red16(x); x += shx(x, 16); x += shx(x, 32); return x; }

#if defined(__HIP_DEVICE_COMPILE__)
#define GAS __attribute__((address_space(1)))
#else
#define GAS
#endif
struct InPtrs { const GAS float* p[33]; };
struct Args { InPtrs in; GAS float* out; GAS unsigned char* ws; int lo, hi; };
struct InView {
    const __attribute__((address_space(4))) Args* a;
    __device__ __forceinline__ const float* operator[](int i) const { return (const float*)a->in.p[i]; }
};
struct ArgView { InView in; __device__ __forceinline__ const ArgView* operator->() const { return this; } };
#define MEMBAR() asm volatile("" ::: "memory")
struct Ctx {
    ArgView a; float* out; GAS unsigned char* ws; LAS unsigned char* lds;
    int tid, lane, wave, bid, G;
    template <class T> __device__ __forceinline__ T* w(size_t off) const { return (T*)(ws + off); }
};

namespace pg8 {
constexpr int MISC_OFF = 131072; constexpr int BM = 256, BK = 64, HALF = 128, HTB = HALF * BK * 2, STAGE_BYTES = 8 * HTB, NXCD = 8, WGM = 8;
__device__ __forceinline__ int lds_byte(int r, int c) { const int st = (r >> 4) * 2 + (c >> 5), rr = r & 15, cc = c & 31, ob = rr * 64 + cc * 2; return st * 1024 + (ob ^ (((ob >> 9) & 1) << 5)); }
__device__ __forceinline__ void stage_rc(int b, int& R, int& C) { const int st = b / 1024, sb = b % 1024, swz = sb ^ (((sb >> 9) & 1) << 5); R = (st >> 1) * 16 + swz / 64; C = (st & 1) * 32 + (swz % 64) / 2; }
__device__ __forceinline__ int perm32(int rho) { const int n = rho >> 4, i = rho & 15; return 8 * (i >> 2) + 4 * n + (i & 3); }
struct Unit { int pm, pn, e, mt, cnt; };

struct StaticOrder {
    static constexpr bool GATHER_A = false;
    const char* A; const char* Bt; int K; int nM, nN, nwg, G, c; bool skip_ctx;
    __device__ __forceinline__ void init(const void* A_, const void* Bt_, int M, int N, int K_, int G_, int c_, bool skip_ctx_ = false) { A = (const char*)A_; Bt = (const char*)Bt_; K = K_; skip_ctx = skip_ctx_; nM = skip_ctx_ ? 64 : M / BM; nN = N / BM; nwg = nM * nN; G = G_; c = c_; }
    __device__ __forceinline__ bool next(int i, Unit& u) const {
        const long L = (long)i * G + c; if (L >= nwg) return false;
        int wgid = (int)L; { const int q = nwg / NXCD, r = nwg % NXCD, xcd = wgid % NXCD, off = wgid / NXCD; wgid = (xcd < r ? xcd * (q + 1) : r * (q + 1) + (xcd - r) * q) + off; }
        const int nig = WGM * nN, gid = wgid / nig, fm = gid * WGM, gsz = (nM - fm) < WGM ? (nM - fm) : WGM;
        u.pm = fm + ((wgid % nig) % gsz); u.pn = (wgid % nig) / gsz; u.e = 0; u.mt = 0; u.cnt = 0;
        if (skip_ctx) u.pm = u.pm + (u.pm >> 3) + 1;
        return true;
    }
    __device__ __forceinline__ const char* a_base(const Unit& u) const { return A + (size_t)u.pm * BM * K * 2; }
    __device__ __forceinline__ const char* b_base(const Unit& u) const { return Bt + (size_t)u.pn * BM * K * 2; }
    __device__ __forceinline__ void a_offs(const Unit&, int tid, unsigned (&vo)[2][2]) const {
#pragma unroll
        for (int i = 0; i < 2; ++i) { int R, C; stage_rc(tid * 16 + i * 8192, R, C);
#pragma unroll
            for (int h = 0; h < 2; ++h) vo[h][i] = (unsigned)((h * HALF + R) * K + C) * 2u; }
    }
};
template <bool GATHER> struct MoeOrder {
    static constexpr bool GATHER_A = GATHER;
    const char* A; const char* Bt; int K; const int* list; const LAS int* tp; const LAS int* cn; int G, c;
    __device__ __forceinline__ bool next(int i, Unit& u) const {
        if ((G & 7) == 0) {
            const int xcd = c & 7; int j = i * (G >> 3) + (c >> 3);
#pragma unroll 1
            for (int q = 0; q < 4; ++q) { const int e = xcd + 8 * q; const int t0 = __builtin_amdgcn_readfirstlane(tp[e]), t1 = __builtin_amdgcn_readfirstlane(tp[e + 1]); const int nu = 4 * (t1 - t0);
                if (j < nu) { u.e = e; u.mt = j >> 2; u.pn = j & 3; u.pm = t0 + u.mt; u.cnt = __builtin_amdgcn_readfirstlane(cn[e]); return true; }
                j -= nu; }
            return false;
        }
        const int L = i * G + c; if (L >= 4 * __builtin_amdgcn_readfirstlane(tp[32])) return false;
        const int tile = L >> 2; u.pn = L & 3; u.pm = tile;
        int e = 0;
#pragma unroll 1
        for (; e < 31; ++e) if (tile < __builtin_amdgcn_readfirstlane(tp[e + 1])) break;
        u.e = e; u.mt = tile - __builtin_amdgcn_readfirstlane(tp[e]); u.cnt = __builtin_amdgcn_readfirstlane(cn[e]); return true;
    }
    __device__ __forceinline__ const char* a_base(const Unit& u) const { return GATHER ? A : A + (size_t)u.pm * BM * K * 2; }
    __device__ __forceinline__ const char* b_base(const Unit& u) const { return Bt + ((size_t)u.e * 1024 + (size_t)u.pn * BM) * K * 2; }
    __device__ __forceinline__ void a_offs(const Unit& u, int tid, unsigned (&vo)[2][2]) const {
#pragma unroll
        for (int i = 0; i < 2; ++i) { int R, C; stage_rc(tid * 16 + i * 8192, R, C);
#pragma unroll
            for (int h = 0; h < 2; ++h) {
                int row = h * HALF + R;
                if (GATHER) { const int idx = u.mt * BM + row; row = idx < u.cnt ? list[(size_t)u.e * MTOK + idx] : 0; }
                vo[h][i] = (unsigned)(row * K + C) * 2u;
            } }
    }
};

struct EpiBf16Rows {
    static constexpr bool PERM = true;
    bf16_t* O; int ldc; int ncols;
    __device__ __forceinline__ void operator()(const f32x4 (&acc)[2][2][4][2], const Unit& u, int wr, int wc, int fr, int fq) const {
        const int row0 = u.pm * BM + wr * 64 + fr, col0 = u.pn * BM + wc * 32 + 8 * fq;
#pragma unroll
        for (int ai = 0; ai < 2; ++ai)
#pragma unroll
            for (int m = 0; m < 4; ++m) { bf16_t* rowp = O + (size_t)(row0 + ai * HALF + m * 16) * ldc + col0;
#pragma unroll
                for (int bj = 0; bj < 2; ++bj) { if (u.pn * BM + bj * HALF >= ncols) continue;
                    const f32x4 v0 = acc[ai][bj][m][0], v1 = acc[ai][bj][m][1];
                    u32x4 w; w.x = pk2(v0[0], v0[1]); w.y = pk2(v0[2], v0[3]); w.z = pk2(v1[0], v1[1]); w.w = pk2(v1[2], v1[3]);
                    *(u32x4*)(rowp + bj * HALF) = w; } }
    }
};
struct EpiX {
    static constexpr bool PERM = false;
    float* X; const float* gate;
    __device__ __forceinline__ void operator()(const f32x4 (&acc)[2][2][4][2], const Unit& u, int wr, int wc, int fr, int fq) const {
        const int row0 = u.pm * BM + wr * 64 + fr, col0 = u.pn * BM + wc * 32 + 4 * fq;
        const int bb = u.pm / 9, mrow = (u.pm - bb * 9 == 0) ? 8 : bb;
        const float* g = gate + (size_t)mrow * 6144 + col0;
        f32x4 gv[2][2];
#pragma unroll
        for (int bj = 0; bj < 2; ++bj)
#pragma unroll
            for (int n = 0; n < 2; ++n) gv[bj][n] = *(const f32x4*)(g + bj * HALF + n * 16);
#pragma unroll
        for (int ai = 0; ai < 2; ++ai)
#pragma unroll
            for (int m = 0; m < 4; ++m) { float* rowp = X + (size_t)(row0 + ai * HALF + m * 16) * D + col0;
#pragma unroll
                for (int bj = 0; bj < 2; ++bj)
#pragma unroll
                    for (int n = 0; n < 2; ++n) { f32x4* p = (f32x4*)(rowp + bj * HALF + n * 16); *p = *p + gv[bj][n] * acc[ai][bj][m][n]; } }
    }
};
struct EpiHid {
    static constexpr bool PERM = true;
    bf16_t* O; const float* listw;
    __device__ __forceinline__ void operator()(const f32x4 (&acc)[2][2][4][2], const Unit& u, int wr, int wc, int fr, int fq) const {
        const int col0 = u.pn * HALF + wc * 32 + 8 * fq;
#pragma unroll
        for (int ai = 0; ai < 2; ++ai)
#pragma unroll
            for (int m = 0; m < 4; ++m) {
                const int r = ai * HALF + wr * 64 + m * 16 + fr, idx = u.mt * BM + r;
                const float w = idx < u.cnt ? listw[(size_t)u.e * MTOK + idx] : 0.f;
                const f32x4 g0 = acc[ai][0][m][0], g1 = acc[ai][0][m][1], u0 = acc[ai][1][m][0], u1 = acc[ai][1][m][1];
                float h[8];
#pragma unroll
                for (int j = 0; j < 4; ++j) { h[j] = g0[j] * sigm(g0[j]) * u0[j] * w; h[4 + j] = g1[j] * sigm(g1[j]) * u1[j] * w; }
                u32x4 o; o.x = pk2(h[0], h[1]); o.y = pk2(h[2], h[3]); o.z = pk2(h[4], h[5]); o.w = pk2(h[6], h[7]);
                *(u32x4*)(O + (size_t)(u.pm * BM + r) * DF + col0) = o;
                asm volatile("" ::: "memory"); }
    }
};

template <class Epi, class Sched>
__device__ __forceinline__ void gemm_phase(LAS unsigned char* lds, const int tid, const Sched& S, const Epi& E) {
    const int wid = __builtin_amdgcn_readfirstlane(tid >> 6), lane = tid & 63, wr = wid >> 2, wc = wid & 3, fr = lane & 15, fq = lane >> 4;
    const int K = S.K, nt = K / BK;
    unsigned voffB[2];
#pragma unroll
    for (int i = 0; i < 2; ++i) { int Rr, Cc; stage_rc(tid * 16 + i * 8192, Rr, Cc); const int Rb = Epi::PERM ? ((Rr & ~31) + perm32(Rr & 31)) : Rr; voffB[i] = (unsigned)(Rb * K + Cc) * 2u; }
    const size_t kstep = (size_t)(BK * 2);
    const size_t hstep = (size_t)HALF * K * 2;
    const unsigned ldsw = (unsigned)wid * 1024u;
    const int aoff = lds_byte(wr * 64 + fr, fq * 8), boff = lds_byte(wc * 32 + fr, fq * 8);
#define PG8_SA(b, h) (((b) * 2 + (h)) * HTB)
#define PG8_SB(b, h) ((4 + (b) * 2 + (h)) * HTB)
#define PG8_STAGE2(bufoff, gbase, o0, o1) do { \
        __builtin_amdgcn_global_load_lds((const unsigned*)((const char*)(gbase) + (o0)), (LAS unsigned*)(lds + (bufoff) + ldsw), 16, 0, 0); \
        __builtin_amdgcn_global_load_lds((const unsigned*)((const char*)(gbase) + (o1)), (LAS unsigned*)(lds + (bufoff) + ldsw + 8192), 16, 0, 0); } while (0)
#define PG8_STAGEB(bufoff, gbase) PG8_STAGE2(bufoff, gbase, voffB[0], voffB[1])
#define PG8_LDA(dst, b, h) do { _Pragma("unroll") for (int m = 0; m < 4; ++m) _Pragma("unroll") for (int k = 0; k < 2; ++k) dst[m][k] = *(const LAS bf16x8*)(lds + PG8_SA(b, h) + aoff + m * 2048 + k * 1024); } while (0)
#define PG8_LDB(dst, b, h) do { _Pragma("unroll") for (int n = 0; n < 2; ++n) _Pragma("unroll") for (int k = 0; k < 2; ++k) dst[n][k] = *(const LAS bf16x8*)(lds + PG8_SB(b, h) + boff + n * 2048 + k * 1024); } while (0)
#define PG8_MMA(ai, bj, At, Bt) do { __builtin_amdgcn_s_setprio(1); _Pragma("unroll") for (int m = 0; m < 4; ++m) _Pragma("unroll") for (int n = 0; n < 2; ++n) _Pragma("unroll") for (int k = 0; k < 2; ++k) \
        acc[ai][bj][m][n] = __builtin_amdgcn_mfma_f32_16x16x32_bf16(Bt[n][k], At[m][k], acc[ai][bj][m][n], 0, 0, 0); __builtin_amdgcn_s_setprio(0); } while (0)
#define PG8_WAIT_V(n) asm volatile("s_waitcnt vmcnt(" #n ")" ::: "memory")
#define PG8_WAIT_L(n) asm volatile("s_waitcnt lgkmcnt(" #n ")" ::: "memory")
#define PG8_BAR __builtin_amdgcn_s_barrier()
#define PG8_SCHED __builtin_amdgcn_sched_barrier(0)
    Unit cur, nxt; int ui = 0;
    if (!S.next(0, cur)) return;
    f32x4 acc[2][2][4][2];
#pragma unroll
    for (int a = 0; a < 2; ++a)
#pragma unroll
        for (int b = 0; b < 2; ++b)
#pragma unroll
            for (int m = 0; m < 4; ++m)
#pragma unroll
                for (int n = 0; n < 2; ++n) acc[a][b][m][n] = (f32x4){0.f, 0.f, 0.f, 0.f};
    bf16x8 At[4][2], B0[2][2], B1[2][2];
    unsigned vo[2][2];
    LAS u32x4* stash = (LAS u32x4*)(lds + MISC_OFF + 1024) + tid;
    S.a_offs(cur, tid, vo);
    const char* cA = S.a_base(cur); const char* cB = S.b_base(cur);
    PG8_STAGEB(PG8_SB(0, 0), cB); PG8_STAGE2(PG8_SA(0, 0), cA, vo[0][0], vo[0][1]); PG8_STAGEB(PG8_SB(0, 1), cB + hstep); PG8_STAGE2(PG8_SA(0, 1), cA, vo[1][0], vo[1][1]);
    if (wr == 1) PG8_BAR;
    PG8_WAIT_V(4); PG8_BAR;
    PG8_STAGEB(PG8_SB(1, 0), cB + kstep); PG8_STAGE2(PG8_SA(1, 0), cA + kstep, vo[0][0], vo[0][1]); PG8_STAGEB(PG8_SB(1, 1), cB + hstep + kstep);
    PG8_WAIT_V(6); PG8_BAR;
    for (;;) {
        const bool has_next = S.next(ui + 1, nxt);
        const char* nA = cA; const char* nB = cB;
        if (has_next) { nA = S.a_base(nxt); nB = S.b_base(nxt); }
        if constexpr (Sched::GATHER_A) { unsigned nvo[2][2];
            if (has_next) S.a_offs(nxt, tid, nvo); else { nvo[0][0] = vo[0][0]; nvo[0][1] = vo[0][1]; nvo[1][0] = vo[1][0]; nvo[1][1] = vo[1][1]; }
            *stash = (u32x4){nvo[0][0], nvo[0][1], nvo[1][0], nvo[1][1]}; }
        for (int t = 0; t < nt; t += 2) {
            const bool last = (t == nt - 2);
            const char* a1 = cA + (size_t)(t + 1) * kstep;
            const char* a2 = last ? nA : cA + (size_t)(t + 2) * kstep; const char* b2 = last ? nB : cB + (size_t)(t + 2) * kstep;
            const char* a3 = a2 + kstep; const char* b3 = b2 + kstep;
            unsigned s00 = vo[0][0], s01 = vo[0][1], s10 = vo[1][0], s11 = vo[1][1];
            if constexpr (Sched::GATHER_A) { if (last) { const u32x4 nv = *stash; s00 = nv.x; s01 = nv.y; s10 = nv.z; s11 = nv.w; } }
            PG8_LDB(B0, 0, 0); PG8_SCHED; PG8_LDA(At, 0, 0); PG8_STAGE2(PG8_SA(1, 1), a1, vo[1][0], vo[1][1]);
            PG8_WAIT_L(8); PG8_BAR; PG8_WAIT_L(0); PG8_MMA(0, 0, At, B0); PG8_BAR; PG8_SCHED;
            PG8_LDB(B1, 0, 1); PG8_STAGEB(PG8_SB(0, 0), b2);
            PG8_BAR; PG8_WAIT_L(0); PG8_MMA(0, 1, At, B1); PG8_BAR;
            PG8_LDA(At, 0, 1); PG8_STAGE2(PG8_SA(0, 0), a2, s00, s01);
            PG8_BAR; PG8_WAIT_L(0); PG8_MMA(1, 0, At, B0); PG8_BAR; PG8_SCHED;
            PG8_STAGEB(PG8_SB(0, 1), b2 + hstep);
            PG8_WAIT_V(6); PG8_BAR; PG8_MMA(1, 1, At, B1); PG8_BAR;
            PG8_LDB(B0, 1, 0); PG8_SCHED; PG8_LDA(At, 1, 0); PG8_STAGE2(PG8_SA(0, 1), a2, s10, s11);
            PG8_WAIT_L(8); PG8_BAR; PG8_WAIT_L(0); PG8_MMA(0, 0, At, B0); PG8_BAR; PG8_SCHED;
            PG8_LDB(B1, 1, 1); PG8_STAGEB(PG8_SB(1, 0), b3);
            PG8_BAR; PG8_WAIT_L(0); PG8_MMA(0, 1, At, B1); PG8_BAR;
            PG8_LDA(At, 1, 1); PG8_STAGE2(PG8_SA(1, 0), a3, s00, s01);
            PG8_BAR; PG8_WAIT_L(0); PG8_MMA(1, 0, At, B0); PG8_BAR; PG8_SCHED;
            PG8_STAGEB(PG8_SB(1, 1), b3 + hstep);
            PG8_WAIT_V(6); PG8_BAR; PG8_MMA(1, 1, At, B1); PG8_BAR;
        }
        E(acc, cur, wr, wc, fr, fq);
        if (!has_next) break;
#pragma unroll
        for (int a = 0; a < 2; ++a)
#pragma unroll
            for (int b = 0; b < 2; ++b)
#pragma unroll
                for (int m = 0; m < 4; ++m)
#pragma unroll
                    for (int n = 0; n < 2; ++n) acc[a][b][m][n] = (f32x4){0.f, 0.f, 0.f, 0.f};
        cur = nxt; cA = nA; cB = nB; ++ui;
        if constexpr (Sched::GATHER_A) { const u32x4 nv = *stash; vo[0][0] = nv.x; vo[0][1] = nv.y; vo[1][0] = nv.z; vo[1][1] = nv.w; }
    }
    PG8_WAIT_V(0);
    if (wr == 0) PG8_BAR;
    PG8_BAR;
#undef PG8_SA
#undef PG8_SB
#undef PG8_STAGE2
#undef PG8_STAGEB
#undef PG8_LDA
#undef PG8_LDB
#undef PG8_MMA
#undef PG8_WAIT_V
#undef PG8_WAIT_L
#undef PG8_BAR
#undef PG8_SCHED
}
}

__device__ __forceinline__ void cvt_tile(const Ctx& c, LAS float* T, const float* src, int src_ld, bf16_t* dst, int dst_ld) {
    const int ty = c.tid >> 4, tx = c.tid & 15;
#pragma unroll
    for (int i = 0; i < 2; ++i) { const int k = ty + 32 * i; const float4 v = *(const float4*)(src + (size_t)k * src_ld + tx * 4);
        T[k * 65 + tx * 4 + 0] = v.x; T[k * 65 + tx * 4 + 1] = v.y; T[k * 65 + tx * 4 + 2] = v.z; T[k * 65 + tx * 4 + 3] = v.w; }
    __syncthreads();
    const int tn = c.tid >> 3, tk = c.tid & 7;
    float v[8];
#pragma unroll
    for (int j = 0; j < 8; ++j) v[j] = T[(tk * 8 + j) * 65 + tn];
    u32x4 o; o.x = pk2(v[0], v[1]); o.y = pk2(v[2], v[3]); o.z = pk2(v[4], v[5]); o.w = pk2(v[6], v[7]);
    *(u32x4*)(dst + (size_t)tn * dst_ld + tk * 8) = o;
    __syncthreads();
}

struct CvtJob { const float* src; bf16_t* dst; int src_ld, dst_ld; };
__device__ __forceinline__ void cvt_tile4(const Ctx& c, LAS float* T, const CvtJob (&jb)[4]) {
    const int ty = c.tid >> 4, tx = c.tid & 15;
    float4 v[4][2];
#pragma unroll
    for (int q = 0; q < 4; ++q)
#pragma unroll
        for (int i = 0; i < 2; ++i) v[q][i] = *(const float4*)(jb[q].src + (size_t)(ty + 32 * i) * jb[q].src_ld + tx * 4);
#pragma unroll
    for (int q = 0; q < 4; ++q)
#pragma unroll
        for (int i = 0; i < 2; ++i) { LAS float* t = T + q * 4160 + (ty + 32 * i) * 65 + tx * 4; t[0] = v[q][i].x; t[1] = v[q][i].y; t[2] = v[q][i].z; t[3] = v[q][i].w; }
    __syncthreads();
    const int tn = c.tid >> 3, tk = c.tid & 7;
#pragma unroll
    for (int q = 0; q < 4; ++q) {
        float w[8];
#pragma unroll
        for (int j = 0; j < 8; ++j) w[j] = T[q * 4160 + (tk * 8 + j) * 65 + tn];
        u32x4 o; o.x = pk2(w[0], w[1]); o.y = pk2(w[2], w[3]); o.z = pk2(w[4], w[5]); o.w = pk2(w[6], w[7]);
        *(u32x4*)(jb[q].dst + (size_t)tn * jb[q].dst_ld + tk * 8) = o;
    }
    __syncthreads();
}

__device__ __forceinline__ void phase_prologue(const Ctx& c) {
    {
        LAS float* Ssm = (LAS float*)c.lds; LAS float* red = Ssm + 9 * 1024;
        for (int i = c.tid; i < 9 * 1024; i += 512) { const int r = i >> 10, k = i & 1023; const float v = r < 8 ? c.a->in[1][r * 1024 + k] : c.a->in[3][k]; Ssm[i] = v * sigm(v); }
        __syncthreads();
        float* MOD = c.w<float>(WS_MOD);
        for (int task = c.bid; task < 384; task += c.G) {
            const int l = task / 96, c0 = (task % 96) * 64, kg = c.tid >> 6, col = c.tid & 63;
            const float* wp = c.a->in[6] + ((size_t)l * 1024 + kg * 128) * 6144 + c0 + col;
            float acc[9];
#pragma unroll
            for (int r = 0; r < 9; ++r) acc[r] = 0.f;
#pragma unroll 4
            for (int k = 0; k < 128; ++k) { const float wv = wp[(size_t)k * 6144];
#pragma unroll
                for (int r = 0; r < 9; ++r) acc[r] += Ssm[r * 1024 + kg * 128 + k] * wv; }
#pragma unroll
            for (int r = 0; r < 9; ++r) red[(kg * 9 + r) * 64 + col] = acc[r];
            __syncthreads();
            for (int i = c.tid; i < 576; i += 512) { const int r = i >> 6, cc = i & 63; float s = 0.f;
#pragma unroll
                for (int k2 = 0; k2 < 8; ++k2) s += red[(k2 * 9 + r) * 64 + cc];
                MOD[((size_t)l * 9 + r) * 6144 + c0 + cc] = s + c.a->in[7][l * 6144 + c0 + cc]; }
            __syncthreads();
        }
    }
    if (c.bid == 0) {
        const int d = c.tid >> 8, ch = c.tid & 255; const float* lg = c.a->in[10] + (size_t)d * 4 * 256 + ch;
        const float a0 = lg[0], a1 = lg[256], a2 = lg[512], a3 = lg[768]; const float mx = fmaxf(fmaxf(a0, a1), fmaxf(a2, a3));
        const float e0 = expf(a0 - mx), e1 = expf(a1 - mx), e2 = expf(a2 - mx), e3 = expf(a3 - mx), inv = 1.f / (e0 + e1 + e2 + e3);
        float* LB = c.w<float>(WS_LB) + (size_t)d * 4 * 256 + ch;
        LB[0] = 0.f; LB[256] = e1 * inv; LB[512] = (e1 + e2) * inv; LB[768] = (e1 + e2 + e3) * inv;
    }
    if (c.bid == 1 % c.G) {
        float* RT = c.w<float>(WS_ROPE);
        for (int i = c.tid; i < 64 * 16; i += 512) { const int pos = i >> 4, j = i & 15; const float inv = exp2f(-(float)j * (13.287712379549449f / 16.f)); const float ang = (float)pos * inv;
            RT[i * 2] = __cosf(ang); RT[i * 2 + 1] = __sinf(ang); }
    }
    {
        __syncthreads();
        LAS float* T = (LAS float*)c.lds;
        constexpr int PER_L = 992 + 256 + 24;
        for (int task4 = c.bid; task4 < PER_L; task4 += c.G) {
            CvtJob jb[4];
#pragma unroll
            for (int q = 0; q < 4; ++q) {
                const int task = task4 * 4 + q; const int l = task / PER_L; int t = task - l * PER_L;
                if (t < 992) { const int kt = t / 62, nt = t % 62;
                    jb[q].src = c.a->in[8] + ((size_t)l * 1024 + kt * 64) * PT + nt * 64; jb[q].src_ld = PT; jb[q].dst = c.w<bf16_t>(WS_WIN) + ((size_t)l * 4096 + nt * 64) * 1024 + kt * 64; jb[q].dst_ld = 1024;
                } else if (t < 992 + 256) { t -= 992; const int kt = t >> 4, nt = t & 15;
                    jb[q].src = c.a->in[9] + ((size_t)l * 1024 + kt * 64) * 1024 + nt * 64; jb[q].src_ld = 1024; jb[q].dst = c.w<bf16_t>(WS_WOUT) + ((size_t)l * 1024 + nt * 64) * 1024 + kt * 64; jb[q].dst_ld = 1024;
                } else { t -= 992 + 256; bf16_t* lo = c.w<bf16_t>(WS_LORA + (size_t)l * LORA_L);
                    if (t < 8) { const int d = t >> 2, nt = t & 3;
                        jb[q].src = c.a->in[14] + ((size_t)(l * 2 + d) * 64) * 256 + nt * 64; jb[q].src_ld = 256; jb[q].dst = lo + (size_t)d * 16384 + (size_t)nt * 64 * 64; jb[q].dst_ld = 64;
                    } else if (t < 16) { t -= 8; const int d = t >> 2, nt = t & 3;
                        jb[q].src = c.a->in[16] + ((size_t)(l * 2 + d) * 64) * 256 + nt * 64; jb[q].src_ld = 256; jb[q].dst = lo + 32768 + (size_t)d * 16384 + (size_t)nt * 64 * 64; jb[q].dst_ld = 64;
                    } else { t -= 16; const int kt = t >> 2, nt = t & 3;
                        jb[q].src = c.a->in[17] + ((size_t)l * 128 + kt * 64) * 256 + nt * 64; jb[q].src_ld = 256; jb[q].dst = lo + 65536 + (size_t)nt * 64 * 128 + kt * 64; jb[q].dst_ld = 128;
                    }
                }
            }
            cvt_tile4(c, T, jb);
        }
        u32x4* z = c.w<u32x4>(WS_WIN);
        for (int i = c.bid * 512 + c.tid; i < 4 * 16384; i += c.G * 512) { const int l = i >> 14, o = i & 16383; z[((size_t)l * 4096 + 3968) * 128 + o] = (u32x4){0u, 0u, 0u, 0u}; }
    }
}

__device__ __forceinline__ void build_tpre(const Ctx& c, int l) {
    LAS int* tp = (LAS int*)(c.lds + MISC_OFF + 64); LAS int* cn = (LAS int*)(c.lds + MISC_OFF + 256);
    __syncthreads();
    if (c.tid < 32) cn[c.tid] = (int)__hip_atomic_load(c.w<unsigned>(WS_CTL) + CW_CNT + l * 64 + c.tid, __ATOMIC_RELAXED, __HIP_MEMORY_SCOPE_AGENT);
    __syncthreads();
    if (c.tid == 0) { int s = 0; for (int e = 0; e < 32; ++e) { tp[e] = s; s += (cn[e] + 255) >> 8; } tp[32] = s; }
    __syncthreads();
}

__device__ __forceinline__ void phase_norm1(const Ctx& c, int l) {
    LAS int* tp = (LAS int*)(c.lds + MISC_OFF + 64);
    if (l > 0) build_tpre(c, l - 1);
    const float* MOD = c.w<float>(WS_MOD); float* X = c.w<float>(WS_X); const bf16_t* Y = c.w<bf16_t>(WS_Y); bf16_t* H = c.w<bf16_t>(WS_H);
    const int4* ROUTE = c.w<int4>(WS_ROUTE);
    const int stride = c.G * 8, lane = c.lane;
    constexpr int NR = 3;
    for (int rowb = c.bid * 8 + c.wave; rowb < MTOK; rowb += NR * stride) {
        f32x4 x[NR][4]; int4 rt[NR]; bool act[NR]; int mrow[NR];
#pragma unroll
        for (int u = 0; u < NR; ++u) { const int row = rowb + u * stride; const int rr = row < MTOK ? row : rowb; const int b = rr / TPB, s = rr - b * TPB;
            act[u] = row < MTOK && !(l == DEPTH && s < CTX); mrow[u] = s < CTX ? 8 : b;
            const float* xs = l > 0 ? X + (size_t)rr * D : (s < CTX ? c.a->in[2] + ((size_t)b * CTX + s) * D : c.a->in[0] + ((size_t)b * SEQ + (s - CTX)) * D);
#pragma unroll
            for (int j = 0; j < 4; ++j) x[u][j] = *(const f32x4*)(xs + lane * 4 + 256 * j);
            rt[u] = l > 0 ? ROUTE[rr] : make_int4(0, 0, 0, 0); }
        if (l > 0) {
            u32x2 y0[NR][4], y1[NR][4];
#pragma unroll
            for (int u = 0; u < NR; ++u) { const int e0 = act[u] ? rt[u].x : 0, e1 = act[u] ? rt[u].z : 0, p0 = act[u] ? rt[u].y : 0, p1 = act[u] ? rt[u].w : 0;
                const size_t r0 = (size_t)tp[e0] * 256 + p0, r1 = (size_t)tp[e1] * 256 + p1;
#pragma unroll
                for (int j = 0; j < 4; ++j) { y0[u][j] = *(const u32x2*)(Y + r0 * D + lane * 4 + 256 * j); y1[u][j] = *(const u32x2*)(Y + r1 * D + lane * 4 + 256 * j); } }
#pragma unroll
            for (int u = 0; u < NR; ++u) { const float* g2 = MOD + ((size_t)(l - 1) * 9 + mrow[u]) * 6144 + 5120;
#pragma unroll
                for (int j = 0; j < 4; ++j) { const f32x4 g = *(const f32x4*)(g2 + lane * 4 + 256 * j);
                    x[u][j][0] += g[0] * (bflo(y0[u][j].x) + bflo(y1[u][j].x)); x[u][j][1] += g[1] * (bfhi(y0[u][j].x) + bfhi(y1[u][j].x));
                    x[u][j][2] += g[2] * (bflo(y0[u][j].y) + bflo(y1[u][j].y)); x[u][j][3] += g[3] * (bfhi(y0[u][j].y) + bfhi(y1[u][j].y)); } }
        }
#pragma unroll
        for (int u = 0; u < NR; ++u) {
            if (!act[u]) continue;
            const int row = rowb + u * stride; const int b = row / TPB, s = row - b * TPB;
            if (l == DEPTH) {
                float* o = c.out + ((size_t)b * SEQ + (s - CTX)) * D;
#pragma unroll
                for (int j = 0; j < 4; ++j) *(f32x4*)(o + lane * 4 + 256 * j) = x[u][j];
                continue;
            }
#pragma unroll
            for (int j = 0; j < 4; ++j) *(f32x4*)(X + (size_t)row * D + lane * 4 + 256 * j) = x[u][j];
            float ss = 0.f;
#pragma unroll
            for (int j = 0; j < 4; ++j) ss += x[u][j][0] * x[u][j][0] + x[u][j][1] * x[u][j][1] + x[u][j][2] * x[u][j][2] + x[u][j][3] * x[u][j][3];
            ss = red64(ss);
            const float inv = rsqrtf(ss * (1.f / 1024.f) + 1e-6f);
            const float* gain = c.a->in[4] + (size_t)l * D; const float* md = MOD + ((size_t)l * 9 + mrow[u]) * 6144;
#pragma unroll
            for (int j = 0; j < 4; ++j) { const int col = lane * 4 + 256 * j;
                const f32x4 gn = *(const f32x4*)(gain + col), sh = *(const f32x4*)(md + col), sc = *(const f32x4*)(md + 1024 + col);
                const f32x4 h = x[u][j] * inv * gn * (1.f + sc) + sh;
                u32x2 o; o.x = pk2(h[0], h[1]); o.y = pk2(h[2], h[3]); *(u32x2*)(H + (size_t)row * D + col) = o; }
        }
    }
}

__device__ __forceinline__ void phase_prep(const Ctx& c, int l) {
    const bf16_t* P = c.w<bf16_t>(WS_P);
    const int gw = c.bid * 8 + c.wave, nw = c.G * 8, lane = c.lane;
    {
        const float* RT = c.w<float>(WS_ROPE); bf16_t* QN = c.w<bf16_t>(WS_QN); bf16_t* KN = c.w<bf16_t>(WS_KN);
        const int hd = lane >> 3, sub = lane & 7;
        u32x2 nq[2][2];
#define QK_LOAD(r_) do { _Pragma("unroll") for (int w_ = 0; w_ < 2; ++w_) { const bf16_t* pq_ = P + (size_t)(r_) * PT + (w_ ? PC_K : PC_Q) + hd * 64 + sub * 4; \
            nq[w_][0] = *(const u32x2*)pq_; nq[w_][1] = *(const u32x2*)(pq_ + 32); } } while (0)
        QK_LOAD(gw < MTOK ? gw : 0);
        for (int row = gw; row < MTOK; row += nw) {
            const int b = row / TPB, s = row - b * TPB; const bool lat = s >= CTX; const int t = s - CTX, pr = t >> 6, pc = t & 63;
            const int pos = sub < 4 ? pr : pc, jj0 = (sub & 3) * 4;
            u32x2 cq[2][2];
#pragma unroll
            for (int w_ = 0; w_ < 2; ++w_) { cq[w_][0] = nq[w_][0]; cq[w_][1] = nq[w_][1]; }
            QK_LOAD(row + nw < MTOK ? row + nw : row);
#pragma unroll
            for (int which = 0; which < 2; ++which) {
                const u32x2 a = cq[which][0], bq = cq[which][1];
                float x1[4] = {bflo(a.x), bfhi(a.x), bflo(a.y), bfhi(a.y)}, x2[4] = {bflo(bq.x), bfhi(bq.x), bflo(bq.y), bfhi(bq.y)};
                float ss = 0.f;
#pragma unroll
                for (int j = 0; j < 4; ++j) ss += x1[j] * x1[j] + x2[j] * x2[j];
                ss = red8(ss);
                const float inv = rsqrtf(ss * (1.f / 64.f) + 1e-6f);
                const float* gn = c.a->in[which ? 24 : 23] + l * 64 + sub * 4;
                float y1[4], y2[4];
#pragma unroll
                for (int j = 0; j < 4; ++j) { const float u1 = x1[j] * inv * gn[j], u2 = x2[j] * inv * gn[32 + j];
                    if (lat) { const float cs = RT[(pos * 16 + jj0 + j) * 2], sn = RT[(pos * 16 + jj0 + j) * 2 + 1]; y1[j] = u1 * cs - u2 * sn; y2[j] = u2 * cs + u1 * sn; }
                    else { y1[j] = u1; y2[j] = u2; }
                    if (!which) { y1[j] *= 0.125f; y2[j] *= 0.125f; } }
                u32x2 o1, o2; o1.x = pk2(y1[0], y1[1]); o1.y = pk2(y1[2], y1[3]); o2.x = pk2(y2[0], y2[1]); o2.y = pk2(y2[2], y2[3]);
                if (which) {
                    bf16_t* dst = KN + ((size_t)(b * 8 + hd)) * TPB * 64 + (size_t)(s >> 3) * 512 + (s & 7) * 32 + (sub >> 1) * 8 + (sub & 1) * 4;
                    *(u32x2*)dst = o1; *(u32x2*)(dst + 256) = o2;
                } else {
                    bf16_t* dst = QN + (((size_t)(b * 8 + hd)) * TPB + s) * 64 + sub * 4;
                    *(u32x2*)dst = o1; *(u32x2*)(dst + 32) = o2;
                }
            }
        }
    }
    {
        LAS bf16_t* T = (LAS bf16_t*)(c.lds + c.wave * 9216);
        bf16_t* VT = c.w<bf16_t>(WS_VT);
        for (int task = gw; task < NB * 8 * 36; task += nw) {
            const int b = task / 288, h = (task / 36) & 7, tb = task % 36;
#pragma unroll
            for (int i = 0; i < 8; ++i) { const int tok = i * 8 + (lane >> 3), ch = lane & 7;
                const u32x4 v = *(const u32x4*)(P + (size_t)(b * TPB + tb * 64 + tok) * PT + PC_V + h * 64 + ch * 8);
                *(LAS u32x4*)(T + tok * 72 + ch * 8) = v; }
            __builtin_amdgcn_wave_barrier();
            unsigned pk[32];
#pragma unroll
            for (int i = 0; i < 32; ++i) pk[i] = (unsigned)T[(2 * i) * 72 + lane] | ((unsigned)T[(2 * i + 1) * 72 + lane] << 16);
            bf16_t* dst = VT + (size_t)(b * 8 + h) * 64 * TPB + (size_t)(tb * 8) * 512 + (lane >> 4) * 128 + (lane & 15) * 8;
#pragma unroll
            for (int i = 0; i < 8; ++i) *(u32x4*)(dst + i * 512) = (u32x4){pk[4 * i], pk[4 * i + 1], pk[4 * i + 2], pk[4 * i + 3]};
            __builtin_amdgcn_wave_barrier();
        }
    }
}
__device__ __forceinline__ void phase_prep_hgrn(const Ctx& c, int l) {
    const bf16_t* P = c.w<bf16_t>(WS_P);
    const int gw = c.bid * 8 + c.wave, nw = c.G * 8;
    {
        LAS bf16_t* QT = (LAS bf16_t*)(c.lds + (c.wave < 7 ? c.wave * 8192 : 132096)); LAS bf16_t* KTl = QT + 16 * 72; LAS bf16_t* IV = KTl + 16 * 72;
        const float* LB = c.w<float>(WS_LB);
        bf16_t* QIN = c.w<bf16_t>(WS_QIN); bf16_t* KOT = c.w<bf16_t>(WS_KOT); bf16_t* IT = c.w<bf16_t>(WS_IT); float* DEC = c.w<float>(WS_DEC); bf16_t* O1 = c.w<bf16_t>(WS_O1);
        const bool bal = (c.G == 256);
        const int t_lo = bal ? (c.bid < 128 ? c.bid * 8 : 1024 + (c.bid - 128) * 28) + c.wave : gw;
        const int t_hi = bal ? (c.bid < 128 ? c.bid * 8 + 8 : 1024 + (c.bid - 128) * 28 + 28) : NB * 4 * NBLK16;
        const int t_st = bal ? 8 : nw;
        bf16_t nqr[16], nir[16], nfr[16], nbr[16];
#define HG_TLOAD(task_) do { const int tk_ = (task_); const int b_ = tk_ / (4 * NBLK16), h_ = (tk_ / NBLK16) & 3, nb_ = tk_ % NBLK16; \
            const bf16_t* pr_ = P + (size_t)(b_ * TPB + nb_ * 16) * PT + h_ * 64 + c.lane; \
            _Pragma("unroll") for (int t_ = 0; t_ < 16; ++t_) { nqr[t_] = pr_[(size_t)t_ * PT + PA_Q]; nir[t_] = pr_[(size_t)t_ * PT + PA_I]; nfr[t_] = pr_[(size_t)t_ * PT + PA_FF]; nbr[t_] = pr_[(size_t)t_ * PT + PA_FB]; } } while (0)
        if (t_lo < t_hi) HG_TLOAD(t_lo);
        for (int task = t_lo; task < t_hi; task += t_st) {
            int lane = c.lane; asm volatile("" : "+v"(lane));
            const int fr = lane & 15, g = lane >> 4;
            const int b = task / (4 * NBLK16), h = (task / NBLK16) & 3, nb = task % NBLK16; const int row0 = b * TPB + nb * 16;
            float q[16]; bf16_t ffr[16], fbr[16];
            {
                float iv[16];
#pragma unroll
                for (int t = 0; t < 16; ++t) { q[t] = bf2f(nqr[t]); iv[t] = bf2f(nir[t]); ffr[t] = nfr[t]; fbr[t] = nbr[t]; }
                HG_TLOAD(task + t_st < t_hi ? task + t_st : task);
                unsigned pk[8];
#pragma unroll
                for (int i = 0; i < 8; ++i) pk[i] = pk2(iv[2 * i], iv[2 * i + 1]);
                bf16_t* dst = IT + (((size_t)(b * 4 + h) * NBLK16 + nb) * 64 + lane) * 16;
                *(u32x4*)dst = (u32x4){pk[0], pk[1], pk[2], pk[3]}; *(u32x4*)(dst + 8) = (u32x4){pk[4], pk[5], pk[6], pk[7]};
                *(LAS u32x4*)(IV + lane * 24) = (u32x4){pk[0], pk[1], pk[2], pk[3]}; *(LAS u32x4*)(IV + lane * 24 + 8) = (u32x4){pk[4], pk[5], pk[6], pk[7]};
            }
            f32x4 oacc[4];
#pragma unroll
            for (int n = 0; n < 4; ++n) oacc[n] = (f32x4){0.f, 0.f, 0.f, 0.f};
#pragma unroll 1
            for (int dir = 0; dir < 2; ++dir) {
                const float lb = LB[((size_t)dir * 4 + l) * 256 + h * 64 + lane];
                float kf[16], cum[16];
#pragma unroll
                for (int t = 0; t < 16; ++t) { const float fp = bf2f(dir ? fbr[t] : ffr[t]);
                    const float f = lb + (1.f - lb) * sigm(fp); cum[t] = __logf(fmaxf(f, 1e-20f)); kf[t] = (1.f - lb) * sigm(-fp); }
                if (dir == 0) {
#pragma unroll
                    for (int t = 1; t < 16; ++t) cum[t] += cum[t - 1];
                } else {
#pragma unroll
                    for (int t = 14; t >= 0; --t) cum[t] += cum[t + 1];
                }
                const float cend = dir ? cum[0] : cum[15], cmid = dir ? cum[8] : cum[7];
                const size_t blk = ((size_t)(dir * 8 + b) * 4 + h) * NBLK16 + nb;
                DEC[blk * 64 + lane] = __expf(cend);
                unsigned pko[8];
#pragma unroll
                for (int t = 0; t < 16; ++t) {
                    const float qi = q[t] * __expf(cum[t]), ko = kf[t] * __expf(cend - cum[t]);
                    QIN[((size_t)dir * MTOK + row0 + t) * 256 + h * 64 + lane] = f2bf(qi);
                    if (t & 1) pko[t >> 1] |= (unsigned)f2bf(ko) << 16; else pko[t >> 1] = (unsigned)f2bf(ko);
                    QT[t * 72 + lane] = f2bf(q[t] * __expf(fminf(fmaxf(cum[t] - cmid, -80.f), 80.f)));
                    KTl[t * 72 + lane] = f2bf(kf[t] * __expf(fminf(fmaxf(cmid - cum[t], -80.f), 80.f)));
                }
                { bf16_t* dst = KOT + (blk * 64 + lane) * 16;
                  *(u32x4*)dst = (u32x4){pko[0], pko[1], pko[2], pko[3]}; *(u32x4*)(dst + 8) = (u32x4){pko[4], pko[5], pko[6], pko[7]}; }
                MEMBAR();
                __builtin_amdgcn_wave_barrier();
                f32x4 sT = {0.f, 0.f, 0.f, 0.f};
#pragma unroll
                for (int ks = 0; ks < 2; ++ks) {
                    const bf16x8 aK = *(const LAS bf16x8*)(KTl + fr * 72 + ks * 32 + g * 8), bQ = *(const LAS bf16x8*)(QT + fr * 72 + ks * 32 + g * 8);
                    sT = __builtin_amdgcn_mfma_f32_16x16x32_bf16(aK, bQ, sT, 0, 0, 0);
                }
                float sm[4];
#pragma unroll
                for (int j = 0; j < 4; ++j) { const int sI = 4 * g + j; const bool ok = dir ? (sI >= fr) : (sI <= fr); sm[j] = ok ? sT[j] : 0.f; }
                union { u32x2 u; bf16x4 v; } aS; aS.u = (u32x2){pk2m(sm[0], sm[1]), pk2m(sm[2], sm[3])};
#pragma unroll
                for (int n = 0; n < 4; ++n) { const bf16x4 bI = *(const LAS bf16x4*)(IV + (16 * n + fr) * 24 + 4 * g);
                    oacc[n] = __builtin_amdgcn_mfma_f32_16x16x16bf16_1k(aS.v, bI, oacc[n], 0, 0, 0); }
                MEMBAR();
                __builtin_amdgcn_wave_barrier();
            }
#pragma unroll
            for (int n = 0; n < 4; ++n)
#pragma unroll
                for (int j = 0; j < 4; ++j) O1[(size_t)(row0 + 4 * g + j) * 256 + h * 64 + 16 * n + fr] = f2bf(oacc[n][j]);
        }
    }
}
__device__ __forceinline__ void rwkv_chunk_task(const Ctx& c, const int task);
__device__ __forceinline__ int rw_img_off(int hd) { return hd < 4 ? 89344 + hd * 9216 : (hd < 7 ? 131136 + (hd - 4) * 9216 : 49408); }
__device__ __forceinline__ int rw_sm_off(int wv) { return wv < 6 ? wv * 8192 : (wv == 6 ? 76800 : 58624); }
constexpr int SPS = 772;
__device__ __forceinline__ void rwkv_chunk_task(const Ctx& c, const int task);
__device__ __forceinline__ void phase_prep_rwkv(const Ctx& c, int l) {
    const bf16_t* P = c.w<bf16_t>(WS_P);
    const int lane = c.lane;
    {
        LAS float* SP = (LAS float*)c.lds;
        LAS float* SPL = (LAS float*)(c.lds + 49408);
        LAS float* KKI = (LAS float*)(c.lds + 73984);
        LAS float* BONP = KKI + 64;
        LAS float* GCL = (LAS float*)(c.lds + 74752);
        LAS bf16_t* ACT = (LAS bf16_t*)(c.lds + 76800);
        const float* mu = c.a->in[12] + (size_t)l * 1152;
        const float* kks = c.a->in[18] + l * 256; const float* k_a = c.a->in[19] + l * 256; const float* r_k = c.a->in[20] + l * 256;
        const bf16_t* lo = c.w<bf16_t>(WS_LORA + (size_t)l * LORA_L);
        bf16_t* GG = c.w<bf16_t>(WS_G); bf16_t* BON = c.w<bf16_t>(WS_BON); float* GCo = c.w<float>(WS_GC); bf16_t* VT2 = c.w<bf16_t>(WS_VT2);
        const int fr = lane & 15, g = lane >> 4;
        for (int tile = c.bid; tile < MTOK / 16; tile += c.G) {
            const int r0 = tile * 16; const int b = r0 / TPB, s0 = r0 - b * TPB;
#pragma unroll
            for (int it = 0; it < 5; ++it) {
                const int idx = c.tid + it * 512;
                if (idx < 16 * 144) {
                    const int t = idx / 144, ch = (idx - t * 144) * 8; const int s = s0 + t;
                    const bf16_t* pp = P + (size_t)(r0 + t) * PT + PB0 + ch;
                    const u32x4 zero4 = {0u, 0u, 0u, 0u};
                    const u32x4 p4 = *(const u32x4*)pp;
                    const u32x4 m4 = (s != 0 && s != CTX) ? *(const u32x4*)(pp - PT) : zero4;
                    const u32x4 n4 = (s != CTX - 1 && s != TPB - 1) ? *(const u32x4*)(pp + PT) : zero4;
                    const f32x4 mu0 = *(const f32x4*)(mu + ch), mu1 = *(const f32x4*)(mu + ch + 4);
                    f32x4 o0, o1;
#pragma unroll
                    for (int e = 0; e < 4; ++e) {
                        const unsigned pw = p4[e], mw = m4[e], nw = n4[e];
                        const float pl = bflo(pw), ph = bfhi(pw);
                        const float vl = pl + (0.5f * (bflo(mw) + bflo(nw)) - pl) * (e < 2 ? mu0[2 * e] : mu1[2 * e - 4]);
                        const float vh = ph + (0.5f * (bfhi(mw) + bfhi(nw)) - ph) * (e < 2 ? mu0[2 * e + 1] : mu1[2 * e - 3]);
                        if (e < 2) { o0[2 * e] = vl; o0[2 * e + 1] = vh; } else { o1[2 * e - 4] = vl; o1[2 * e - 3] = vh; }
                    }
                    LAS float* sd = ch < 768 ? SP + t * SPS + ch : SPL + t * 384 + (ch - 768);
                    *(LAS f32x4*)sd = o0; *(LAS f32x4*)(sd + 4) = o1;
                }
            }
            __syncthreads();
            {
#pragma unroll
                for (int it = 0; it < 6; ++it) { const int idx = c.tid + it * 512; const int t = idx / 192, c2 = (idx - t * 192) * 2;
                    const float x0 = SPL[t * 384 + c2], x1 = SPL[t * 384 + c2 + 1];
                    float y0, y1;
                    if (c2 < 128) { y0 = 1.f - 2.f / (__expf(2.f * x0) + 1.f); y1 = 1.f - 2.f / (__expf(2.f * x1) + 1.f); }
                    else if (c2 < 256) { y0 = x0; y1 = x1; }
                    else { y0 = sigm(x0); y1 = sigm(x1); }
                    *(LAS unsigned*)(ACT + t * 392 + c2) = pk2(y0, y1); }
            }
            {
#pragma unroll
                for (int tt = 0; tt < 2; ++tt) { const int t = c.wave * 2 + tt; float ss = 0.f;
#pragma unroll
                    for (int j = 0; j < 4; ++j) { const float v = SP[t * SPS + 256 + lane * 4 + j] * kks[lane * 4 + j]; ss += v * v; }
                    ss = red16(ss);
                    if (fr == 0) KKI[t * 4 + g] = 1.f / fmaxf(sqrtf(ss), 1e-12f); }
            }
            __syncthreads();
            float bpart[4] = {0.f, 0.f, 0.f, 0.f};
#pragma unroll 1
            for (int nn = 0; nn < 2; ++nn) {
                const int nt = c.wave * 2 + nn, ch = nt * 16 + fr, hh = nt >> 2;
                f32x4 aw[2], aa[2], ag = (f32x4){0.f, 0.f, 0.f, 0.f};
#pragma unroll
                for (int d = 0; d < 2; ++d) { aw[d] = (f32x4){0.f, 0.f, 0.f, 0.f}; aa[d] = aw[d]; }
#pragma unroll
                for (int d = 0; d < 2; ++d)
#pragma unroll
                    for (int ks = 0; ks < 2; ++ks) {
                        const bf16x8 fa = *(const LAS bf16x8*)(ACT + fr * 392 + d * 64 + ks * 32 + g * 8), fb = *(const LAS bf16x8*)(ACT + fr * 392 + 128 + d * 64 + ks * 32 + g * 8);
                        const bf16x8 bw = *(const bf16x8*)(lo + (size_t)d * 16384 + (size_t)ch * 64 + ks * 32 + g * 8);
                        const bf16x8 ba = *(const bf16x8*)(lo + 32768 + (size_t)d * 16384 + (size_t)ch * 64 + ks * 32 + g * 8);
                        aw[d] = __builtin_amdgcn_mfma_f32_16x16x32_bf16(fa, bw, aw[d], 0, 0, 0);
                        aa[d] = __builtin_amdgcn_mfma_f32_16x16x32_bf16(fb, ba, aa[d], 0, 0, 0);
                    }
#pragma unroll
                for (int ks = 0; ks < 4; ++ks) {
                    const bf16x8 fg = *(const LAS bf16x8*)(ACT + fr * 392 + 256 + ks * 32 + g * 8);
                    const bf16x8 bg = *(const bf16x8*)(lo + 65536 + (size_t)ch * 128 + ks * 32 + g * 8);
                    ag = __builtin_amdgcn_mfma_f32_16x16x32_bf16(fg, bg, ag, 0, 0, 0);
                }
                const float kksc = kks[ch], kac = k_a[ch], rkc = r_k[ch];
                const float w0f = c.a->in[13][(size_t)(l * 2 + 0) * 256 + ch], w0b = c.a->in[13][(size_t)(l * 2 + 1) * 256 + ch];
                const float a0f = c.a->in[15][(size_t)(l * 2 + 0) * 256 + ch], a0b = c.a->in[15][(size_t)(l * 2 + 1) * 256 + ch];
                float ld[2][4], kdv[2][4], akv[2][4], kkv[4], rrv[4], vvv[4];
#pragma unroll
                for (int j = 0; j < 4; ++j) {
                    const int t = 4 * g + j; const size_t row = (size_t)r0 + t;
                    const float rr = SP[t * SPS + ch], kk0 = SP[t * SPS + 256 + ch], vv = SP[t * SPS + 512 + ch];
                    const float kk = kk0 * kksc * KKI[t * 4 + hh];
                    kkv[j] = kk; rrv[j] = rr; vvv[j] = vv;
                    float kdsum = 0.f;
#pragma unroll
                    for (int d = 0; d < 2; ++d) {
                        const float wl = (d ? w0b : w0f) + aw[d][j];
                        const float xx = -wl; const float sp = fmaxf(xx, 0.f) + __logf(1.f + __expf(-fabsf(xx)));
                        const float wlog = -sp - 0.5f; ld[d][j] = -__expf(wlog);
                        const float a = sigm((d ? a0b : a0f) + aa[d][j]);
                        const float kd = kk0 * (1.f + (a - 1.f) * kac);
                        kdv[d][j] = kd; akv[d][j] = a * kk; kdsum += kd;
                    }
                    GG[row * 256 + ch] = f2bf(ag[j]);
                    bpart[j] += rr * kdsum * rkc;
                }
                const int k = ch & 63;
#pragma unroll
                for (int d = 0; d < 2; ++d) {
                    const float tot = (ld[d][0] + ld[d][1]) + (ld[d][2] + ld[d][3]);
                    const float T0 = shidx(tot, fr), T1 = shidx(tot, fr + 16), T2 = shidx(tot, fr + 32), T3 = shidx(tot, fr + 48);
                    float run = d ? ((g < 3 ? T3 : 0.f) + (g < 2 ? T2 : 0.f) + (g < 1 ? T1 : 0.f)) : ((g > 0 ? T0 : 0.f) + (g > 1 ? T1 : 0.f) + (g > 2 ? T2 : 0.f));
                    const int hd = hh * 2 + d;
                    LAS bf16_t* ALT = (LAS bf16_t*)(c.lds + rw_img_off(hd)); LAS bf16_t* KT = ALT + 16 * 72; LAS bf16_t* KAP = KT + 16 * 72; LAS bf16_t* RT = KAP + 16 * 72;
#pragma unroll
                    for (int jj = 0; jj < 4; ++jj) {
                        const int j = d ? 3 - jj : jj; const int tq = d ? 15 - (4 * g + j) : 4 * g + j;
                        const float Gp = __expf(run); run += ld[d][j]; const float G = __expf(run), iG = __expf(-run);
                        ALT[tq * 72 + k] = f2bf(akv[d][j] * iG); KT[tq * 72 + k] = f2bf(kdv[d][j] * iG); KAP[tq * 72 + k] = f2bf(Gp * kkv[j]); RT[tq * 72 + k] = f2bf(G * rrv[j]);
                    }
                    const size_t task = (size_t)((b * 4 + hh) * 2 + d) * 144 + (s0 >> 4);
                    if (g == 0) { const float gc = __expf((T0 + T1) + (T2 + T3)); GCL[hd * 64 + k] = gc; GCo[task * 64 + k] = gc; }
                    u32x2 pv; if (d) { pv.x = pk2(vvv[3], vvv[2]); pv.y = pk2(vvv[1], vvv[0]); } else { pv.x = pk2(vvv[0], vvv[1]); pv.y = pk2(vvv[2], vvv[3]); }
                    *(u32x2*)(VT2 + (task * 64 + k) * 16 + (d ? 12 - 4 * g : 4 * g)) = pv;
                }
            }
#pragma unroll
            for (int j = 0; j < 4; ++j) { const float s = red16(bpart[j]); if (fr == 0) BONP[(4 * g + j) * 8 + c.wave] = s; }
            __syncthreads();
            for (int idx = c.tid; idx < 16 * 256; idx += 512) { const int t = idx >> 8, ch = idx & 255, hh = ch >> 6;
                BON[((size_t)r0 + t) * 256 + ch] = f2bf((BONP[t * 8 + hh * 2] + BONP[t * 8 + hh * 2 + 1]) * SP[t * SPS + 512 + ch]); }
            __syncthreads();
            rwkv_chunk_task(c, ((b * 4 + (c.wave >> 1)) * 2 + (c.wave & 1)) * 144 + (s0 >> 4));
            if (REP_PHASE == 35) rwkv_chunk_task(c, ((b * 4 + (c.wave >> 1)) * 2 + (c.wave & 1)) * 144 + (s0 >> 4));
            __syncthreads();
        }
    }
}

__device__ __forceinline__ void rwkv_chunk_task(const Ctx& c, const int task) {
    const int wv = c.wave;
    {
    int lane = c.lane; asm volatile("" : "+v"(lane));
    const int fr = lane & 15, g = lane >> 4;
    LAS bf16_t* ALT = (LAS bf16_t*)(c.lds + rw_img_off(wv)); LAS bf16_t* KT = ALT + 16 * 72; LAS bf16_t* KAP = KT + 16 * 72; LAS bf16_t* RT = KAP + 16 * 72;
    LAS float* SM = (LAS float*)(c.lds + rw_sm_off(wv));
    bf16_t* KHT = c.w<bf16_t>(WS_KHT); bf16_t* AHT = c.w<bf16_t>(WS_AHT); float* GCo = c.w<float>(WS_GC); bf16_t* RH = c.w<bf16_t>(WS_RH); bf16_t* WYo = c.w<bf16_t>(WS_WY); bf16_t* ZT = c.w<bf16_t>(WS_ZT);
    {
        const float Gc = ((const LAS float*)(c.lds + 74752))[wv * 64 + lane];
        {
            f32x4 dN = {0.f, 0.f, 0.f, 0.f}, dM = dN, dNR = dN, dMR = dN;
#pragma unroll
            for (int ks = 0; ks < 2; ++ks) {
                const bf16x8 aA = *(const LAS bf16x8*)(ALT + fr * 72 + ks * 32 + g * 8), aK = *(const LAS bf16x8*)(KT + fr * 72 + ks * 32 + g * 8);
                const bf16x8 bP = *(const LAS bf16x8*)(KAP + fr * 72 + ks * 32 + g * 8), bR = *(const LAS bf16x8*)(RT + fr * 72 + ks * 32 + g * 8);
                dN = __builtin_amdgcn_mfma_f32_16x16x32_bf16(aA, bP, dN, 0, 0, 0); dM = __builtin_amdgcn_mfma_f32_16x16x32_bf16(aK, bP, dM, 0, 0, 0);
                dNR = __builtin_amdgcn_mfma_f32_16x16x32_bf16(aA, bR, dNR, 0, 0, 0); dMR = __builtin_amdgcn_mfma_f32_16x16x32_bf16(aK, bR, dMR, 0, 0, 0);
            }
#pragma unroll
            for (int j = 0; j < 4; ++j) { const int sI = 4 * g + j;
                SM[0 * 256 + sI * 16 + fr] = sI < fr ? dN[j] : 0.f; SM[1 * 256 + sI * 16 + fr] = sI < fr ? dM[j] : 0.f;
                SM[2 * 256 + sI * 16 + fr] = sI <= fr ? dNR[j] : 0.f; SM[3 * 256 + sI * 16 + fr] = sI <= fr ? dMR[j] : 0.f; }
        }
        __builtin_amdgcn_wave_barrier();
        {
            const int role = g & 1;
            float X[16];
#define ROW4(dst, mat, r_) do { _Pragma("unroll") for (int q_ = 0; q_ < 4; ++q_) dst[q_] = *(const LAS f32x4*)(SM + (mat) * 256 + (r_) * 16 + 4 * q_); } while (0)
            {
                f32x4 nr[4]; float nrhs = role ? SM[2 * 256 + 15 * 16 + fr] : (15 == fr ? 1.f : 0.f);
                ROW4(nr, 0, 15);
#pragma unroll
                for (int sI = 15; sI >= 0; --sI) {
                    f32x4 cr[4]; float acc = nrhs;
#pragma unroll
                    for (int q = 0; q < 4; ++q) cr[q] = nr[q];
                    if (sI > 0) { ROW4(nr, 0, sI - 1); nrhs = role ? SM[2 * 256 + (sI - 1) * 16 + fr] : (sI - 1 == fr ? 1.f : 0.f); }
                    MEMBAR();
#pragma unroll
                    for (int j = sI + 1; j < 16; ++j) acc -= cr[j >> 2][j & 3] * X[j];
                    X[sI] = acc;
                }
            }
            {
                f32x4 nr[4]; float nmr = SM[3 * 256 + 0 * 16 + fr];
                ROW4(nr, 1, 0);
#pragma unroll
                for (int sI = 0; sI < 16; ++sI) {
                    f32x4 cr[4]; const float mr = nmr;
#pragma unroll
                    for (int q = 0; q < 4; ++q) cr[q] = nr[q];
                    if (sI < 15) { ROW4(nr, 1, sI + 1); nmr = SM[3 * 256 + (sI + 1) * 16 + fr]; }
                    MEMBAR();
                    float om = 0.f;
#pragma unroll
                    for (int j = sI + 1; j < 16; ++j) om += cr[j >> 2][j & 3] * X[j];
                    const float oo = role ? mr - om : om;
                    SM[(4 + role) * 256 + sI * 16 + fr] = X[sI]; SM[(6 + role) * 256 + sI * 16 + fr] = oo;
                }
            }
        }
        __builtin_amdgcn_wave_barrier();
        float Kh[16], ahv[16];
        {
            float Rh[16];
#pragma unroll
            for (int t = 0; t < 16; ++t) { Kh[t] = 0.f; Rh[t] = bf2f(RT[t * 72 + lane]); }
            f32x4 nt4[4], ng4[4]; bf16_t nk = KAP[0 * 72 + lane];
            ROW4(nt4, 4, 0); ROW4(ng4, 5, 0);
            MEMBAR();
#pragma unroll
            for (int sI = 0; sI < 16; ++sI) {
                f32x4 ct[4], cg[4]; const float kps = bf2f(nk);
#pragma unroll
                for (int q = 0; q < 4; ++q) { ct[q] = nt4[q]; cg[q] = ng4[q]; }
                if (sI < 15) { ROW4(nt4, 4, sI + 1); ROW4(ng4, 5, sI + 1); nk = KAP[(sI + 1) * 72 + lane]; }
                MEMBAR();
#pragma unroll
                for (int t = sI; t < 16; ++t) { Kh[t] += kps * ct[t >> 2][t & 3]; Rh[t] -= kps * cg[t >> 2][t & 3]; }
            }
            bf16_t* rd = RH + (size_t)task * 1024 + lane; bf16_t* kd2 = KHT + (size_t)task * 1024 + lane;
#pragma unroll
            for (int t = 0; t < 16; ++t) { rd[t * 64] = f2bf(Rh[t]); kd2[t * 64] = f2bf(Kh[t]); }
            MEMBAR();
        }
        {
            float Z[16];
#pragma unroll
            for (int t = 0; t < 16; ++t) ahv[t] = bf2f(ALT[t * 72 + lane]) * Gc;
            f32x4 nm4[4]; bf16_t nk = KT[0 * 72 + lane];
            ROW4(nm4, 6, 0);
            MEMBAR();
#pragma unroll
            for (int sI = 0; sI < 16; ++sI) {
                f32x4 cm[4]; float z = bf2f(nk) * Gc;
#pragma unroll
                for (int q = 0; q < 4; ++q) cm[q] = nm4[q];
                if (sI < 15) { ROW4(nm4, 6, sI + 1); nk = KT[(sI + 1) * 72 + lane]; }
                MEMBAR();
#pragma unroll
                for (int t = sI + 1; t < 16; ++t) z -= cm[t >> 2][t & 3] * ahv[t];
                Z[sI] = z;
            }
            unsigned pz[8];
#pragma unroll
            for (int i = 0; i < 8; ++i) pz[i] = pk2(Z[2 * i], Z[2 * i + 1]);
            bf16_t* zd = ZT + ((size_t)task * 64 + lane) * 16;
            *(u32x4*)zd = (u32x4){pz[0], pz[1], pz[2], pz[3]}; *(u32x4*)(zd + 8) = (u32x4){pz[4], pz[5], pz[6], pz[7]};
            MEMBAR();
        }
#undef ROW4
        {
            unsigned pa[8];
#pragma unroll
            for (int i = 0; i < 8; ++i) pa[i] = pk2(ahv[2 * i], ahv[2 * i + 1]);
            bf16_t* ad = AHT + ((size_t)task * 64 + lane) * 16;
            *(u32x4*)ad = (u32x4){pa[0], pa[1], pa[2], pa[3]}; *(u32x4*)(ad + 8) = (u32x4){pa[4], pa[5], pa[6], pa[7]};
            if (g == 0) {
                unsigned pw[8];
#pragma unroll
                for (int i = 0; i < 8; ++i) pw[i] = pk2(SM[7 * 256 + (2 * i) * 16 + fr], SM[7 * 256 + (2 * i + 1) * 16 + fr]);
                bf16_t* wd = WYo + ((size_t)task * 16 + fr) * 16;
                *(u32x4*)wd = (u32x4){pw[0], pw[1], pw[2], pw[3]}; *(u32x4*)(wd + 8) = (u32x4){pw[4], pw[5], pw[6], pw[7]};
            }
        }
        __builtin_amdgcn_wave_barrier();
    }
    }
}

constexpr int RC_RD = 5, RC_SLOT = 10240;
__device__ __forceinline__ void rwkv_scan(const Ctx& c) {
    const int lane = c.lane, fr = lane & 15, g = lane >> 4;
    LAS unsigned char* ring = c.lds;
    for (int task = c.bid; task < 256; task += c.G) {
        const int b = task >> 5, h = (task >> 3) & 3, dir = (task >> 2) & 1, vs = task & 3;
        const size_t cbase = (size_t)((b * 4 + h) * 2 + dir) * 144;
        const unsigned char* KHT = c.w<unsigned char>(WS_KHT) + cbase * 2048 + lane * 16; const unsigned char* RH = c.w<unsigned char>(WS_RH) + cbase * 2048 + lane * 16;
        const unsigned char* AHT = c.w<unsigned char>(WS_AHT) + cbase * 2048 + lane * 16; const unsigned char* ZT = c.w<unsigned char>(WS_ZT) + cbase * 2048 + lane * 16;
        const unsigned char* X1 = lane < 16 ? c.w<unsigned char>(WS_GC) + cbase * 256 + lane * 16 : (lane < 48 ? c.w<unsigned char>(WS_WY) + cbase * 512 + (lane - 16) * 16 : c.w<unsigned char>(WS_VT2) + cbase * 2048 + vs * 512 + (lane - 48) * 16);
        const int x1s = lane < 16 ? 256 : (lane < 48 ? 512 : 2048);
        const unsigned char* X2 = lane < 16 ? c.w<unsigned char>(WS_VT2) + cbase * 2048 + vs * 512 + 256 + lane * 16 : c.w<unsigned char>(WS_GC) + cbase * 256 + (lane & 15) * 16;
        const int x2s = lane < 16 ? 2048 : 256;
        bf16_t* YSp = c.w<bf16_t>(WS_YS) + (size_t)dir * MTOK * 256 + h * 64 + vs * 16 + fr;
#define RC_NB(ci_) (dir == 0 ? (ci_) : ((ci_) < 16 ? 15 - (ci_) : 159 - (ci_)))
#define RC_DMA(ci_, slot_) do { int cc_ = (ci_); cc_ = cc_ < 144 ? cc_ : 143; const int nb_ = RC_NB(cc_); LAS unsigned char* d_ = ring + (slot_) * RC_SLOT; \
        _Pragma("unroll") for (int k_ = 0; k_ < 2; ++k_) { \
            __builtin_amdgcn_global_load_lds((const unsigned*)(KHT + (size_t)nb_ * 2048 + k_ * 1024), (LAS unsigned*)(d_ + k_ * 1024), 16, 0, 0); \
            __builtin_amdgcn_global_load_lds((const unsigned*)(RH + (size_t)nb_ * 2048 + k_ * 1024), (LAS unsigned*)(d_ + 2048 + k_ * 1024), 16, 0, 0); \
            __builtin_amdgcn_global_load_lds((const unsigned*)(AHT + (size_t)nb_ * 2048 + k_ * 1024), (LAS unsigned*)(d_ + 4096 + k_ * 1024), 16, 0, 0); \
            __builtin_amdgcn_global_load_lds((const unsigned*)(ZT + (size_t)nb_ * 2048 + k_ * 1024), (LAS unsigned*)(d_ + 6144 + k_ * 1024), 16, 0, 0); } \
        __builtin_amdgcn_global_load_lds((const unsigned*)(X1 + (size_t)nb_ * x1s), (LAS unsigned*)(d_ + 8192), 16, 0, 0); \
        __builtin_amdgcn_global_load_lds((const unsigned*)(X2 + (size_t)nb_ * x2s), (LAS unsigned*)(d_ + 9216), 16, 0, 0); } while (0)
        f32x4 S[4];
#pragma unroll
        for (int m = 0; m < 4; ++m) S[m] = (f32x4){0.f, 0.f, 0.f, 0.f};
#pragma unroll 1
        for (int q = 0; q < RC_RD; ++q) RC_DMA(q, q);
        asm volatile("s_waitcnt vmcnt(0)" ::: "memory");
        int slot = 0;
#pragma unroll 1
        for (int ci = 0; ci < 144; ++ci) {
            const int nb = RC_NB(ci); const int row0 = b * TPB + nb * 16;
            asm volatile("s_waitcnt vmcnt(%0)" :: "n"((RC_RD - 1) * 14 + 4) : "memory");
            const LAS bf16_t* sp = (const LAS bf16_t*)(ring + slot * RC_SLOT);
            u32x2 kh[2][2], rh[2][2], ah[4], zt[4], wy, vt; f32x4 gc[4];
#pragma unroll
            for (int k = 0; k < 2; ++k) { kh[k][0] = *(const LAS u32x2*)(sp + fr * 64 + 32 * k + 4 * g); kh[k][1] = *(const LAS u32x2*)(sp + fr * 64 + 32 * k + 16 + 4 * g);
                rh[k][0] = *(const LAS u32x2*)(sp + 1024 + fr * 64 + 32 * k + 4 * g); rh[k][1] = *(const LAS u32x2*)(sp + 1024 + fr * 64 + 32 * k + 16 + 4 * g); }
#pragma unroll
            for (int m = 0; m < 4; ++m) { ah[m] = *(const LAS u32x2*)(sp + 2048 + (16 * m + fr) * 16 + 4 * g); zt[m] = *(const LAS u32x2*)(sp + 3072 + (16 * m + fr) * 16 + 4 * g);
                gc[m] = *(const LAS f32x4*)((const LAS float*)(sp + 4096) + 16 * m + 4 * g); }
            wy = *(const LAS u32x2*)(sp + 4096 + 128 + fr * 16 + 4 * g);
            vt = *(const LAS u32x2*)(sp + 4096 + 384 + fr * 16 + 4 * g);
            asm volatile("s_waitcnt lgkmcnt(0)" ::: "memory");
            RC_DMA(ci + RC_RD, slot);
            union { u32x4 u; bf16x8 v; } B0, B1, A;
            union { u32x2 u; bf16x4 v; } a4, b4, w4;
            B0.u = (u32x4){pk2m(S[0][0], S[0][1]), pk2m(S[0][2], S[0][3]), pk2m(S[1][0], S[1][1]), pk2m(S[1][2], S[1][3])};
            B1.u = (u32x4){pk2m(S[2][0], S[2][1]), pk2m(S[2][2], S[2][3]), pk2m(S[3][0], S[3][1]), pk2m(S[3][2], S[3][3])};
            b4.u = vt;
            f32x4 w = {0.f, 0.f, 0.f, 0.f}, y = {0.f, 0.f, 0.f, 0.f};
            A.u = (u32x4){kh[0][0].x, kh[0][0].y, kh[0][1].x, kh[0][1].y}; w = __builtin_amdgcn_mfma_f32_16x16x32_bf16(A.v, B0.v, w, 0, 0, 0);
            A.u = (u32x4){kh[1][0].x, kh[1][0].y, kh[1][1].x, kh[1][1].y}; w = __builtin_amdgcn_mfma_f32_16x16x32_bf16(A.v, B1.v, w, 0, 0, 0);
            A.u = (u32x4){rh[0][0].x, rh[0][0].y, rh[0][1].x, rh[0][1].y}; y = __builtin_amdgcn_mfma_f32_16x16x32_bf16(A.v, B0.v, y, 0, 0, 0);
            A.u = (u32x4){rh[1][0].x, rh[1][0].y, rh[1][1].x, rh[1][1].y}; y = __builtin_amdgcn_mfma_f32_16x16x32_bf16(A.v, B1.v, y, 0, 0, 0);
            a4.u = wy; y = __builtin_amdgcn_mfma_f32_16x16x16bf16_1k(a4.v, b4.v, y, 0, 0, 0);
            w4.u = (u32x2){pk2m(-w[0], -w[1]), pk2m(-w[2], -w[3])};
#pragma unroll
            for (int m = 0; m < 4; ++m) {
                f32x4 d = {0.f, 0.f, 0.f, 0.f};
                a4.u = zt[m]; d = __builtin_amdgcn_mfma_f32_16x16x16bf16_1k(a4.v, b4.v, d, 0, 0, 0);
                a4.u = ah[m]; d = __builtin_amdgcn_mfma_f32_16x16x16bf16_1k(a4.v, w4.v, d, 0, 0, 0);
                S[m] = S[m] * gc[m] + d;
            }
#pragma unroll
            for (int j = 0; j < 4; ++j) { const int t = 4 * g + j; YSp[(size_t)(row0 + (dir ? 15 - t : t)) * 256] = f2bf(y[j]); }
            slot = slot + 1 == RC_RD ? 0 : slot + 1;
        }
        asm volatile("s_waitcnt vmcnt(0)" ::: "memory");
#undef RC_NB
#undef RC_DMA
    }
}

__device__ __forceinline__ void hgrn_scan(const Ctx& c) {
    const int lane = c.lane, fr = lane & 15, g = lane >> 4;
    for (int task = c.bid; task < 256; task += c.G) {
        const int b = task >> 5, h = (task >> 3) & 3, dir = (task >> 2) & 1, vs = task & 3;
        const bf16_t* QIN = c.w<bf16_t>(WS_QIN) + (size_t)dir * MTOK * 256 + h * 64;
        const bf16_t* KOT = c.w<bf16_t>(WS_KOT) + (((size_t)(dir * 8 + b) * 4 + h) * NBLK16) * 1024;
        const bf16_t* IT = c.w<bf16_t>(WS_IT) + (((size_t)(b * 4 + h)) * NBLK16) * 1024;
        const float* DEC = c.w<float>(WS_DEC) + (((size_t)(dir * 8 + b) * 4 + h) * NBLK16) * 64;
        bf16_t* O2 = c.w<bf16_t>(WS_O2) + (size_t)dir * MTOK * 256 + h * 64 + vs * 16 + fr;
        f32x4 S[4];
#pragma unroll
        for (int m = 0; m < 4; ++m) S[m] = (f32x4){0.f, 0.f, 0.f, 0.f};
        u32x2 q00[4], q01[4], q10[4], q11[4]; f32x4 dc[4][4]; bf16x4 ka[4][4], ib[4];
#define HG_NB(ci_) (dir == 0 ? (ci_) : ((ci_) < 16 ? 15 - (ci_) : 159 - (ci_)))
#define HG_LOAD(ci_, st_) do { int cc_ = (ci_); cc_ = cc_ < NBLK16 ? cc_ : NBLK16 - 1; const int nb_ = HG_NB(cc_); const bf16_t* qp_ = QIN + (size_t)(b * TPB + nb_ * 16 + fr) * 256 + 4 * g; \
        q00[st_] = *(const u32x2*)qp_; q01[st_] = *(const u32x2*)(qp_ + 16); q10[st_] = *(const u32x2*)(qp_ + 32); q11[st_] = *(const u32x2*)(qp_ + 48); \
        _Pragma("unroll") for (int m_ = 0; m_ < 4; ++m_) { dc[st_][m_] = *(const f32x4*)(DEC + (size_t)nb_ * 64 + 16 * m_ + 4 * g); ka[st_][m_] = *(const bf16x4*)(KOT + (size_t)nb_ * 1024 + (16 * m_ + fr) * 16 + 4 * g); } \
        ib[st_] = *(const bf16x4*)(IT + (size_t)nb_ * 1024 + (vs * 16 + fr) * 16 + 4 * g); MEMBAR(); } while (0)
#define HG_STEP(ci_, st_) do { const int nb_ = HG_NB(ci_); const int row0_ = b * TPB + nb_ * 16; \
        union { u32x4 u; bf16x8 v; } A0, A1, B0, B1; \
        A0.u = (u32x4){q00[st_].x, q00[st_].y, q01[st_].x, q01[st_].y}; A1.u = (u32x4){q10[st_].x, q10[st_].y, q11[st_].x, q11[st_].y}; \
        B0.u = (u32x4){pk2m(S[0][0], S[0][1]), pk2m(S[0][2], S[0][3]), pk2m(S[1][0], S[1][1]), pk2m(S[1][2], S[1][3])}; \
        B1.u = (u32x4){pk2m(S[2][0], S[2][1]), pk2m(S[2][2], S[2][3]), pk2m(S[3][0], S[3][1]), pk2m(S[3][2], S[3][3])}; \
        f32x4 o = (f32x4){0.f, 0.f, 0.f, 0.f}; \
        o = __builtin_amdgcn_mfma_f32_16x16x32_bf16(A0.v, B0.v, o, 0, 0, 0); o = __builtin_amdgcn_mfma_f32_16x16x32_bf16(A1.v, B1.v, o, 0, 0, 0); \
        _Pragma("unroll") for (int j_ = 0; j_ < 4; ++j_) O2[(size_t)(row0_ + 4 * g + j_) * 256] = f2bf(o[j_]); \
        _Pragma("unroll") for (int m_ = 0; m_ < 4; ++m_) { S[m_] = S[m_] * dc[st_][m_]; S[m_] = __builtin_amdgcn_mfma_f32_16x16x16bf16_1k(ka[st_][m_], ib[st_], S[m_], 0, 0, 0); } } while (0)
        HG_LOAD(0, 0); HG_LOAD(1, 1); HG_LOAD(2, 2);
#pragma unroll 1
        for (int ci = 0; ci < NBLK16; ci += 4) {
            HG_LOAD(ci + 3, 3); HG_STEP(ci, 0);
            HG_LOAD(ci + 4, 0); HG_STEP(ci + 1, 1);
            HG_LOAD(ci + 5, 1); HG_STEP(ci + 2, 2);
            HG_LOAD(ci + 6, 2); HG_STEP(ci + 3, 3);
        }
#undef HG_NB
#undef HG_LOAD
#undef HG_STEP
    }
}

template <bool LAT> __device__ __forceinline__ void attn_unit(const Ctx& c, int l, int b, int h, int r, int jb) {
    const int lane = c.lane, fr = lane & 15, g = lane >> 4;
    const size_t bh = (size_t)(b * 8 + h);
    const bf16_t* Q = c.w<bf16_t>(WS_QN) + bh * TPB * 64; const bf16_t* K = c.w<bf16_t>(WS_KN) + bh * TPB * 64; const bf16_t* V = c.w<bf16_t>(WS_VT) + bh * 64 * TPB;
    const int q0 = LAT ? CTX + r * 64 + jb * 16 : jb * 16;
    const bf16x8 qf0 = *(const bf16x8*)(Q + (size_t)(q0 + fr) * 64 + 8 * g), qf1 = *(const bf16x8*)(Q + (size_t)(q0 + fr) * 64 + 32 + 8 * g);
    constexpr int NT = LAT ? 32 : 16, NB = NT / 8;
    int r_start = r - 4; r_start = r_start < 0 ? 0 : (r_start > 24 ? 24 : r_start);
    int k_start = 16 * jb - 8; k_start = k_start < 0 ? 0 : (k_start > 32 ? 32 : k_start);
    const bf16_t* kbase = K + (size_t)(fr >> 3) * 512 + (fr & 7) * 32 + g * 8;
#define KEY0(t) ((t) < 16 ? (t) * 16 : CTX + (r_start + (((t) - 16) >> 1)) * 64 + k_start + 16 * ((t) & 1))
    f32x4 sc[NT];
    bf16x8 kf[2][8][2];
#define K_ISSUE(bt, buf) do { _Pragma("unroll") for (int i_ = 0; i_ < 8; ++i_) { const bf16_t* kp_ = kbase + (size_t)(KEY0((bt) * 8 + i_) >> 3) * 512; \
        kf[buf][i_][0] = *(const bf16x8*)kp_; kf[buf][i_][1] = *(const bf16x8*)(kp_ + 256); } MEMBAR(); } while (0)
#define K_COMP(bt, buf) do { _Pragma("unroll") for (int i_ = 0; i_ < 8; ++i_) { f32x4 a_ = (f32x4){0.f, 0.f, 0.f, 0.f}; \
        a_ = __builtin_amdgcn_mfma_f32_16x16x32_bf16(kf[buf][i_][0], qf0, a_, 0, 0, 0); a_ = __builtin_amdgcn_mfma_f32_16x16x32_bf16(kf[buf][i_][1], qf1, a_, 0, 0, 0); sc[(bt) * 8 + i_] = a_; } MEMBAR(); } while (0)
    K_ISSUE(0, 0); K_ISSUE(1, 1);
    K_COMP(0, 0);
    if (LAT) { K_ISSUE(2, 0); K_COMP(1, 1); K_ISSUE(3, 1); K_COMP(2, 0); K_COMP(3, 1); }
    else K_COMP(1, 1);
#undef K_ISSUE
#undef K_COMP
    if (LAT) {
        const int qc = 16 * jb + fr; int w_start = qc - 8; w_start = w_start < 0 ? 0 : (w_start > 48 ? 48 : w_start);
        const float* rpb = c.a->in[25] + (size_t)(l * 8 + h) * 15 * 31;
        float bias[16][4];
#pragma unroll
        for (int t = 16; t < NT; ++t) {
            const int rrow = (t - 16) >> 1, hf = t & 1; const int ridx = r_start + rrow - r + 7;
#pragma unroll
            for (int j = 0; j < 4; ++j) { const int kc = k_start + 16 * hf + 4 * g + j; int cidx = kc - qc + 15; cidx = cidx < 0 ? 0 : (cidx > 30 ? 30 : cidx); bias[t - 16][j] = rpb[ridx * 31 + cidx]; }
        }
        MEMBAR();
#pragma unroll
        for (int t = 16; t < NT; ++t)
#pragma unroll
            for (int j = 0; j < 4; ++j) { const int kc = k_start + 16 * (t & 1) + 4 * g + j; const bool ok = kc >= w_start && kc < w_start + 16; sc[t][j] = ok ? sc[t][j] + bias[t - 16][j] : -1e30f; }
    }
    float m = -3e38f;
#pragma unroll
    for (int t = 0; t < NT; ++t) m = fmaxf(m, fmaxf(fmaxf(sc[t][0], sc[t][1]), fmaxf(sc[t][2], sc[t][3])));
    m = fmaxf(m, shx(m, 16)); m = fmaxf(m, shx(m, 32));
    float ls = 0.f;
    u32x4 pa[NT / 2];
#pragma unroll
    for (int ks = 0; ks < NT / 2; ++ks) {
        float p[8];
#pragma unroll
        for (int j = 0; j < 4; ++j) { p[j] = __expf(sc[2 * ks][j] - m); p[4 + j] = __expf(sc[2 * ks + 1][j] - m); }
#pragma unroll
        for (int j = 0; j < 8; ++j) ls += p[j];
        pa[ks] = (u32x4){pk2m(p[0], p[1]), pk2m(p[2], p[3]), pk2m(p[4], p[5]), pk2m(p[6], p[7])};
    }
    ls += shx(ls, 16); ls += shx(ls, 32);
    f32x4 o[4];
#pragma unroll
    for (int n = 0; n < 4; ++n) o[n] = (f32x4){0.f, 0.f, 0.f, 0.f};
    const bf16_t* vbase = V + (size_t)(g >> 1) * 512 + fr * 8 + (g & 1) * 4;
    u32x2 vf[2][2][4][2];
#define V_ISSUE(bt, buf) do { _Pragma("unroll") for (int i_ = 0; i_ < 2; ++i_) { const int ta_ = 2 * ((bt) * 2 + i_); const int tok_ = KEY0(ta_); \
        _Pragma("unroll") for (int n_ = 0; n_ < 4; ++n_) { const bf16_t* vp_ = vbase + n_ * 128 + (size_t)(tok_ >> 3) * 512; vf[buf][i_][n_][0] = *(const u32x2*)vp_; vf[buf][i_][n_][1] = *(const u32x2*)(vp_ + 1024); } } MEMBAR(); } while (0)
#define V_COMP(bt, buf) do { _Pragma("unroll") for (int i_ = 0; i_ < 2; ++i_) { union { u32x4 u; bf16x8 v; } pa_; pa_.u = pa[(bt) * 2 + i_]; \
        _Pragma("unroll") for (int n_ = 0; n_ < 4; ++n_) { union { u32x4 u; bf16x8 v; } vf_; vf_.u = (u32x4){vf[buf][i_][n_][0].x, vf[buf][i_][n_][0].y, vf[buf][i_][n_][1].x, vf[buf][i_][n_][1].y}; \
            o[n_] = __builtin_amdgcn_mfma_f32_16x16x32_bf16(pa_.v, vf_.v, o[n_], 0, 0, 0); } } MEMBAR(); } while (0)
    V_ISSUE(0, 0); V_ISSUE(1, 1);
    V_COMP(0, 0); V_ISSUE(2, 0); V_COMP(1, 1); V_ISSUE(3, 1); V_COMP(2, 0);
    if (LAT) { V_ISSUE(4, 0); V_COMP(3, 1); V_ISSUE(5, 1); V_COMP(4, 0); V_ISSUE(6, 0); V_COMP(5, 1); V_ISSUE(7, 1); V_COMP(6, 0); V_COMP(7, 1); }
    else V_COMP(3, 1);
#undef V_ISSUE
#undef V_COMP
#undef KEY0
    bf16_t* MIX = c.w<bf16_t>(WS_MIX);
#pragma unroll
    for (int j = 0; j < 4; ++j) {
        const float li = 1.f / shidx(ls, 4 * g + j);
        bf16_t* dst = MIX + (size_t)(b * TPB + q0 + 4 * g + j) * D + 512 + h * 64 + fr;
#pragma unroll
        for (int n = 0; n < 4; ++n) dst[16 * n] = f2bf(o[n][j] * li);
    }
}

__device__ __forceinline__ void phase_mix(const Ctx& c, int l) {
#pragma unroll 1
    for (int rep = 0; rep < (REP_PHASE == 41 ? 2 : 1); ++rep) if (c.wave == 0) { __builtin_amdgcn_s_setprio(3); rwkv_scan(c); __builtin_amdgcn_s_setprio(0); }
#pragma unroll 1
    for (int rep = 0; rep < (REP_PHASE == 42 ? 2 : 1); ++rep) if (c.wave == 1) { __builtin_amdgcn_s_setprio(3); hgrn_scan(c); __builtin_amdgcn_s_setprio(0); }
    if (c.G == 256) {
        const int x = c.bid & 7;
        unsigned* head = c.w<unsigned>(WS_CTL) + CW_ATT + (l * 8 + x) * 64;
        unsigned un = 0;
        if (c.lane == 0) un = __hip_atomic_fetch_add(head, 1u, __ATOMIC_RELAXED, __HIP_MEMORY_SCOPE_AGENT);
        for (;;) {
            const unsigned u = (unsigned)__builtin_amdgcn_readfirstlane((int)un);
            if (u >= 8 * 144) break;
            if (c.lane == 0) un = __hip_atomic_fetch_add(head, 1u, __ATOMIC_RELAXED, __HIP_MEMORY_SCOPE_AGENT);
            const int p = (int)u / 144, q = (int)u - p * 144, gp = p * 8 + x, b = gp >> 3, h = gp & 7;
            if (q < 128) attn_unit<true>(c, l, b, h, q >> 2, q & 3);
            else if (l < DEPTH - 1) attn_unit<false>(c, l, b, h, 0, q - 128);
        }
    } else {
        for (int u = c.bid * 8 + c.wave; u < 8192 + 1024; u += c.G * 8) {
            if (u < 8192) attn_unit<true>(c, l, u >> 10, (u >> 7) & 7, (u >> 2) & 31, u & 3);
            else { const int v = u - 8192; attn_unit<false>(c, l, v >> 7, (v >> 4) & 7, 0, v & 15); }
        }
    }
}

__device__ __forceinline__ void cvt_moe_group(const Ctx& c, int l, int task4) {
    LAS float* T = (LAS float*)c.lds;
    bf16_t* W1 = c.w<bf16_t>(WS_W1); bf16_t* W2 = c.w<bf16_t>(WS_W2);
    CvtJob jb[4];
#pragma unroll
    for (int q = 0; q < 4; ++q) {
        const int task = task4 * 4 + q; const int e = task / 384; int t = task - e * 384;
        if (t < 256) { const int up = t >> 7; t &= 127; const int kt = t >> 3, nt = t & 7; const int n0 = nt * 64, drow = (n0 >> 7) * 256 + (n0 & 127) + up * 128;
            jb[q].src = c.a->in[up ? 31 : 30] + (((size_t)l * 32 + e) * 1024 + kt * 64) * 512 + n0; jb[q].src_ld = 512; jb[q].dst = W1 + ((size_t)e * 1024 + drow) * 1024 + kt * 64; jb[q].dst_ld = 1024;
        } else { t -= 256; const int kt = t >> 4, nt = t & 15;
            jb[q].src = c.a->in[32] + (((size_t)l * 32 + e) * 512 + kt * 64) * 1024 + nt * 64; jb[q].src_ld = 1024; jb[q].dst = W2 + ((size_t)e * 1024 + nt * 64) * 512 + kt * 64; jb[q].dst_ld = 512;
        }
    }
    cvt_tile4(c, T, jb);
}

__device__ __forceinline__ void phase_post(const Ctx& c, int l) {
    const bf16_t* P = c.w<bf16_t>(WS_P); bf16_t* MIX = c.w<bf16_t>(WS_MIX);
    const bf16_t* O1 = c.w<bf16_t>(WS_O1); const bf16_t* O2 = c.w<bf16_t>(WS_O2); const bf16_t* YS = c.w<bf16_t>(WS_YS);
    const bf16_t* GG = c.w<bf16_t>(WS_G); const bf16_t* BON = c.w<bf16_t>(WS_BON);
    const int lane = c.lane;
    {
        const int ch = lane * 4, stride = c.G * 8;
        const f32x4 gn = *(const f32x4*)(c.a->in[11] + (size_t)l * 256 + ch), lg = *(const f32x4*)(c.a->in[21] + (size_t)l * 256 + ch), lb = *(const f32x4*)(c.a->in[22] + (size_t)l * 256 + ch);
        u32x2 pa, pbo, pgg, pgp, pb0, pb1, py0, py1;
#define POST_LOAD(r_) do { const size_t rr_ = (size_t)(r_); pa = *(const u32x2*)(O1 + rr_ * 256 + ch); pb0 = *(const u32x2*)(O2 + rr_ * 256 + ch); pb1 = *(const u32x2*)(O2 + ((size_t)MTOK + rr_) * 256 + ch); \
        pgp = *(const u32x2*)(P + rr_ * PT + PA_G + ch); py0 = *(const u32x2*)(YS + rr_ * 256 + ch); py1 = *(const u32x2*)(YS + ((size_t)MTOK + rr_) * 256 + ch); \
        pbo = *(const u32x2*)(BON + rr_ * 256 + ch); pgg = *(const u32x2*)(GG + rr_ * 256 + ch); } while (0)
        const bool lat_only = (l == DEPTH - 1); const int nrows = lat_only ? NB * SEQ : MTOK;
#define POST_ROW(i_) (lat_only ? ((i_) >> 11) * TPB + CTX + ((i_) & (SEQ - 1)) : (i_))
        POST_LOAD(POST_ROW(c.bid * 8 + c.wave));
        for (int ri = c.bid * 8 + c.wave; ri < nrows; ri += stride) {
            const int row = POST_ROW(ri);
            const u32x2 gp = pgp;
            const f32x4 a = {bflo(pa.x), bfhi(pa.x), bflo(pa.y), bfhi(pa.y)}, bo = {bflo(pbo.x), bfhi(pbo.x), bflo(pbo.y), bfhi(pbo.y)}, gg = {bflo(pgg.x), bfhi(pgg.x), bflo(pgg.y), bfhi(pgg.y)};
            const f32x4 b0 = {bflo(pb0.x), bfhi(pb0.x), bflo(pb0.y), bfhi(pb0.y)}, b1 = {bflo(pb1.x), bfhi(pb1.x), bflo(pb1.y), bfhi(pb1.y)};
            const f32x4 y0 = {bflo(py0.x), bfhi(py0.x), bflo(py0.y), bfhi(py0.y)}, y1 = {bflo(py1.x), bfhi(py1.x), bflo(py1.y), bfhi(py1.y)};
            POST_LOAD(ri + stride < nrows ? POST_ROW(ri + stride) : row);
            {
                const f32x4 o = a + b0 + b1;
                float ss = o[0] * o[0] + o[1] * o[1] + o[2] * o[2] + o[3] * o[3]; ss = red16(ss);
                const float inv = rsqrtf(ss * (1.f / 64.f) + 1e-6f);
                const float g0 = bflo(gp.x), g1 = bfhi(gp.x), g2 = bflo(gp.y), g3 = bfhi(gp.y);
                u32x2 w; w.x = pk2(o[0] * inv * gn[0] * g0 * sigm(g0), o[1] * inv * gn[1] * g1 * sigm(g1)); w.y = pk2(o[2] * inv * gn[2] * g2 * sigm(g2), o[3] * inv * gn[3] * g3 * sigm(g3));
                *(u32x2*)(MIX + (size_t)row * D + ch) = w;
            }
            {
                const f32x4 y = y0 + y1;
                float sm = y[0] + y[1] + y[2] + y[3]; sm = red16(sm); const float mean = sm * (1.f / 64.f);
                const f32x4 dv = y - mean;
                float vs = dv[0] * dv[0] + dv[1] * dv[1] + dv[2] * dv[2] + dv[3] * dv[3]; vs = red16(vs);
                const float inv = rsqrtf(vs * (1.f / 64.f) + 64e-5f);
                const f32x4 r = (dv * inv * lg + lb + bo) * gg;
                u32x2 w; w.x = pk2(r[0], r[1]); w.y = pk2(r[2], r[3]);
                *(u32x2*)(MIX + (size_t)row * D + 256 + ch) = w;
            }
        }
#undef POST_LOAD
#undef POST_ROW
    }
    __syncthreads();
    {
        const int nhere = (l < DEPTH - 1 && c.G == 256) ? 256 : 2048;
        for (int i = c.bid; i < nhere; i += c.G) cvt_moe_group(c, l, 96 * (i >> 6) + (i & 63));
    }
}

constexpr int WG_OFF = 140288;
__device__ __forceinline__ void phase_norm2(const Ctx& c, int l) {
    const float* MOD = c.w<float>(WS_MOD); const float* X = c.w<float>(WS_X); bf16_t* H = c.w<bf16_t>(WS_H);
    int4* ROUTE = c.w<int4>(WS_ROUTE); int* LIST = c.w<int>(WS_LIST); float* LISTW = c.w<float>(WS_LISTW);
    unsigned* CNT = c.w<unsigned>(WS_CTL) + CW_CNT + l * 64;
    const float* brg = c.a->in[27] + l * 4; const float* bre = c.a->in[29] + l * 32;
    LAS float* WE = (LAS float*)c.lds; LAS float* WG = (LAS float*)(c.lds + WG_OFF);
    LAS unsigned* lcnt = (LAS unsigned*)(c.lds + MISC_OFF + 1024); LAS unsigned* lbase = lcnt + 32; LAS int* rinfo = (LAS int*)(lcnt + 64);
    const int lane = c.lane;
    {
        const f32x4* wre4 = (const f32x4*)(c.a->in[28] + (size_t)l * 1024 * 32); const f32x4* wrg4 = (const f32x4*)(c.a->in[26] + (size_t)l * 1024 * 4);
        f32x4 wv[18];
#pragma unroll
        for (int i = 0; i < 16; ++i) wv[i] = wre4[c.tid + i * 512];
#pragma unroll
        for (int i = 0; i < 2; ++i) wv[16 + i] = wrg4[c.tid + i * 512];
#pragma unroll
        for (int i = 0; i < 16; ++i) { const int idx = c.tid + i * 512; const int k = idx >> 3, c4 = idx & 7, slot = ((k >> 8) * 4 + (k & 3)) * 64 + ((k >> 2) & 63);
            *(LAS f32x4*)(WE + ((size_t)((c4 >> 1) * 1024 + slot)) * 8 + (c4 & 1) * 4) = wv[i]; }
#pragma unroll
        for (int i = 0; i < 2; ++i) { const int k = c.tid + i * 512; const int slot = ((k >> 8) * 4 + (k & 3)) * 64 + ((k >> 2) & 63); *(LAS f32x4*)(WG + slot * 4) = wv[16 + i]; }
        if (c.tid < 32) lcnt[c.tid] = 0u;
    }
    __syncthreads();
    int nrow = 0;
    const int stride = c.G * 8;
    f32x4 gn4[4], xc[4], shc[4], scc[4];
    {
        const float* gain = c.a->in[5] + (size_t)l * D; const int row0 = c.bid * 8 + c.wave; const int b0 = row0 / TPB, s0 = row0 - b0 * TPB;
        const float* md0 = MOD + ((size_t)l * 9 + (s0 < CTX ? 8 : b0)) * 6144;
#pragma unroll
        for (int j = 0; j < 4; ++j) { const int col = lane * 4 + 256 * j; gn4[j] = *(const f32x4*)(gain + col);
            xc[j] = *(const f32x4*)(X + (size_t)row0 * D + col); shc[j] = *(const f32x4*)(md0 + 3072 + col); scc[j] = *(const f32x4*)(md0 + 4096 + col); }
    }
    for (int row = c.bid * 8 + c.wave; row < MTOK; row += stride) {
        const int b = row / TPB, s = row - b * TPB;
        f32x4 x[4], shv[4], scv[4];
#pragma unroll
        for (int j = 0; j < 4; ++j) { x[j] = xc[j]; shv[j] = shc[j]; scv[j] = scc[j]; }
        {
            const int rn = row + stride < MTOK ? row + stride : row; const int bn = rn / TPB, sn = rn - bn * TPB;
            const float* mdn = MOD + ((size_t)l * 9 + (sn < CTX ? 8 : bn)) * 6144;
#pragma unroll
            for (int j = 0; j < 4; ++j) { const int col = lane * 4 + 256 * j;
                xc[j] = *(const f32x4*)(X + (size_t)rn * D + col); shc[j] = *(const f32x4*)(mdn + 3072 + col); scc[j] = *(const f32x4*)(mdn + 4096 + col); }
        }
        if (l == DEPTH - 1 && s < CTX) continue;
        float ss = 0.f;
#pragma unroll
        for (int j = 0; j < 4; ++j) ss += x[j][0] * x[j][0] + x[j][1] * x[j][1] + x[j][2] * x[j][2] + x[j][3] * x[j][3];
        ss = red64(ss);
        const float inv = rsqrtf(ss * (1.f / 1024.f) + 1e-6f);
        f32x4 hv[4];
#pragma unroll
        for (int j = 0; j < 4; ++j) { const int col = lane * 4 + 256 * j;
            hv[j] = x[j] * inv * gn4[j] * (1.f + scv[j]) + shv[j];
            u32x2 o; o.x = pk2(hv[j][0], hv[j][1]); o.y = pk2(hv[j][2], hv[j][3]); *(u32x2*)(H + (size_t)row * D + col) = o; }
        f32x4 gl4 = {0.f, 0.f, 0.f, 0.f};
#pragma unroll
        for (int j = 0; j < 4; ++j)
#pragma unroll
            for (int e = 0; e < 4; ++e) gl4 += *(const LAS f32x4*)(WG + ((j * 4 + e) * 64 + lane) * 4) * hv[j][e];
        float gl[4];
#pragma unroll
        for (int q = 0; q < 4; ++q) gl[q] = red64(gl4[q]) + brg[q];
        int gs = 0; float gm = gl[0];
#pragma unroll
        for (int q = 1; q < 4; ++q) if (gl[q] > gm) { gm = gl[q]; gs = q; }
        gs = __builtin_amdgcn_readfirstlane(gs);
        const float gw = 1.f / (expf(gl[0] - gm) + expf(gl[1] - gm) + expf(gl[2] - gm) + expf(gl[3] - gm));
        f32x4 e0 = {0.f, 0.f, 0.f, 0.f}, e1 = e0;
        const LAS float* we = WE + ((size_t)gs * 1024 + lane) * 8;
#pragma unroll
        for (int j = 0; j < 4; ++j)
#pragma unroll
            for (int e = 0; e < 4; ++e) { const LAS float* wp = we + (j * 4 + e) * 64 * 8; e0 += *(const LAS f32x4*)wp * hv[j][e]; e1 += *(const LAS f32x4*)(wp + 4) * hv[j][e]; }
        float el[8];
#pragma unroll
        for (int q = 0; q < 4; ++q) { el[q] = red64(e0[q]) + bre[gs * 8 + q]; el[4 + q] = red64(e1[q]) + bre[gs * 8 + 4 + q]; }
        int i0 = 0; float m0 = el[0];
#pragma unroll
        for (int q = 1; q < 8; ++q) if (el[q] > m0) { m0 = el[q]; i0 = q; }
        int i1 = -1; float m1 = -3e38f;
#pragma unroll
        for (int q = 0; q < 8; ++q) if (q != i0 && el[q] > m1) { m1 = el[q]; i1 = q; }
        if (i1 < 0) i1 = (i0 + 1) & 7;
        const float p1 = expf(m1 - m0);
        const float wa = gw / (1.f + p1), wb = gw * p1 / (1.f + p1);
        if (lane == 0) {
            const int ea = gs * 8 + i0, eb = gs * 8 + i1;
            const int ra = (int)__hip_atomic_fetch_add(lcnt + ea, 1u, __ATOMIC_RELAXED, __HIP_MEMORY_SCOPE_WORKGROUP);
            const int rb = (int)__hip_atomic_fetch_add(lcnt + eb, 1u, __ATOMIC_RELAXED, __HIP_MEMORY_SCOPE_WORKGROUP);
            LAS int* ri = rinfo + (c.wave * 16 + nrow) * 8;
            ri[0] = ea; ri[1] = ra; ri[2] = eb; ri[3] = rb; ri[4] = __float_as_int(wa); ri[5] = __float_as_int(wb); ri[6] = row;
        }
        ++nrow;
    }
    __syncthreads();
    if (c.tid < 32) { const unsigned n = lcnt[c.tid]; lbase[c.tid] = n ? atomicAdd(CNT + c.tid, n) : 0u; }
    __syncthreads();
    if (lane < nrow) {
        const LAS int* ri = rinfo + (c.wave * 16 + lane) * 8;
        const int ea = ri[0], eb = ri[2], row = ri[6]; const int pa = (int)lbase[ea] + ri[1], pb = (int)lbase[eb] + ri[3];
        LIST[(size_t)ea * MTOK + pa] = row; LISTW[(size_t)ea * MTOK + pa] = __int_as_float(ri[4]);
        LIST[(size_t)eb * MTOK + pb] = row; LISTW[(size_t)eb * MTOK + pb] = __int_as_float(ri[5]);
        ROUTE[row] = make_int4(ea, pa, eb, pb);
    }
}

constexpr int NPHASE = 2 + 9 * DEPTH;

__global__ void __launch_bounds__(512, 2) mk_fwd(Args a) {
    extern __shared__ __attribute__((aligned(16))) unsigned char lds_raw[];
    Ctx c;
    c.a.in.a = (const __attribute__((address_space(4))) Args*)__builtin_amdgcn_kernarg_segment_ptr(); c.out = (float*)a.out; c.ws = a.ws; c.lds = (LAS unsigned char*)lds_raw;
    const int wave0 = __builtin_amdgcn_readfirstlane((int)threadIdx.x >> 6);
    { int t_; asm volatile("v_mbcnt_lo_u32_b32 %0, -1, 0\n\tv_mbcnt_hi_u32_b32 %0, -1, %0" : "=v"(t_)); c.tid = wave0 * 64 + t_; }
    c.lane = c.tid & 63; c.wave = wave0; c.bid = blockIdx.x; c.G = gridDim.x;
    const int lo = a.lo, hi = a.hi;
    if (c.tid < 4) ((LAS unsigned*)(c.lds + MISC_OFF))[c.tid] = 0u;
    __syncthreads();
    XcdBarrier bar; bar.bar = c.w<unsigned>(WS_CTL); bar.x = 0; bar.st = (volatile LAS unsigned*)(c.lds + MISC_OFF);
    if (hi - lo > 1) bar = xcd_barrier_post(c.w<unsigned>(WS_CTL), (volatile LAS unsigned*)(c.lds + MISC_OFF), (unsigned)c.tid);
#ifndef PH_ONLY
#define PH_ONLY -1
#endif
#define PHON(j) (PH_ONLY < 0 || PH_ONLY == (j))
#define IN(k) (lo <= (k) && (k) < hi)
#define SEAM(k) do { if (IN((k) + 1)) xcd_barrier(bar, (unsigned)c.tid); } while (0)
#define FRESH() do { const __attribute__((address_space(4))) Args* ap_ = (const __attribute__((address_space(4))) Args*)__builtin_amdgcn_kernarg_segment_ptr(); \
        GAS unsigned char* wp_ = ap_->ws; int t_; asm volatile("v_mbcnt_lo_u32_b32 %0, -1, 0\n\tv_mbcnt_hi_u32_b32 %0, -1, %0" : "=v"(t_)); t_ += wave0 * 64; asm volatile("" : "+s"(ap_), "+s"(wp_)); \
        c.a.in.a = ap_; c.out = (float*)ap_->out; c.ws = wp_; c.tid = t_; c.lane = t_ & 63; c.wave = __builtin_amdgcn_readfirstlane(t_ >> 6); } while (0)
#if REP_PHASE >= 0 && REP_PHASE <= 10
#define SITE(j, pidx, ...) if (PHON(j) && IN(pidx)) { int nrep_ = (REP_PHASE == (j)) ? 2 : 1; asm volatile("" : "+s"(nrep_)); \
        for (int rep_ = 0; rep_ < nrep_; ++rep_) { FRESH(); { __VA_ARGS__ } if (rep_ + 1 < nrep_) xcd_barrier(bar, (unsigned)c.tid); } SEAM(pidx); }
#else
#define SITE(j, pidx, ...) if (PHON(j) && IN(pidx)) { FRESH(); { __VA_ARGS__ } SEAM(pidx); }
#endif
    SITE(0, 0, phase_prologue(c);)
#pragma unroll 1
    for (int l = 0; l < DEPTH; ++l) {
        const int p0 = 1 + 9 * l;
        SITE(1, p0 + 0, phase_norm1(c, l);)
        SITE(2, p0 + 1,
            pg8::StaticOrder S; S.init(c.w<bf16_t>(WS_H), c.w<bf16_t>(WS_WIN) + (size_t)l * 4096 * 1024, MTOK, 4096, 1024, c.G, c.bid);
            pg8::EpiBf16Rows E{c.w<bf16_t>(WS_P), PT, PT};
            pg8::gemm_phase(c.lds, c.tid, S, E);)
        SITE(3, p0 + 2, phase_prep(c, l); __syncthreads(); if (REP_PHASE == 31) { FRESH(); phase_prep(c, l); __syncthreads(); }
                        FRESH(); phase_prep_hgrn(c, l); __syncthreads(); if (REP_PHASE == 32) { FRESH(); phase_prep_hgrn(c, l); __syncthreads(); }
                        FRESH(); phase_prep_rwkv(c, l); if (REP_PHASE == 33) { __syncthreads(); FRESH(); phase_prep_rwkv(c, l); }
)
        SITE(4, p0 + 3, phase_mix(c, l);)
        SITE(5, p0 + 4, phase_post(c, l);)
        SITE(6, p0 + 5,
            pg8::StaticOrder S; S.init(c.w<bf16_t>(WS_MIX), c.w<bf16_t>(WS_WOUT) + (size_t)l * 1024 * 1024, MTOK, 1024, 1024, c.G, c.bid, l == DEPTH - 1);
            pg8::EpiX E{c.w<float>(WS_X), c.w<float>(WS_MOD) + (size_t)l * 9 * 6144 + 2048};
            pg8::gemm_phase(c.lds, c.tid, S, E);
            if (l < DEPTH - 1 && c.G == 256 && c.bid >= 32) { __syncthreads();
                for (int j = 0; j < 8; ++j) { const int i = 256 + (c.bid - 32) * 8 + j; cvt_moe_group(c, l, 96 * (i >> 6) + (i & 63)); } })
        SITE(7, p0 + 6, phase_norm2(c, l);)
        SITE(8, p0 + 7,
            build_tpre(c, l);
            pg8::MoeOrder<true> S{(const char*)c.w<bf16_t>(WS_H), (const char*)c.w<bf16_t>(WS_W1), 1024, c.w<int>(WS_LIST), (const LAS int*)(c.lds + MISC_OFF + 64), (const LAS int*)(c.lds + MISC_OFF + 256), c.G, c.bid};
            pg8::EpiHid E{c.w<bf16_t>(WS_HID), c.w<float>(WS_LISTW)};
            pg8::gemm_phase(c.lds, c.tid, S, E);
            {
                unsigned* tk = c.w<unsigned>(WS_CTL) + CW_CVT + l * 64; LAS int* tl = (LAS int*)(c.lds + MISC_OFF + 32);
                for (;;) { __syncthreads();
                    if (c.tid == 0) *tl = (int)__hip_atomic_fetch_add(tk, 1u, __ATOMIC_RELAXED, __HIP_MEMORY_SCOPE_AGENT);
                    __syncthreads();
                    const int j = __builtin_amdgcn_readfirstlane(*tl); if (j >= 1024) break;
                    cvt_moe_group(c, l, 96 * (j >> 5) + 64 + (j & 31)); } })
        SITE(9, p0 + 8,
            build_tpre(c, l);
            pg8::MoeOrder<false> S{(const char*)c.w<bf16_t>(WS_HID), (const char*)c.w<bf16_t>(WS_W2), 512, c.w<int>(WS_LIST), (const LAS int*)(c.lds + MISC_OFF + 64), (const LAS int*)(c.lds + MISC_OFF + 256), c.G, c.bid};
            pg8::EpiBf16Rows E{c.w<bf16_t>(WS_Y), 1024, 1024};
            pg8::gemm_phase(c.lds, c.tid, S, E);)
    }
    SITE(10, NPHASE - 1, phase_norm1(c, DEPTH);)
#undef SITE
#undef IN
#undef SEAM
}

extern "C" void kernel_launch(void* const* d_in, const int* in_sizes, int n_in, void* d_out, int out_size, void* d_ws, size_t ws_size, hipStream_t stream) {
    static int grid = 0;
    if (grid == 0) {
        if (n_in != 33 || ws_size < WS_END) { fprintf(stderr, "kernel_launch: unexpected n_in %d / ws %zu (need %zu)\n", n_in, ws_size, (size_t)WS_END); grid = -1; return; }
        int dev = 0, cus = 0, per_cu = 0;
        hipGetDevice(&dev); hipDeviceGetAttribute(&cus, hipDeviceAttributeMultiprocessorCount, dev);
        if (hipFuncSetAttribute((const void*)mk_fwd, hipFuncAttributeMaxDynamicSharedMemorySize, LDS_BYTES) != hipSuccess) { fprintf(stderr, "kernel_launch: hipFuncSetAttribute failed\n"); grid = -1; return; }
        hipOccupancyMaxActiveBlocksPerMultiprocessor(&per_cu, (const void*)mk_fwd, 512, LDS_BYTES);
        (void)hipGetLastError();
        if (per_cu < 1) fprintf(stderr, "kernel_launch: occupancy query reports %d\n", per_cu);
        grid = cus > 0 ? cus : 256;
    }
    if (grid < 0) return;
    hipMemsetAsync((char*)d_ws + WS_CTL, 0, CTL_BYTES, stream);
    Args a{};
    for (int i = 0; i < 33; ++i) a.in.p[i] = (const GAS float*)d_in[i];
    a.out = (GAS float*)d_out; a.ws = (GAS unsigned char*)d_ws;
#if MK_SPLIT
    for (int p = 0; p < NPHASE; ++p) { a.lo = p; a.hi = p + 1; hipLaunchKernelGGL(mk_fwd, dim3(grid), dim3(512), LDS_BYTES, stream, a); }
#else
    a.lo = 0; a.hi = NPHASE; hipLaunchKernelGGL(mk_fwd, dim3(grid), dim3(512), LDS_BYTES, stream, a);
#endif
}
```
